# Optimizing an MI355X kernel written in HIP

```python
import math
import jax, jax.numpy as jnp
from jax import lax
import numpy as np

D_MODEL = 1024
BATCH = 16
SEQ = 2048
DEPTH = 2

CHUNK = 64
N_MIXERS = 2
N_A = (DEPTH + 1) // 2
N_B = DEPTH // 2
CONV_W = 3
CONV_GROUPS = 16
HG_EXPAND = 128
HG_HEADS = D_MODEL // HG_EXPAND
HG_DV = D_MODEL // HG_HEADS
MEM_LEN = 256
X_HEADS = 4
X_HEAD_DIM = D_MODEL // X_HEADS
D_FF = ((8 * D_MODEL // 3 + 255) // 256) * 256
EPS = 1e-6

kernel_name = "hybrid_shortconv_hgrn2_memxattn"


def rmsnorm(x, g):
    xf = x.astype(jnp.float32)
    y = xf * lax.rsqrt(jnp.mean(xf * xf, axis=-1, keepdims=True) + EPS)
    return (y * g.astype(jnp.float32)).astype(x.dtype)


def short_conv_mixer(h, w_in, w_conv, w_out):
    s = h.shape[1]
    gb, gc, u = jnp.split(h @ w_in, 3, axis=-1)
    u = gc * u
    up = jnp.pad(u, ((0, 0), (CONV_W - 1, 0), (0, 0)))
    z = sum(w_conv[j] * up[:, j:j + s] for j in range(CONV_W))
    return (gb * z) @ w_out


def _gla_chunk_step(state, inp):
    q, k, v, logg = inp
    c = q.shape[2]
    b = jnp.cumsum(logg, axis=2)
    o_inter = jnp.einsum('bhtk,bhkv->bhtv', q * jnp.exp(b), state)
    tri = jnp.tril(jnp.ones((c, c), dtype=bool))
    dec = jnp.where(tri[None, None, :, :, None],
                    b[:, :, :, None, :] - b[:, :, None, :, :], -jnp.inf)
    attn = jnp.einsum('bhtk,bhsk,bhtsk->bhts', q, k, jnp.exp(dec))
    o_intra = jnp.einsum('bhts,bhsv->bhtv', attn, v)
    b_last = b[:, :, -1:, :]
    new_state = (jnp.exp(b_last[:, :, 0, :])[..., None] * state
                 + jnp.einsum('bhsk,bhsv->bhkv', k * jnp.exp(b_last - b), v))
    return new_state, o_inter + o_intra


def hgrn2_mixer(h, w_in, w_out, g_norm, lb):
    bsz, s, _ = h.shape
    q, f, i, og = jnp.split(h @ w_in, 4, axis=-1)
    q = jax.nn.silu(q.astype(jnp.float32))
    lbf = lb.astype(jnp.float32)
    g = lbf + (1.0 - lbf) * jax.nn.sigmoid(f.astype(jnp.float32))
    k = 1.0 - g
    logg = jnp.log(g)
    nc = s // CHUNK

    def to_chunks(t, d):
        return t.astype(jnp.float32).reshape(bsz, nc, CHUNK, HG_HEADS, d).transpose(1, 0, 3, 2, 4)

    xs = (to_chunks(q, HG_EXPAND), to_chunks(k, HG_EXPAND), to_chunks(i, HG_DV), to_chunks(logg, HG_EXPAND))
    s0 = jnp.zeros((bsz, HG_HEADS, HG_EXPAND, HG_DV), jnp.float32)
    _, o = lax.scan(_gla_chunk_step, s0, xs)
    o = o.transpose(1, 0, 3, 2, 4).reshape(bsz, s, HG_HEADS, HG_DV)
    o = rmsnorm(o, g_norm.reshape(HG_HEADS, HG_DV))
    o = o.reshape(bsz, s, D_MODEL).astype(h.dtype) * jax.nn.silu(og)
    return o @ w_out


def memory_cross_attn(h, mem_n, w_q, w_kv, w_o):
    bsz, s, _ = h.shape
    q = (h @ w_q).reshape(bsz, s, X_HEADS, X_HEAD_DIM)
    k, v = jnp.split(mem_n @ w_kv, 2, axis=-1)
    k = k.reshape(bsz, -1, X_HEADS, X_HEAD_DIM)
    v = v.reshape(bsz, -1, X_HEADS, X_HEAD_DIM)
    sc = jnp.einsum('bshd,bmhd->bhsm', q.astype(jnp.float32), k.astype(jnp.float32)) * (X_HEAD_DIM ** -0.5)
    p = jax.nn.softmax(sc, axis=-1).astype(h.dtype)
    o = jnp.einsum('bhsm,bmhd->bshd', p, v).reshape(bsz, s, D_MODEL)
    return o @ w_o


def swiglu(h, w_in, w_out):
    a, b = jnp.split(h @ w_in, 2, axis=-1)
    return (jax.nn.silu(a) * b) @ w_out


def setup_inputs(seed: int = 0) -> dict:
    key = jax.random.key(seed)
    ks = jax.random.split(key, 24)
    d = D_MODEL

    def w(k, shape, fan_in):
        return jax.random.normal(k, shape, jnp.float32) * fan_in ** -0.5

    def gain(k, shape):
        return 1.0 + 0.02 * jax.random.normal(k, shape, jnp.float32)

    return {
        "x": jax.random.normal(ks[0], (BATCH, SEQ, d), jnp.float32),
        "mem": jax.random.normal(ks[1], (BATCH, MEM_LEN, d), jnp.float32),
        "norm_mix": gain(ks[2], (DEPTH, d)),
        "conv_w_in": w(ks[3], (N_A, d, 3 * d), d),
        "conv_w": w(ks[4], (N_A, CONV_W, d), CONV_W),
        "conv_w_out": w(ks[5], (N_A, d, d), d),
        "hgrn_w_in": w(ks[6], (N_B, d, 4 * d), d),
        "hgrn_w_out": w(ks[7], (N_B, d, d), d),
        "hgrn_norm": gain(ks[8], (N_B, d)),
        "hgrn_lb": 0.5 * jax.random.normal(ks[9], (DEPTH, d), jnp.float32),
        "norm_xattn": gain(ks[10], (DEPTH, d)),
        "norm_mem": gain(ks[11], (DEPTH, d)),
        "xattn_w_q": w(ks[12], (DEPTH, d, d), d),
        "xattn_w_kv": w(ks[13], (DEPTH, d, 2 * d), d),
        "xattn_w_o": w(ks[14], (DEPTH, d, d), d),
        "norm_ffn": gain(ks[15], (DEPTH, d)),
        "ffn_w_in": w(ks[16], (DEPTH, d, 2 * D_FF), d),
        "ffn_w_out": w(ks[17], (DEPTH, D_FF, d), D_FF),
        "final_norm": gain(ks[18], (d,)),
    }


def reference(x, mem, norm_mix, conv_w_in, conv_w, conv_w_out, hgrn_w_in, hgrn_w_out, hgrn_norm, hgrn_lb,
              norm_xattn, norm_mem, xattn_w_q, xattn_w_kv, xattn_w_o, norm_ffn, ffn_w_in, ffn_w_out, final_norm):
    lb_all = jnp.cumsum(jax.nn.softmax(hgrn_lb.astype(jnp.float32), axis=0), axis=0)
    lb_all = lb_all - lb_all[0:1]
    for i in range(DEPTH):
        h = rmsnorm(x, norm_mix[i])
        if i % N_MIXERS == 0:
            j = i // N_MIXERS
            y = short_conv_mixer(h, conv_w_in[j], conv_w[j], conv_w_out[j])
        else:
            j = i // N_MIXERS
            y = hgrn2_mixer(h, hgrn_w_in[j], hgrn_w_out[j], hgrn_norm[j], lb_all[i])
        x = x + y
        h = rmsnorm(x, norm_xattn[i])
        x = x + memory_cross_attn(h, rmsnorm(mem, norm_mem[i]), xattn_w_q[i], xattn_w_kv[i], xattn_w_o[i])
        h = rmsnorm(x, norm_ffn[i])
        x = x + swiglu(h, ffn_w_in[i], ffn_w_out[i])
    return rmsnorm(x, final_norm)
```

```cpp
#define MK_NAIVE_GEMM 0
#include <hip/hip_runtime.h>
#include <cstdio>
#include <cstdint>
namespace pg8 {
#define PG8_LAS __attribute__((address_space(3)))
typedef unsigned short bf16_t;
typedef short bf16x8 __attribute__((ext_vector_type(8)));
typedef float f32x4 __attribute__((ext_vector_type(4)));
typedef unsigned u32x4 __attribute__((ext_vector_type(4)));
constexpr int BM = 256, BK = 64, HALF = 128, HTB = HALF * BK * 2  , STAGE_BYTES = 8 * HTB, NXCD = 8, WGM = 8;

__host__ __device__ __forceinline__ int lds_byte(int r, int c) { const int st = (r >> 4) * 2 + (c >> 5), rr = r & 15, cc = c & 31, ob = rr * 64 + cc * 2; return st * 1024 + (ob ^ (((ob >> 9) & 1) << 5)); }
__host__ __device__ __forceinline__ void stage_rc(int b, int& R, int& C) { const int st = b / 1024, sb = b % 1024, swz = sb ^ (((sb >> 9) & 1) << 5); R = (st >> 1) * 16 + swz / 64; C = (st & 1) * 32 + (swz % 64) / 2; }
__host__ __device__ __forceinline__ int perm32(int rho) { const int n = rho >> 4, i = rho & 15; return 8 * (i >> 2) + 4 * n + (i & 3); }

struct Unit { int pm, pn; };
struct Gemm { const bf16_t* A; const bf16_t* Bt; int M, N, K; };

struct StaticOrder {
    int nM, nN, nwg, G, c;
    __host__ __device__ void init(int M, int N, int G_, int c_) { nM = M / BM; nN = N / BM; nwg = nM * nN; G = G_; c = c_; }
    __host__ __device__ bool next(int i, Unit& u) const {
        const long L = (long)i * G + c; if (L >= nwg) return false;
        int wgid = (int)L; { const int q = nwg / NXCD, r = nwg % NXCD, xcd = wgid % NXCD, off = wgid / NXCD; wgid = (xcd < r ? xcd * (q + 1) : r * (q + 1) + (xcd - r) * q) + off; }
        const int nig = WGM * nN, gid = wgid / nig, fm = gid * WGM, gsz = (nM - fm) < WGM ? (nM - fm) : WGM;
        u.pm = fm + ((wgid % nig) % gsz); u.pn = (wgid % nig) / gsz; return true;
    }
    __device__ __forceinline__ void a_ready(const Unit&) const {}
    __device__ __forceinline__ void done(const Unit&) const {}
};

__device__ __forceinline__ unsigned cvt_pk_bf16(float lo, float hi) { unsigned r; asm volatile("v_cvt_pk_bf16_f32 %0, %1, %2" : "=v"(r) : "v"(lo), "v"(hi)); return r; }
typedef unsigned u32x2 __attribute__((ext_vector_type(2)));
constexpr int TT_ROWS = 32768;
__device__ __forceinline__ void rs_rows(const float* ssq, const float* rdirect, int rowbase, int lane, float (&v)[2]) {
#pragma unroll
    for (int ai = 0; ai < 2; ++ai) {
        const int row = rowbase + ai * HALF + lane;
        if (rdirect) v[ai] = rdirect[row];
        else { float s = 0.f;
#pragma unroll
            for (int k = 0; k < 16; ++k) s += ssq[(size_t)k * TT_ROWS + row];
            v[ai] = rsqrtf(s * (1.0f / 1024.0f) + 1e-6f); }
    }
}
__device__ __forceinline__ float silu_f(float x) { return x / (1.0f + __expf(-x)); }
__device__ __forceinline__ u32x4 pack8(const f32x4 v0, const f32x4 v1) { u32x4 w; w.x = cvt_pk_bf16(v0[0], v0[1]); w.y = cvt_pk_bf16(v0[2], v0[3]); w.z = cvt_pk_bf16(v1[0], v1[1]); w.w = cvt_pk_bf16(v1[2], v1[3]); return w; }

template <int MODE> struct EpiPair {
    static constexpr bool PERM = true, AFTER_DRAIN = false;
    bf16_t* OUT; int ldo; bf16_t* GB; const float* ssq;
    __device__ __forceinline__ void operator()(const f32x4 (&acc)[2][2][4][2], const Unit& u, int wr, int wc, int fr, int fq) const {
        const int row0 = u.pm * BM + wr * 64 + fr;
        float rsv[2]; rs_rows(ssq, nullptr, u.pm * BM + wr * 64, fq * 16 + fr, rsv);
        if (MODE == 0 && u.pn >= 8) {
            const int col0 = (u.pn - 8) * 256 + wc * 32 + 8 * fq;
#pragma unroll
            for (int ai = 0; ai < 2; ++ai)
#pragma unroll
                for (int m = 0; m < 4; ++m) { const int row = row0 + ai * HALF + m * 16; const float rs = __shfl(rsv[ai], 16 * m + fr); bf16_t* rowp = GB + (size_t)row * 1024 + col0;
#pragma unroll
                    for (int bj = 0; bj < 2; ++bj) *(u32x4*)(rowp + bj * HALF) = pack8(acc[ai][bj][m][0] * rs, acc[ai][bj][m][1] * rs); }
        } else {
            const int col0 = u.pn * 128 + wc * 32 + 8 * fq;
#pragma unroll
            for (int ai = 0; ai < 2; ++ai)
#pragma unroll
                for (int m = 0; m < 4; ++m) { const int row = row0 + ai * HALF + m * 16; const float rs = __shfl(rsv[ai], 16 * m + fr);
                    const f32x4 a0 = acc[ai][0][m][0] * rs, a1 = acc[ai][0][m][1] * rs, b0 = acc[ai][1][m][0] * rs, b1 = acc[ai][1][m][1] * rs; f32x4 v0, v1;
                    if (MODE == 0) { v0 = a0 * b0; v1 = a1 * b1; }
                    else {
#pragma unroll
                        for (int j = 0; j < 4; ++j) { v0[j] = silu_f(a0[j]) * b0[j]; v1[j] = silu_f(a1[j]) * b1[j]; } }
                    *(u32x4*)(OUT + (size_t)row * ldo + col0) = pack8(v0, v1); }
        }
    }
};
struct EpiResid {
    static constexpr bool PERM = false, AFTER_DRAIN = false;
    const float* base; float* out; bf16_t* xb; float* ssq;
    __device__ __forceinline__ void operator()(const f32x4 (&acc)[2][2][4][2], const Unit& u, int wr, int wc, int fr, int fq) const {
        const int row0 = u.pm * BM + wr * 64 + fr, col0 = u.pn * BM + wc * 32 + 4 * fq;
#pragma unroll
        for (int ai = 0; ai < 2; ++ai)
#pragma unroll
            for (int m = 0; m < 4; ++m) { const int row = row0 + ai * HALF + m * 16; const size_t off = (size_t)row * 1024 + col0; float sq = 0.f;
#pragma unroll
                for (int bj = 0; bj < 2; ++bj)
#pragma unroll
                    for (int n = 0; n < 2; ++n) { const f32x4 b = *(const f32x4*)(base + off + bj * HALF + n * 16); const f32x4 o = b + acc[ai][bj][m][n];
                        *(f32x4*)(out + off + bj * HALF + n * 16) = o; u32x2 w; w.x = cvt_pk_bf16(o[0], o[1]); w.y = cvt_pk_bf16(o[2], o[3]); *(u32x2*)(xb + off + bj * HALF + n * 16) = w;
                        sq += (o[0] * o[0] + o[1] * o[1]) + (o[2] * o[2] + o[3] * o[3]); }
                sq += __shfl_xor(sq, 16); sq += __shfl_xor(sq, 32);
                if (fq == 0) ssq[(size_t)(u.pn * 4 + wc) * TT_ROWS + row] = sq;
                asm volatile("" ::: "memory"); }
    }
};
struct EpiScale {
    static constexpr bool PERM = true, AFTER_DRAIN = false;
    bf16_t* O; int ldc; const float* ssq; const float* rdirect; float scale;
    __device__ __forceinline__ void operator()(const f32x4 (&acc)[2][2][4][2], const Unit& u, int wr, int wc, int fr, int fq) const {
        const int row0 = u.pm * BM + wr * 64 + fr, col0 = u.pn * BM + wc * 32 + 8 * fq;
        float rsv[2]; rs_rows(ssq, rdirect, u.pm * BM + wr * 64, fq * 16 + fr, rsv);
#pragma unroll
        for (int ai = 0; ai < 2; ++ai)
#pragma unroll
            for (int m = 0; m < 4; ++m) { const int row = row0 + ai * HALF + m * 16; const float rs = __shfl(rsv[ai], 16 * m + fr) * scale; bf16_t* rowp = O + (size_t)row * ldc + col0;
#pragma unroll
                for (int bj = 0; bj < 2; ++bj) *(u32x4*)(rowp + bj * HALF) = pack8(acc[ai][bj][m][0] * rs, acc[ai][bj][m][1] * rs); }
    }
};
struct EpiHgrn {
    static constexpr bool PERM = true, AFTER_DRAIN = false;
    bf16_t* P; size_t pstride; const float* ssq; const float* lb;
    __device__ __forceinline__ void operator()(const f32x4 (&acc)[2][2][4][2], const Unit& u, int wr, int wc, int fr, int fq) const {
        const int row0 = u.pm * BM + wr * 64 + fr, type = u.pn >> 2, col0 = (u.pn & 3) * BM + wc * 32 + 8 * fq;
        bf16_t* base = P + (size_t)type * pstride + (size_t)row0 * 1024 + col0;
        float rsv[2]; rs_rows(ssq, nullptr, u.pm * BM + wr * 64, fq * 16 + fr, rsv);
        if (type == 1) {
#pragma unroll
            for (int bj = 0; bj < 2; ++bj) {
                const f32x4 l0 = *(const f32x4*)(lb + col0 + bj * HALF), l1 = *(const f32x4*)(lb + col0 + bj * HALF + 4);
#pragma unroll
                for (int ai = 0; ai < 2; ++ai)
#pragma unroll
                    for (int m = 0; m < 4; ++m) { const float rs = __shfl(rsv[ai], 16 * m + fr); f32x4 v0, v1;
#pragma unroll
                        for (int j = 0; j < 4; ++j) { const float s0 = 1.0f / (1.0f + __expf(-acc[ai][bj][m][0][j] * rs)), s1 = 1.0f / (1.0f + __expf(-acc[ai][bj][m][1][j] * rs));
                            v0[j] = __logf(l0[j] + (1.0f - l0[j]) * s0); v1[j] = __logf(l1[j] + (1.0f - l1[j]) * s1); }
                        *(u32x4*)(base + (size_t)(ai * HALF + m * 16) * 1024 + bj * HALF) = pack8(v0, v1); }
            }
        } else if (type == 2) {
#pragma unroll
            for (int ai = 0; ai < 2; ++ai)
#pragma unroll
                for (int m = 0; m < 4; ++m) { const float rs = __shfl(rsv[ai], 16 * m + fr);
#pragma unroll
                    for (int bj = 0; bj < 2; ++bj) *(u32x4*)(base + (size_t)(ai * HALF + m * 16) * 1024 + bj * HALF) = pack8(acc[ai][bj][m][0] * rs, acc[ai][bj][m][1] * rs); }
        } else {
#pragma unroll
            for (int ai = 0; ai < 2; ++ai)
#pragma unroll
                for (int m = 0; m < 4; ++m) { const float rs = __shfl(rsv[ai], 16 * m + fr);
#pragma unroll
                    for (int bj = 0; bj < 2; ++bj) { f32x4 v0, v1;
#pragma unroll
                        for (int j = 0; j < 4; ++j) { v0[j] = silu_f(acc[ai][bj][m][0][j] * rs); v1[j] = silu_f(acc[ai][bj][m][1][j] * rs); }
                        *(u32x4*)(base + (size_t)(ai * HALF + m * 16) * 1024 + bj * HALF) = pack8(v0, v1); } }
        }
    }
};
template <class Epi, class Sched, bool ALIGN_EPI = false, bool SP2 = false>
__device__ __forceinline__ void gemm_phase(PG8_LAS unsigned char* lds, const Gemm g, const Sched& S, const Epi& E) {
    int tid_ = threadIdx.x; asm volatile("" : "+v"(tid_));
    const int tid = tid_, wid = __builtin_amdgcn_readfirstlane(tid >> 6), lane = tid & 63, wr = wid >> 2, wc = wid & 3, fr = lane & 15, fq = lane >> 4;
    const int K = g.K, nt = K / BK;
    unsigned voffA[2], voffB[2];
#pragma unroll
    for (int i = 0; i < 2; ++i) { int R, C; stage_rc(tid * 16 + i * 8192, R, C); const int Rb = Epi::PERM ? ((R & ~31) + perm32(R & 31)) : R;
        voffA[i] = (unsigned)(R * K + C) * 2u; voffB[i] = (unsigned)(Rb * K + C) * 2u; }
    const size_t kstep = (size_t)(BK * 2);
    const size_t hstep = (size_t)HALF * K * 2;
    const size_t tstep = 2 * hstep;
    const unsigned ldsw = (unsigned)wid * 1024u;
    const int aoff = lds_byte(wr * 64 + fr, fq * 8), boff = lds_byte(wc * 32 + fr, fq * 8);
#define PG8_SA(b, h) (((b) * 2 + (h)) * HTB)
#define PG8_SB(b, h) ((4 + (b) * 2 + (h)) * HTB)
#define PG8_STAGE(bufoff, gbase, voff) do { _Pragma("unroll") for (int _i = 0; _i < 2; ++_i) \
        __builtin_amdgcn_global_load_lds((const unsigned*)((const char*)(gbase) + (voff)[_i]), (PG8_LAS unsigned*)(lds + (bufoff) + ldsw + _i * 8192), 16, 0, 0); } while (0)
#define PG8_LDA(dst, b, h) do { _Pragma("unroll") for (int m = 0; m < 4; ++m) _Pragma("unroll") for (int k = 0; k < 2; ++k) dst[m][k] = *(const PG8_LAS bf16x8*)(lds + PG8_SA(b, h) + aoff + m * 2048 + k * 1024); } while (0)
#define PG8_LDB(dst, b, h) do { _Pragma("unroll") for (int n = 0; n < 2; ++n) _Pragma("unroll") for (int k = 0; k < 2; ++k) dst[n][k] = *(const PG8_LAS bf16x8*)(lds + PG8_SB(b, h) + boff + n * 2048 + k * 1024); } while (0)
#define PG8_MMA(ai, bj, At, Bt) do { __builtin_amdgcn_s_setprio(1); _Pragma("unroll") for (int m = 0; m < 4; ++m) _Pragma("unroll") for (int n = 0; n < 2; ++n) _Pragma("unroll") for (int k = 0; k < 2; ++k) \
        acc[ai][bj][m][n] = __builtin_amdgcn_mfma_f32_16x16x32_bf16(Bt[n][k], At[m][k], acc[ai][bj][m][n], 0, 0, 0); __builtin_amdgcn_s_setprio(0); } while (0)
#define PG8_WAIT_V(n) asm volatile("s_waitcnt vmcnt(" #n ")" ::: "memory")
#define PG8_WAIT_L(n) asm volatile("s_waitcnt lgkmcnt(" #n ")" ::: "memory")
#define PG8_BAR __builtin_amdgcn_s_barrier()
#define PG8_SCHED __builtin_amdgcn_sched_barrier(0)
    Unit cur, nxt; int ui = 0;
    if (!S.next(0, cur)) return;
    f32x4 acc[2][2][4][2];
#pragma unroll
    for (int a = 0; a < 2; ++a)
#pragma unroll
        for (int b = 0; b < 2; ++b)
#pragma unroll
            for (int m = 0; m < 4; ++m)
#pragma unroll
                for (int n = 0; n < 2; ++n) acc[a][b][m][n] = (f32x4){0.f, 0.f, 0.f, 0.f};
    bf16x8 At[4][2], B0[2][2], B1[2][2];
    const char* cA = (const char*)g.A + (size_t)cur.pm * tstep; const char* cB = (const char*)g.Bt + (size_t)cur.pn * tstep;
    S.a_ready(cur);
    if constexpr (SP2) {
        PG8_STAGE(PG8_SB(0, 0), cB, voffB); PG8_STAGE(PG8_SB(0, 1), cB + hstep, voffB); PG8_STAGE(PG8_SA(0, 0), cA, voffA); PG8_STAGE(PG8_SA(0, 1), cA + hstep, voffA);
        if (wr == 1) PG8_BAR;
        PG8_WAIT_V(2); PG8_BAR;
        PG8_STAGE(PG8_SB(1, 0), cB + kstep, voffB); PG8_STAGE(PG8_SA(1, 0), cA + kstep, voffA); PG8_STAGE(PG8_SB(1, 1), cB + hstep + kstep, voffB);
        PG8_WAIT_V(6); PG8_BAR;
    } else {
        PG8_STAGE(PG8_SB(0, 0), cB, voffB); PG8_STAGE(PG8_SA(0, 0), cA, voffA); PG8_STAGE(PG8_SB(0, 1), cB + hstep, voffB); PG8_STAGE(PG8_SA(0, 1), cA + hstep, voffA);
        if (wr == 1) PG8_BAR;
        PG8_WAIT_V(4); PG8_BAR;
        PG8_STAGE(PG8_SB(1, 0), cB + kstep, voffB); PG8_STAGE(PG8_SA(1, 0), cA + kstep, voffA); PG8_STAGE(PG8_SB(1, 1), cB + hstep + kstep, voffB);
        PG8_WAIT_V(6); PG8_BAR;
    }
    for (;;) {
        const bool has_next = S.next(ui + 1, nxt);
        const char* nA = has_next ? (const char*)g.A + (size_t)nxt.pm * tstep : cA; const char* nB = has_next ? (const char*)g.Bt + (size_t)nxt.pn * tstep : cB;
        for (int t = 0; t < nt; t += 2) {
            const bool last = (t == nt - 2);
            const char* a1 = cA + (size_t)(t + 1) * kstep;
            const char* a2 = last ? nA : cA + (size_t)(t + 2) * kstep; const char* b2 = last ? nB : cB + (size_t)(t + 2) * kstep;
            const char* a3 = a2 + kstep; const char* b3 = b2 + kstep;
            if (last && has_next) S.a_ready(nxt);
            if constexpr (SP2) {
            PG8_LDB(B0, 0, 0); PG8_LDB(B1, 0, 1); PG8_SCHED; PG8_LDA(At, 0, 0); PG8_STAGE(PG8_SA(1, 1), a1 + hstep, voffA);
            PG8_WAIT_V(8); PG8_WAIT_L(0); PG8_BAR; PG8_MMA(0, 0, At, B0); PG8_MMA(0, 1, At, B1); PG8_BAR; PG8_SCHED;
            PG8_LDA(At, 0, 1); PG8_STAGE(PG8_SB(0, 0), b2, voffB); PG8_STAGE(PG8_SB(0, 1), b2 + hstep, voffB); PG8_STAGE(PG8_SA(0, 0), a2, voffA);
            PG8_WAIT_V(8); PG8_WAIT_L(0); PG8_BAR; PG8_MMA(1, 0, At, B0); PG8_MMA(1, 1, At, B1); PG8_BAR; PG8_SCHED;
            PG8_LDB(B0, 1, 0); PG8_LDB(B1, 1, 1); PG8_SCHED; PG8_LDA(At, 1, 0); PG8_STAGE(PG8_SA(0, 1), a2 + hstep, voffA);
            PG8_WAIT_V(8); PG8_WAIT_L(0); PG8_BAR; PG8_MMA(0, 0, At, B0); PG8_MMA(0, 1, At, B1); PG8_BAR; PG8_SCHED;
            PG8_LDA(At, 1, 1); PG8_STAGE(PG8_SB(1, 0), b3, voffB); PG8_STAGE(PG8_SB(1, 1), b3 + hstep, voffB); PG8_STAGE(PG8_SA(1, 0), a3, voffA);
            PG8_WAIT_V(8); PG8_WAIT_L(0); PG8_BAR; PG8_MMA(1, 0, At, B0); PG8_MMA(1, 1, At, B1); PG8_BAR; PG8_SCHED;
            } else {
            PG8_LDB(B0, 0, 0); PG8_SCHED; PG8_LDA(At, 0, 0); PG8_STAGE(PG8_SA(1, 1), a1 + hstep, voffA);
            PG8_WAIT_L(8); PG8_BAR; PG8_WAIT_L(0); PG8_MMA(0, 0, At, B0); PG8_BAR; PG8_SCHED;
            PG8_LDB(B1, 0, 1); PG8_STAGE(PG8_SB(0, 0), b2, voffB);
            PG8_BAR; PG8_WAIT_L(0); PG8_MMA(0, 1, At, B1); PG8_BAR;
            PG8_LDA(At, 0, 1); PG8_STAGE(PG8_SA(0, 0), a2, voffA);
            PG8_BAR; PG8_WAIT_L(0); PG8_MMA(1, 0, At, B0); PG8_BAR; PG8_SCHED;
            PG8_STAGE(PG8_SB(0, 1), b2 + hstep, voffB);
            PG8_WAIT_V(6); PG8_BAR; PG8_MMA(1, 1, At, B1); PG8_BAR;
            PG8_LDB(B0, 1, 0); PG8_SCHED; PG8_LDA(At, 1, 0); PG8_STAGE(PG8_SA(0, 1), a2 + hstep, voffA);
            PG8_WAIT_L(8); PG8_BAR; PG8_WAIT_L(0); PG8_MMA(0, 0, At, B0); PG8_BAR; PG8_SCHED;
            PG8_LDB(B1, 1, 1); PG8_STAGE(PG8_SB(1, 0), b3, voffB);
            PG8_BAR; PG8_WAIT_L(0); PG8_MMA(0, 1, At, B1); PG8_BAR;
            PG8_LDA(At, 1, 1); PG8_STAGE(PG8_SA(1, 0), a3, voffA);
            PG8_BAR; PG8_WAIT_L(0); PG8_MMA(1, 0, At, B0); PG8_BAR; PG8_SCHED;
            PG8_STAGE(PG8_SB(1, 1), b3 + hstep, voffB);
            PG8_WAIT_V(6); PG8_BAR; PG8_MMA(1, 1, At, B1); PG8_BAR;
            }
        }
        if constexpr (ALIGN_EPI) { if (wr == 0) PG8_BAR; }
        if constexpr (!Epi::AFTER_DRAIN) { E(acc, cur, wr, wc, fr, fq); S.done(cur); }
        if (!has_next) break;
#pragma unroll
        for (int a = 0; a < 2; ++a)
#pragma unroll
            for (int b = 0; b < 2; ++b)
#pragma unroll
                for (int m = 0; m < 4; ++m)
#pragma unroll
                    for (int n = 0; n < 2; ++n) acc[a][b][m][n] = (f32x4){0.f, 0.f, 0.f, 0.f};
        cur = nxt; cA = nA; cB = nB; ++ui;
        if constexpr (ALIGN_EPI) { if (wr == 1) PG8_BAR; }
    }
    PG8_WAIT_V(0);
    if constexpr (!ALIGN_EPI) { if (wr == 0) PG8_BAR; }
    PG8_BAR;
    if constexpr (Epi::AFTER_DRAIN) { E.fused(acc, cur, wr, wc, fr, fq, lds, wid, lane); S.done(cur); }
#undef PG8_SA
#undef PG8_SB
#undef PG8_STAGE
#undef PG8_LDA
#undef PG8_LDB
#undef PG8_MMA
#undef PG8_WAIT_V
#undef PG8_WAIT_L
#undef PG8_BAR
#undef PG8_SCHED
}
__device__ __forceinline__ float bf2f(short s) { return __uint_as_float(((unsigned)(unsigned short)s) << 16); }
template <class Epi, class Sched>
__device__ __forceinline__ void gemm_phase_naive(const Gemm g, const Sched& S, const Epi& E) {
    int tid_ = threadIdx.x; asm volatile("" : "+v"(tid_));
    const int tid = tid_, wid = tid >> 6, lane = tid & 63, wr = wid >> 2, wc = wid & 3, fr = lane & 15, fq = lane >> 4;
    const int K = g.K; Unit u;
    for (int i = 0; S.next(i, u); ++i) {
        f32x4 acc[2][2][4][2];
#pragma unroll
        for (int a = 0; a < 2; ++a)
#pragma unroll
            for (int b = 0; b < 2; ++b)
#pragma unroll
                for (int m = 0; m < 4; ++m)
#pragma unroll
                    for (int n = 0; n < 2; ++n) acc[a][b][m][n] = (f32x4){0.f, 0.f, 0.f, 0.f};
        const bf16_t* Arow = g.A + (size_t)(u.pm * BM + wr * 64 + fr) * K;
#pragma unroll
        for (int bj = 0; bj < 2; ++bj) {
            const int cb = u.pn * BM + bj * HALF + wc * 32;
            const bf16_t* B0 = g.Bt + (size_t)(cb + (Epi::PERM ? 8 * fq : 4 * fq)) * K;
            const bf16_t* B1 = g.Bt + (size_t)(cb + (Epi::PERM ? 8 * fq + 4 : 16 + 4 * fq)) * K;
#pragma unroll 1
            for (int k0 = 0; k0 < K; k0 += 4) {
                float bf[2][4][4];
#pragma unroll
                for (int j = 0; j < 4; ++j) { const uint2 b0 = *(const uint2*)(B0 + (size_t)j * K + k0), b1 = *(const uint2*)(B1 + (size_t)j * K + k0);
                    bf[0][j][0] = __uint_as_float(b0.x << 16); bf[0][j][1] = __uint_as_float(b0.x & 0xffff0000u); bf[0][j][2] = __uint_as_float(b0.y << 16); bf[0][j][3] = __uint_as_float(b0.y & 0xffff0000u);
                    bf[1][j][0] = __uint_as_float(b1.x << 16); bf[1][j][1] = __uint_as_float(b1.x & 0xffff0000u); bf[1][j][2] = __uint_as_float(b1.y << 16); bf[1][j][3] = __uint_as_float(b1.y & 0xffff0000u); }
#pragma unroll
                for (int ai = 0; ai < 2; ++ai)
#pragma unroll
                    for (int m = 0; m < 4; ++m) { const uint2 a2 = *(const uint2*)(Arow + (size_t)(ai * HALF + m * 16) * K + k0);
                        const float a0 = __uint_as_float(a2.x << 16), a1 = __uint_as_float(a2.x & 0xffff0000u), a2f = __uint_as_float(a2.y << 16), a3 = __uint_as_float(a2.y & 0xffff0000u);
#pragma unroll
                        for (int n = 0; n < 2; ++n)
#pragma unroll
                            for (int j = 0; j < 4; ++j) acc[ai][bj][m][n][j] += a0 * bf[n][j][0] + a1 * bf[n][j][1] + a2f * bf[n][j][2] + a3 * bf[n][j][3]; }
            }
        }
        E(acc, u, wr, wc, fr, fq);
    }
}
}
#define GAS __attribute__((address_space(1)))
#define LAS __attribute__((address_space(3)))
typedef unsigned short bf16;
typedef unsigned v4u __attribute__((ext_vector_type(4)));
typedef float f32x4 __attribute__((ext_vector_type(4)));
typedef short bf16x8 __attribute__((ext_vector_type(8)));
typedef GAS unsigned gu32;
typedef GAS unsigned long long gu64;
#define RLX_AGENT __ATOMIC_RELAXED, __HIP_MEMORY_SCOPE_AGENT
#define LDS_WAIT() asm volatile("s_waitcnt lgkmcnt(0)" ::: "memory")
#define VM_WAIT() asm volatile("s_waitcnt vmcnt(0)" ::: "memory")
__device__ __forceinline__ unsigned long long rt() { return __builtin_amdgcn_s_memrealtime(); }
__device__ __forceinline__ unsigned f2bf(float f) { unsigned u = __builtin_bit_cast(unsigned, f); return (u + 0x7fffu + ((u >> 16) & 1u)) >> 16; }
__device__ __forceinline__ unsigned pk2(float lo, float hi) { return f2bf(lo) | (f2bf(hi) << 16); }
#define XB_TMO      128
#define XB_XCNT(j)  (256  + 64 * (j))
#define XB_XSUB(j)  (1280 + 64 * (j))
#define XB_XGEN(j)  (2304 + 64 * (j))
#define XB_TOP      3328
#define XB_TOPGEN   3392
#define XCD_BAR_WORDS 3456
#define XB_SPIN_CAP (1u << 22)

__device__ __forceinline__ unsigned xb_ld(unsigned* p)              { return __hip_atomic_load(p, __ATOMIC_RELAXED, __HIP_MEMORY_SCOPE_AGENT); }
__device__ __forceinline__ unsigned xb_add(unsigned* p, unsigned v) { return __hip_atomic_fetch_add(p, v, __ATOMIC_RELAXED, __HIP_MEMORY_SCOPE_AGENT); }
__device__ __forceinline__ unsigned xb_xcc_id() { return (unsigned)__builtin_amdgcn_s_getreg((3 << 11) | 20) & 0xFu; }
#define XB_SPIN(cond, bar) do { unsigned _sp = 0; while (cond) { __builtin_amdgcn_s_sleep(1); \
    if ((++_sp & 255u) == 0u) { if (xb_ld(&(bar)[XB_TMO])) break; if (_sp > XB_SPIN_CAP) { atomicAdd(&(bar)[XB_TMO], 1u); break; } } } } while (0)

struct XcdBarrier {
    unsigned* bar; unsigned x;
    volatile LAS unsigned* st;
};

__device__ __forceinline__ XcdBarrier xcd_barrier_post(unsigned* bar, volatile LAS unsigned* st) {
    XcdBarrier b; b.bar = bar; b.x = xb_xcc_id(); b.st = st;
    if (threadIdx.x == 0) (void)xb_add(&bar[XB_XCNT(b.x)], 1u);
    return b;
}
__device__ __forceinline__ void xcd_barrier_complete(unsigned* bar, unsigned x, unsigned& nloc, unsigned& nx) {
    const unsigned G = gridDim.x * gridDim.y * gridDim.z;
    unsigned sum, cnt, mine, sp = 0u;
    for (;;) {
        sum = 0u; cnt = 0u; mine = 0u;
#pragma unroll
        for (unsigned j = 0; j < 16; ++j) { const unsigned c = xb_ld(&bar[XB_XCNT(j)]); sum += c; cnt += (c > 0u) ? 1u : 0u; mine = (j == x) ? c : mine; }
        if (sum == G) break;
        __builtin_amdgcn_s_sleep(1);
        if ((++sp & 255u) == 0u) { if (xb_ld(&bar[XB_TMO])) break; if (sp > XB_SPIN_CAP) { atomicAdd(&bar[XB_TMO], 1u); break; } }
    }
    nloc = mine > 0u ? mine : 1u; nx = cnt > 0u ? cnt : 1u;
}

__device__ __forceinline__ void xcd_barrier(const XcdBarrier& b) {
    asm volatile("s_waitcnt vmcnt(0)" ::: "memory");
    __syncthreads();
    if (threadIdx.x == 0) {
        unsigned* bar = b.bar;
        __builtin_amdgcn_s_waitcnt(0);
        unsigned nloc = b.st[0], nx = b.st[1];
        if (nloc == 0u) { xcd_barrier_complete(bar, b.x, nloc, nx); b.st[0] = nloc; b.st[1] = nx; }
        const unsigned old = xb_add(&bar[XB_XSUB(b.x)], 1u);
        const unsigned gen = old / nloc;
        if (old + 1u == (gen + 1u) * nloc) {
            __builtin_amdgcn_fence(__ATOMIC_RELEASE, "agent");
            asm volatile("s_waitcnt vmcnt(0)" ::: "memory");
            const unsigned og = xb_add(&bar[XB_TOP], 1u);
            const unsigned tg = og / nx;
            if (og + 1u == (tg + 1u) * nx) xb_add(&bar[XB_TOPGEN], 1u);
            else XB_SPIN(xb_ld(&bar[XB_TOPGEN]) == tg, bar);
            __builtin_amdgcn_fence(__ATOMIC_ACQUIRE, "agent");
            xb_add(&bar[XB_XGEN(b.x)], 1u);
            asm volatile("s_waitcnt vmcnt(0)" ::: "memory");
        } else {
            XB_SPIN(xb_ld(&bar[XB_XGEN(b.x)]) == gen, bar);
            __builtin_amdgcn_fence(__ATOMIC_ACQUIRE, "agent");
            asm volatile("s_waitcnt vmcnt(0)" ::: "memory");
        }
    }
    __syncthreads();
}

constexpr int NWAVES = 8;
constexpr int DM = 1024, NBATCH = 16, SEQ = 2048, TT = NBATCH * SEQ, MEML = 256, TMEM = NBATCH * MEML, DFF = 2816, XH = 4, XHD = 256, HGH = 8, HGD = 128;
constexpr float EPS = 1e-6f;
constexpr float QSCALE = 0.0625f * 1.4426950408889634f;
static_assert(TT == pg8::TT_ROWS, "row count");
constexpr size_t MiB = 1u << 20;
constexpr size_t WS_CTL = 0, CTL_ZERO_BYTES = 1 * MiB;
constexpr size_t WS_SSQ = 1 * MiB;
constexpr size_t WS_RMEM = 3 * MiB;
constexpr size_t WS_LB = 3 * MiB + 65536;
constexpr size_t WS_WCIN = 4 * MiB, WS_WCOUT = 10 * MiB, WS_WHIN = 12 * MiB, WS_WHOUT = 20 * MiB, WS_WQ = 22 * MiB, WS_WKV = 26 * MiB, WS_WO = 34 * MiB, WS_WFIN = 38 * MiB, WS_WFOUT = 60 * MiB;
constexpr size_t SZ_WQ = 2 * MiB, SZ_WKV = 4 * MiB, SZ_WO = 2 * MiB, SZ_WFIN = 11 * MiB, SZ_WFOUT = 5 * MiB + 512 * 1024;
constexpr size_t WS_MEMB = 72 * MiB;
constexpr size_t WS_KV = 80 * MiB, SZ_KV = 16 * MiB;
constexpr size_t WS_XB = 112 * MiB;
constexpr size_t WS_P = 176 * MiB, SZ_P = 64 * MiB;
constexpr size_t WS_END = 432 * MiB;
constexpr int CW_BAR = 4096;
constexpr int RING_OFF = 0, RING_BYTES = 131072;
constexpr int LDSCTL_OFF = RING_BYTES, MISC_OFF = LDSCTL_OFF + 320;
constexpr int LDS_BYTES = 147456;

struct Params { const float* in[19]; float* out; unsigned char* ws; };

__device__ __forceinline__ int opaque_tid() { int t = threadIdx.x; asm volatile("" : "+v"(t)); return t; }
__device__ __forceinline__ float wave_sum(float v) {
#pragma unroll
    for (int o = 1; o < 64; o <<= 1) v += __shfl_xor(v, o);
    return v;
}
__device__ __forceinline__ float wave_max(float v) {
#pragma unroll
    for (int o = 1; o < 64; o <<= 1) v = fmaxf(v, __shfl_xor(v, o));
    return v;
}
__device__ __forceinline__ float bfu2f(unsigned short s) { return __uint_as_float(((unsigned)s) << 16); }
__device__ __forceinline__ float bflo(unsigned w) { return __uint_as_float(w << 16); }
__device__ __forceinline__ float bfhi(unsigned w) { return __uint_as_float(w & 0xffff0000u); }

__device__ __forceinline__ int map_row(int mode, int n0) {
    if (mode == 1) { if (n0 < 1024) return 2048 + n0; if (n0 < 2048) { const int c = n0 - 1024; return 256 * (c >> 7) + (c & 127); } const int c = n0 - 2048; return 256 * (c >> 7) + 128 + (c & 127); }
    if (mode == 2) { if (n0 < DFF) return 256 * (n0 >> 7) + (n0 & 127); const int c = n0 - DFF; return 256 * (c >> 7) + 128 + (c & 127); }
    return n0;
}
__device__ __forceinline__ void transpose_item(const float* W, int K, int N, const float* gain, bf16* WT, int mode, LAS float* scr, int item, int lane) {
    const int nblk = N / 32, kb = item / nblk, nb = item % nblk, k0 = 64 * kb, n0 = 32 * nb;
#pragma unroll 8
    for (int i = 0; i < 32; ++i) { const int kk = 2 * i + (lane >> 5); float w = W[(size_t)(k0 + kk) * N + n0 + (lane & 31)]; if (gain) w *= gain[k0 + kk]; scr[kk * 33 + (lane & 31)] = w; }
    LDS_WAIT(); asm volatile("" ::: "memory");
    const int c = lane & 7, r0 = map_row(mode, n0);
#pragma unroll
    for (int j = 0; j < 4; ++j) { const int n = (lane >> 3) + 8 * j; const LAS float* s = scr + (8 * c) * 33 + n;
        v4u o; o.x = pk2(s[0 * 33], s[1 * 33]); o.y = pk2(s[2 * 33], s[3 * 33]); o.z = pk2(s[4 * 33], s[5 * 33]); o.w = pk2(s[6 * 33], s[7 * 33]);
        *(GAS v4u*)(WT + (size_t)(r0 + n) * K + k0 + 8 * c) = o; }
    LDS_WAIT(); asm volatile("" ::: "memory");
}
__device__ __forceinline__ void p0_prologue(const Params& p, LAS unsigned char* lds) {
    const int tid = opaque_tid(), lane = tid & 63, wave = __builtin_amdgcn_readfirstlane(tid >> 6), gw = blockIdx.x * NWAVES + wave, NGW = gridDim.x * NWAVES;
    unsigned char* ws = p.ws;
    LAS float* scr = (LAS float*)(lds + RING_OFF + wave * 16384);
#define TR_ITEM(Wp, K_, N_, Gp, WTp, MODE_) { constexpr int cnt_ = ((K_) / 64) * ((N_) / 32); if (r < cnt_) { transpose_item((Wp), (K_), (N_), (Gp), (bf16*)(WTp), (MODE_), scr, r, lane); continue; } r -= cnt_; }
    constexpr int NITEMS = (1024 / 64) * ((3072 + 1024 + 4096 + 1024 + 2 * (1024 + 2048 + 1024 + 5632)) / 32) + 2 * (DFF / 64) * (1024 / 32);
    for (int it = gw; it < NITEMS; it += NGW) {
        int r = it;
        TR_ITEM(p.in[3], 1024, 3072, p.in[2], ws + WS_WCIN, 1)
        TR_ITEM(p.in[5], 1024, 1024, (const float*)nullptr, ws + WS_WCOUT, 0)
        TR_ITEM(p.in[6], 1024, 4096, p.in[2] + 1024, ws + WS_WHIN, 0)
        TR_ITEM(p.in[7], 1024, 1024, (const float*)nullptr, ws + WS_WHOUT, 0)
        TR_ITEM(p.in[12], 1024, 1024, p.in[10], ws + WS_WQ, 0)
        TR_ITEM(p.in[12] + 1024 * 1024, 1024, 1024, p.in[10] + 1024, ws + WS_WQ + SZ_WQ, 0)
        TR_ITEM(p.in[13], 1024, 2048, p.in[11], ws + WS_WKV, 0)
        TR_ITEM(p.in[13] + 1024 * 2048, 1024, 2048, p.in[11] + 1024, ws + WS_WKV + SZ_WKV, 0)
        TR_ITEM(p.in[14], 1024, 1024, (const float*)nullptr, ws + WS_WO, 0)
        TR_ITEM(p.in[14] + 1024 * 1024, 1024, 1024, (const float*)nullptr, ws + WS_WO + SZ_WO, 0)
        TR_ITEM(p.in[16], 1024, 5632, p.in[15], ws + WS_WFIN, 2)
        TR_ITEM(p.in[16] + 1024 * 5632, 1024, 5632, p.in[15] + 1024, ws + WS_WFIN + SZ_WFIN, 2)
        TR_ITEM(p.in[17], DFF, 1024, (const float*)nullptr, ws + WS_WFOUT, 0)
        transpose_item(p.in[17] + DFF * 1024, DFF, 1024, (const float*)nullptr, (bf16*)(ws + WS_WFOUT + SZ_WFOUT), 0, scr, r, lane);
    }
#undef TR_ITEM
    const float* x = p.in[0]; bf16* XB = (bf16*)(ws + WS_XB); float* SSQ = (float*)(ws + WS_SSQ);
    for (int m = gw; m < TT; m += NGW) {
        const GAS f32x4* xr = (const GAS f32x4*)(x + (size_t)m * DM) + lane; f32x4 v[4]; float s = 0.f;
#pragma unroll
        for (int j = 0; j < 4; ++j) { v[j] = xr[64 * j]; s += (v[j].x * v[j].x + v[j].y * v[j].y) + (v[j].z * v[j].z + v[j].w * v[j].w); }
        s = wave_sum(s);
        GAS unsigned long long* o8 = (GAS unsigned long long*)(XB + (size_t)m * DM) + lane;
#pragma unroll
        for (int j = 0; j < 4; ++j) o8[64 * j] = (unsigned long long)pk2(v[j].x, v[j].y) | ((unsigned long long)pk2(v[j].z, v[j].w) << 32);
        if (lane < 16) SSQ[(size_t)lane * TT + m] = (lane == 0) ? s : 0.f;
    }
    const float* mem = p.in[1]; bf16* MEMB = (bf16*)(ws + WS_MEMB); float* RMEM = (float*)(ws + WS_RMEM);
    for (int m = gw; m < TMEM; m += NGW) {
        const GAS f32x4* xr = (const GAS f32x4*)(mem + (size_t)m * DM) + lane; f32x4 v[4]; float s = 0.f;
#pragma unroll
        for (int j = 0; j < 4; ++j) { v[j] = xr[64 * j]; s += (v[j].x * v[j].x + v[j].y * v[j].y) + (v[j].z * v[j].z + v[j].w * v[j].w); }
        s = wave_sum(s);
        GAS unsigned long long* o8 = (GAS unsigned long long*)(MEMB + (size_t)m * DM) + lane;
#pragma unroll
        for (int j = 0; j < 4; ++j) o8[64 * j] = (unsigned long long)pk2(v[j].x, v[j].y) | ((unsigned long long)pk2(v[j].z, v[j].w) << 32);
        if (lane == 0) RMEM[m] = rsqrtf(s * (1.0f / DM) + EPS);
    }
    { float* LB = (float*)(ws + WS_LB); const int gt = gw * 64 + lane; if (gt < DM) LB[gt] = 1.0f / (1.0f + __expf(p.in[9][gt] - p.in[9][DM + gt])); }
}

__device__ __forceinline__ void conv_pass(const bf16* U2, const bf16* GBp, const float* cw, bf16* V) {
    const int gtid = blockIdx.x * (NWAVES * 64) + opaque_tid(), NT = gridDim.x * NWAVES * 64;
    for (int idx = gtid; idx < TT * 128; idx += NT) {
        const int row = idx >> 7, c8 = (idx & 127) * 8, t = row & (SEQ - 1);
        const v4u z4 = {0u, 0u, 0u, 0u};
        const v4u ua = *(const v4u*)(U2 + (size_t)row * DM + c8);
        const v4u ub = (t >= 1) ? *(const v4u*)(U2 + (size_t)(row - 1) * DM + c8) : z4;
        const v4u uc = (t >= 2) ? *(const v4u*)(U2 + (size_t)(row - 2) * DM + c8) : z4;
        const v4u g = *(const v4u*)(GBp + (size_t)row * DM + c8);
        const f32x4 w0a = *(const f32x4*)(cw + c8), w0b = *(const f32x4*)(cw + c8 + 4);
        const f32x4 w1a = *(const f32x4*)(cw + DM + c8), w1b = *(const f32x4*)(cw + DM + c8 + 4);
        const f32x4 w2a = *(const f32x4*)(cw + 2 * DM + c8), w2b = *(const f32x4*)(cw + 2 * DM + c8 + 4);
        v4u o;
#define CV(W, e0, e1, wA, wB, wC) { const float z0 = wA[e0] * bflo(uc.W) + wB[e0] * bflo(ub.W) + wC[e0] * bflo(ua.W); const float z1 = wA[e1] * bfhi(uc.W) + wB[e1] * bfhi(ub.W) + wC[e1] * bfhi(ua.W); \
            o.W = pk2(bflo(g.W) * z0, bfhi(g.W) * z1); }
        CV(x, 0, 1, w0a, w1a, w2a) CV(y, 2, 3, w0a, w1a, w2a) CV(z, 0, 1, w0b, w1b, w2b) CV(w, 2, 3, w0b, w1b, w2b)
#undef CV
        *(v4u*)(V + (size_t)row * DM + c8) = o;
    }
}

__device__ __forceinline__ void attn_naive(const bf16* Q, const bf16* KV, bf16* O) {
    const int tid = opaque_tid(), lane = tid & 63, gw = blockIdx.x * NWAVES + __builtin_amdgcn_readfirstlane(tid >> 6), NGW = gridDim.x * NWAVES;
    for (int item = gw; item < TT * XH; item += NGW) {
        const int row = item >> 2, h = item & 3, b = row >> 11;
        const bf16* q = Q + (size_t)row * DM + h * XHD;
        const bf16* Kb = KV + (size_t)(b * MEML) * 2048 + h * XHD;
        float sc[4] = {0.f, 0.f, 0.f, 0.f};
        for (int c = 0; c < 32; ++c) {
            const v4u qv = *(const v4u*)(q + 8 * c);
#pragma unroll
            for (int j = 0; j < 4; ++j) { const v4u kv = *(const v4u*)(Kb + (size_t)(lane + 64 * j) * 2048 + 8 * c);
                sc[j] += bflo(qv.x) * bflo(kv.x) + bfhi(qv.x) * bfhi(kv.x) + bflo(qv.y) * bflo(kv.y) + bfhi(qv.y) * bfhi(kv.y)
                       + bflo(qv.z) * bflo(kv.z) + bfhi(qv.z) * bfhi(kv.z) + bflo(qv.w) * bflo(kv.w) + bfhi(qv.w) * bfhi(kv.w); }
        }
        const float mx = wave_max(fmaxf(fmaxf(sc[0], sc[1]), fmaxf(sc[2], sc[3])));
        float pr[4]; float sum = 0.f;
#pragma unroll
        for (int j = 0; j < 4; ++j) { pr[j] = exp2f(sc[j] - mx); sum += pr[j]; }
        sum = wave_sum(sum); const float inv = 1.0f / sum;
        const bf16* Vb = KV + (size_t)(b * MEML) * 2048 + 1024 + h * XHD + 4 * lane;
        float o0 = 0.f, o1 = 0.f, o2 = 0.f, o3 = 0.f;
#pragma unroll
        for (int j = 0; j < 4; ++j)
            for (int mm = 0; mm < 64; ++mm) { const float pm = __shfl(pr[j], mm); const uint2 vv = *(const uint2*)(Vb + (size_t)(64 * j + mm) * 2048);
                o0 += pm * bflo(vv.x); o1 += pm * bfhi(vv.x); o2 += pm * bflo(vv.y); o3 += pm * bfhi(vv.y); }
        uint2 w; w.x = pk2(o0 * inv, o1 * inv); w.y = pk2(o2 * inv, o3 * inv);
        *(uint2*)(O + (size_t)row * DM + h * XHD + 4 * lane) = w;
    }
}

__device__ __forceinline__ void scan_naive(bf16* P0  , const bf16* P1  , const bf16* P2  , const bf16* P3  , const float* gnorm, unsigned char* lds_generic, int G) {
    float* q_s = (float*)lds_generic;
    float* g_s = q_s + 16 * 128;
    float* v_s = g_s + 16 * 128;
    float* part = v_s + 16 * 128;
    const int tid = opaque_tid(), lane = tid & 63, wave = tid >> 6, vv = tid & 127, kq = tid >> 7;
    for (int item = blockIdx.x; item < NBATCH * HGH; item += G) {
        const int b = item >> 3, h = item & 7;
        const size_t base = (size_t)b * SEQ * DM + h * HGD;
        float S[32];
#pragma unroll
        for (int i = 0; i < 32; ++i) S[i] = 0.f;
        for (int t0 = 0; t0 < SEQ; t0 += 16) {
            __syncthreads();
            { const int r = tid >> 5, c4 = (tid & 31) * 4; const size_t off = base + (size_t)(t0 + r) * DM + c4;
              const uint2 a = *(const uint2*)(P0 + off), l = *(const uint2*)(P1 + off), i2 = *(const uint2*)(P2 + off);
              float* qd = q_s + r * 128 + c4; float* gd = g_s + r * 128 + c4; float* vd = v_s + r * 128 + c4;
              qd[0] = bflo(a.x); qd[1] = bfhi(a.x); qd[2] = bflo(a.y); qd[3] = bfhi(a.y);
              gd[0] = __expf(bflo(l.x)); gd[1] = __expf(bfhi(l.x)); gd[2] = __expf(bflo(l.y)); gd[3] = __expf(bfhi(l.y));
              vd[0] = bflo(i2.x); vd[1] = bfhi(i2.x); vd[2] = bflo(i2.y); vd[3] = bfhi(i2.y); }
            __syncthreads();
            for (int s = 0; s < 16; ++s) {
                const float vval = v_s[s * 128 + vv]; float acc = 0.f;
#pragma unroll
                for (int i = 0; i < 32; ++i) { const float gk = g_s[s * 128 + kq * 32 + i]; S[i] = gk * S[i] + (1.0f - gk) * vval; acc += q_s[s * 128 + kq * 32 + i] * S[i]; }
                part[(s * 4 + kq) * 128 + vv] = acc;
            }
            __syncthreads();
#pragma unroll
            for (int ss = 0; ss < 2; ++ss) { const int s = wave * 2 + ss; const int t = t0 + s;
                float o0 = 0.f, o1 = 0.f;
#pragma unroll
                for (int k = 0; k < 4; ++k) { o0 += part[(s * 4 + k) * 128 + lane]; o1 += part[(s * 4 + k) * 128 + 64 + lane]; }
                const float ssq = wave_sum(o0 * o0 + o1 * o1); const float rs = rsqrtf(ssq * (1.0f / HGD) + EPS);
                const size_t off = base + (size_t)t * DM;
                const float y0 = o0 * rs * gnorm[h * HGD + lane] * bfu2f(P3[off + lane]), y1 = o1 * rs * gnorm[h * HGD + 64 + lane] * bfu2f(P3[off + 64 + lane]);
                P0[off + lane] = (bf16)f2bf(y0); P0[off + 64 + lane] = (bf16)f2bf(y1); }
        }
    }
}

__device__ __forceinline__ void final_norm(float* X, const float* gfin) {
    const int tid = opaque_tid(), lane = tid & 63, gw = blockIdx.x * NWAVES + __builtin_amdgcn_readfirstlane(tid >> 6), NGW = gridDim.x * NWAVES;
    for (int m = gw; m < TT; m += NGW) {
        GAS f32x4* xr = (GAS f32x4*)(X + (size_t)m * DM) + lane; f32x4 v[4]; float s = 0.f;
#pragma unroll
        for (int j = 0; j < 4; ++j) { v[j] = xr[64 * j]; s += (v[j].x * v[j].x + v[j].y * v[j].y) + (v[j].z * v[j].z + v[j].w * v[j].w); }
        s = wave_sum(s); const float rs = rsqrtf(s * (1.0f / DM) + EPS);
#pragma unroll
        for (int j = 0; j < 4; ++j) { const f32x4 g = *((const f32x4*)gfin + lane + 64 * j); xr[64 * j] = v[j] * rs * g; }
    }
}

#ifndef MK_NAIVE_GEMM
#define MK_NAIVE_GEMM 1
#endif
#if MK_NAIVE_GEMM
#define RUN_GEMM(EPI_T, g_, S_, E_) pg8::gemm_phase_naive<EPI_T, pg8::StaticOrder>(g_, S_, E_)
#else
#define RUN_GEMM(EPI_T, g_, S_, E_) pg8::gemm_phase<EPI_T, pg8::StaticOrder, true, true>(lds + RING_OFF, g_, S_, E_)
#endif

__global__ void __launch_bounds__(NWAVES * 64, 2) mk_fwd(Params p) {
    extern __shared__ __attribute__((aligned(16))) unsigned char lds_raw[];
    LAS unsigned char* lds = (LAS unsigned char*)lds_raw;
    volatile LAS unsigned* MISC = (volatile LAS unsigned*)(lds + MISC_OFF);
    const int tid = threadIdx.x;
    const int G = gridDim.x, bid = blockIdx.x;
    unsigned char* ws = p.ws;
    gu32* ctl = (gu32*)(ws + WS_CTL);
    for (int u = tid; u < (LDS_BYTES - LDSCTL_OFF) / 4; u += NWAVES * 64) ((LAS unsigned*)(lds + LDSCTL_OFF))[u] = 0u;
    __syncthreads();
    XcdBarrier bar = xcd_barrier_post((unsigned*)(ctl + CW_BAR), MISC + 8);
#define GRID_BAR() xcd_barrier(bar)

    float* X = p.out;
    float* SSQ = (float*)(ws + WS_SSQ);
    pg8::bf16_t* XB = (pg8::bf16_t*)(ws + WS_XB);
    pg8::bf16_t* P0 = (pg8::bf16_t*)(ws + WS_P), *P1 = (pg8::bf16_t*)(ws + WS_P + SZ_P), *P2 = (pg8::bf16_t*)(ws + WS_P + 2 * SZ_P), *P3 = (pg8::bf16_t*)(ws + WS_P + 3 * SZ_P);
    pg8::bf16_t* HB = P0;

    p0_prologue(p, lds);
    GRID_BAR();

#pragma unroll 1
    for (int l = 0; l < 2; ++l) {
        pg8::Gemm g{(const pg8::bf16_t*)(ws + WS_MEMB), (const pg8::bf16_t*)(ws + WS_WKV + l * SZ_WKV), TMEM, 2048, 1024}; pg8::StaticOrder S; S.init(TMEM, 2048, G, bid);
        pg8::EpiScale E{(pg8::bf16_t*)(ws + WS_KV + l * SZ_KV), 2048, nullptr, (const float*)(ws + WS_RMEM), 1.0f};
        RUN_GEMM(pg8::EpiScale, g, S, E);
    }

#pragma unroll 1
    for (int l = 0; l < 2; ++l) {
        const float* xin = (l == 0) ? p.in[0] : X;
        if (l == 0) {
            { pg8::Gemm g{XB, (const pg8::bf16_t*)(ws + WS_WCIN), TT, 3072, 1024}; pg8::StaticOrder S; S.init(TT, 3072, G, bid);
              pg8::EpiPair<0> E{P0, 1024, P1, SSQ};
              RUN_GEMM(pg8::EpiPair<0>, g, S, E); }
            GRID_BAR();
            conv_pass(P0, P1, p.in[4], P2);
            GRID_BAR();
            { pg8::Gemm g{P2, (const pg8::bf16_t*)(ws + WS_WCOUT), TT, 1024, 1024}; pg8::StaticOrder S; S.init(TT, 1024, G, bid);
              pg8::EpiResid E{xin, X, XB, SSQ};
              RUN_GEMM(pg8::EpiResid, g, S, E); }
            GRID_BAR();
        } else {
            { pg8::Gemm g{XB, (const pg8::bf16_t*)(ws + WS_WHIN), TT, 4096, 1024}; pg8::StaticOrder S; S.init(TT, 4096, G, bid);
              pg8::EpiHgrn E{P0, (size_t)TT * DM, SSQ, (const float*)(ws + WS_LB)};
              RUN_GEMM(pg8::EpiHgrn, g, S, E); }
            GRID_BAR();
            scan_naive(P0, P1, P2, P3, p.in[8], lds_raw, G);
            GRID_BAR();
            { pg8::Gemm g{P0, (const pg8::bf16_t*)(ws + WS_WHOUT), TT, 1024, 1024}; pg8::StaticOrder S; S.init(TT, 1024, G, bid);
              pg8::EpiResid E{xin, X, XB, SSQ};
              RUN_GEMM(pg8::EpiResid, g, S, E); }
            GRID_BAR();
        }
        { pg8::Gemm g{XB, (const pg8::bf16_t*)(ws + WS_WQ + l * SZ_WQ), TT, 1024, 1024}; pg8::StaticOrder S; S.init(TT, 1024, G, bid);
          pg8::EpiScale E{P0, 1024, SSQ, nullptr, QSCALE};
          RUN_GEMM(pg8::EpiScale, g, S, E); }
        GRID_BAR();
        attn_naive(P0, (const bf16*)(ws + WS_KV + l * SZ_KV), P1);
        GRID_BAR();
        { pg8::Gemm g{P1, (const pg8::bf16_t*)(ws + WS_WO + l * SZ_WO), TT, 1024, 1024}; pg8::StaticOrder S; S.init(TT, 1024, G, bid);
          pg8::EpiResid E{X, X, XB, SSQ};
          RUN_GEMM(pg8::EpiResid, g, S, E); }
        GRID_BAR();
        { pg8::Gemm g{XB, (const pg8::bf16_t*)(ws + WS_WFIN + l * SZ_WFIN), TT, 2 * DFF, 1024}; pg8::StaticOrder S; S.init(TT, 2 * DFF, G, bid);
          pg8::EpiPair<1> E{HB, DFF, nullptr, SSQ};
          RUN_GEMM(pg8::EpiPair<1>, g, S, E); }
        GRID_BAR();
        { pg8::Gemm g{HB, (const pg8::bf16_t*)(ws + WS_WFOUT + l * SZ_WFOUT), TT, 1024, DFF}; pg8::StaticOrder S; S.init(TT, 1024, G, bid);
          pg8::EpiResid E{X, X, XB, SSQ};
          RUN_GEMM(pg8::EpiResid, g, S, E); }
        GRID_BAR();
    }
    final_norm(X, p.in[18]);
}

extern "C" void kernel_launch(void* const* d_in, const int* in_sizes, int n_in, void* d_out, int out_size, void* d_ws, size_t ws_size, hipStream_t stream) {
    static int grid = 0;
    if (grid == 0) {
        if (n_in != 19 || out_size != TT * DM || ws_size < WS_END) { fprintf(stderr, "kernel_launch: unexpected shapes (n_in %d, out %d, ws %zu); nothing launched\n", n_in, out_size, ws_size); grid = -1; return; }
        int dev = 0, cus = 0, per_cu = 0;
        if (hipGetDevice(&dev) != hipSuccess || hipDeviceGetAttribute(&cus, hipDeviceAttributeMultiprocessorCount, dev) != hipSuccess) { fprintf(stderr, "kernel_launch: device query failed\n"); grid = -1; return; }
        if (hipFuncSetAttribute((const void*)mk_fwd, hipFuncAttributeMaxDynamicSharedMemorySize, LDS_BYTES) != hipSuccess) { fprintf(stderr, "kernel_launch: hipFuncSetAttribute failed\n"); grid = -1; return; }
        if (hipOccupancyMaxActiveBlocksPerMultiprocessor(&per_cu, (const void*)mk_fwd, NWAVES * 64, LDS_BYTES) != hipSuccess || per_cu < 1) { fprintf(stderr, "kernel_launch: occupancy query says %d blocks per CU\n", per_cu); per_cu = 1; }
        (void)hipGetLastError();
        grid = cus;
    }
    if (grid < 0) return;
    if (hipMemsetAsync((char*)d_ws + WS_CTL, 0, CTL_ZERO_BYTES, stream) != hipSuccess) { fprintf(stderr, "kernel_launch: memset failed\n"); return; }
    Params a{};
    for (int i = 0; i < 19; ++i) a.in[i] = (const float*)d_in[i];
    a.out = (float*)d_out; a.ws = (unsigned char*)d_ws;
    hipLaunchKernelGGL(mk_fwd, dim3(grid), dim3(NWAVES * 64), LDS_BYTES, stream, a);
    const hipError_t le = hipPeekAtLastError();
    if (le != hipSuccess) fprintf(stderr, "kernel_launch: launch failed: %s\n", hipGetErrorName(le));
}
```

```cpp
#define MK_NAIVE_GEMM 0
#include <hip/hip_runtime.h>
#include <cstdio>
#include <cstdint>
namespace pg8 {
#define PG8_LAS __attribute__((address_space(3)))
typedef unsigned short bf16_t;
typedef short bf16x8 __attribute__((ext_vector_type(8)));
typedef float f32x4 __attribute__((ext_vector_type(4)));
typedef unsigned u32x4 __attribute__((ext_vector_type(4)));
constexpr int BM = 256, BK = 64, HALF = 128, HTB = HALF * BK * 2  , STAGE_BYTES = 8 * HTB, NXCD = 8, WGM = 8;

__host__ __device__ __forceinline__ int lds_byte(int r, int c) { const int st = (r >> 4) * 2 + (c >> 5), rr = r & 15, cc = c & 31, ob = rr * 64 + cc * 2; return st * 1024 + (ob ^ (((ob >> 9) & 1) << 5)); }
__host__ __device__ __forceinline__ void stage_rc(int b, int& R, int& C) { const int st = b / 1024, sb = b % 1024, swz = sb ^ (((sb >> 9) & 1) << 5); R = (st >> 1) * 16 + swz / 64; C = (st & 1) * 32 + (swz % 64) / 2; }
__host__ __device__ __forceinline__ int perm32(int rho) { const int n = rho >> 4, i = rho & 15; return 8 * (i >> 2) + 4 * n + (i & 3); }

struct Unit { int pm, pn; };
struct Gemm { const bf16_t* A; const bf16_t* Bt; int M, N, K; int lda; size_t kstepA; int ldb; size_t kstepB; };

struct StaticOrder {
    int nM, nN, nwg, G, c;
    __host__ __device__ void init(int M, int N, int G_, int c_) { nM = M / BM; nN = N / BM; nwg = nM * nN; G = G_; c = c_; }
    __host__ __device__ bool next(int i, Unit& u) const {
        const long L = (long)i * G + c; if (L >= nwg) return false;
        int wgid = (int)L; { const int q = nwg / NXCD, r = nwg % NXCD, xcd = wgid % NXCD, off = wgid / NXCD; wgid = (xcd < r ? xcd * (q + 1) : r * (q + 1) + (xcd - r) * q) + off; }
        const int nig = WGM * nN, gid = wgid / nig, fm = gid * WGM, gsz = (nM - fm) < WGM ? (nM - fm) : WGM;
        u.pm = fm + ((wgid % nig) % gsz); u.pn = (wgid % nig) / gsz; return true;
    }
    __device__ __forceinline__ void a_ready(const Unit&) const {}
    __device__ __forceinline__ void done(const Unit&) const {}
};

typedef float f32x2_cv __attribute__((ext_vector_type(2))); typedef __bf16 bf16x2_cv __attribute__((ext_vector_type(2)));
__device__ __forceinline__ unsigned cvt_pk_bf16(float lo, float hi) { f32x2_cv v = {lo, hi}; bf16x2_cv b = __builtin_convertvector(v, bf16x2_cv); return __builtin_bit_cast(unsigned, b); }
__device__ __forceinline__ float xor16_get(float x) { return __int_as_float(__builtin_amdgcn_ds_swizzle(__float_as_int(x), 0x401F)); }
__device__ __forceinline__ float xor32_sum(float x) { const auto rr = __builtin_amdgcn_permlane32_swap(__float_as_uint(x), __float_as_uint(x), false, false); return __uint_as_float(rr[0]) + __uint_as_float(rr[1]); }
__device__ __forceinline__ float xor32_max(float x) { const auto rr = __builtin_amdgcn_permlane32_swap(__float_as_uint(x), __float_as_uint(x), false, false); return fmaxf(__uint_as_float(rr[0]), __uint_as_float(rr[1])); }
__device__ __forceinline__ float lane_get(float x, int srclane) { return __int_as_float(__builtin_amdgcn_ds_bpermute(srclane << 2, __float_as_int(x))); }
typedef unsigned u32x2 __attribute__((ext_vector_type(2)));
constexpr int TT_ROWS = 32768;
__device__ __forceinline__ void rs_rows(const float* ssq, const float* rdirect, int rowbase, int lane, float (&v)[2]) {
#pragma unroll
    for (int ai = 0; ai < 2; ++ai) {
        const int row = rowbase + ai * HALF + lane;
        if (rdirect) v[ai] = rdirect[row];
        else { const f32x4* sp = (const f32x4*)(ssq + (size_t)row * 16);
            const f32x4 s0 = sp[0], s1 = sp[1], s2 = sp[2], s3 = sp[3];
            const float s = (((s0[0] + s0[1]) + (s0[2] + s0[3])) + ((s1[0] + s1[1]) + (s1[2] + s1[3]))) + (((s2[0] + s2[1]) + (s2[2] + s2[3])) + ((s3[0] + s3[1]) + (s3[2] + s3[3])));
            v[ai] = rsqrtf(s * (1.0f / 1024.0f) + 1e-6f); }
    }
}
__device__ __forceinline__ float sigm_f(float x) { return __builtin_amdgcn_rcpf(1.0f + __builtin_amdgcn_exp2f(x * -1.4426950408889634f)); }
__device__ __forceinline__ float silu_f(float x) { return x * sigm_f(x); }
__device__ __forceinline__ u32x4 pack8(const f32x4 v0, const f32x4 v1) { u32x4 w; w.x = cvt_pk_bf16(v0[0], v0[1]); w.y = cvt_pk_bf16(v0[2], v0[3]); w.z = cvt_pk_bf16(v1[0], v1[1]); w.w = cvt_pk_bf16(v1[2], v1[3]); return w; }

template <int MODE> struct EpiPair {
    static constexpr bool PERM = true, AFTER_DRAIN = false;
    bf16_t* OUT; int ldo; bf16_t* GB; const float* ssq;
    __device__ __forceinline__ void operator()(const f32x4 (&acc)[2][2][4][2], const Unit& u, int wr, int wc, int fr, int fq) const {
        const int row0 = u.pm * BM + wr * 64 + fr;
        float rsv[2]; rs_rows(ssq, nullptr, u.pm * BM + wr * 64, fq * 16 + fr, rsv);
        if (MODE == 0 && u.pn >= 8) {
            const int col0 = (u.pn - 8) * 256 + wc * 32 + 8 * fq;
#pragma unroll
            for (int ai = 0; ai < 2; ++ai)
#pragma unroll
                for (int m = 0; m < 4; ++m) { const int row = row0 + ai * HALF + m * 16; const float rs = lane_get(rsv[ai], 16 * m + fr); bf16_t* rowp = GB + (size_t)row * 1024 + col0;
#pragma unroll
                    for (int bj = 0; bj < 2; ++bj) *(u32x4*)(rowp + bj * HALF) = pack8(acc[ai][bj][m][0] * rs, acc[ai][bj][m][1] * rs); }
        } else {
            const int col0 = u.pn * 128 + wc * 32 + 8 * fq;
#if MK_EPI_REP
#pragma unroll 1
            for (int rep_ = 0; rep_ < (MODE == 1 ? 2 : 1); ++rep_)
#endif
#pragma unroll
            for (int ai = 0; ai < 2; ++ai)
#pragma unroll
                for (int m = 0; m < 4; ++m) { const int row = row0 + ai * HALF + m * 16; const float rs = lane_get(rsv[ai], 16 * m + fr);
                    const f32x4 a0 = acc[ai][0][m][0] * rs, a1 = acc[ai][0][m][1] * rs, b0 = acc[ai][1][m][0] * rs, b1 = acc[ai][1][m][1] * rs; f32x4 v0, v1;
                    if (MODE == 0) { v0 = a0 * b0; v1 = a1 * b1; }
                    else {
#pragma unroll
                        for (int j = 0; j < 4; ++j) { v0[j] = silu_f(a0[j]) * b0[j]; v1[j] = silu_f(a1[j]) * b1[j]; } }
                    if (MODE == 1) {
                        const int kt = 2 * u.pn + (wc >> 1), within = (wc & 1) * 32 + 8 * fq;
                        *(u32x4*)(OUT + ((size_t)kt * TT_ROWS + row) * 64 + within) = pack8(v0, v1);
                    } else *(u32x4*)(OUT + (size_t)row * ldo + col0) = pack8(v0, v1); }
        }
    }
};
struct EpiResid {
    static constexpr bool PERM = true, AFTER_DRAIN = false;
    bf16_t* xb; float* ssq; float sc;
    __device__ __forceinline__ void operator()(const f32x4 (&acc)[2][2][4][2], const Unit& u, int wr, int wc, int fr, int fq) const {
        const int row0 = u.pm * BM + wr * 64 + fr;
        bf16_t* rp[2]; u32x4 bres[2][4][2];
#pragma unroll
        for (int bj = 0; bj < 2; ++bj) rp[bj] = xb + ((size_t)(4 * u.pn + 2 * bj + (wc >> 1)) * TT_ROWS + row0) * 64 + (wc & 1) * 32 + 8 * fq;
#pragma unroll
        for (int ai = 0; ai < 2; ++ai)
#pragma unroll
            for (int m = 0; m < 4; ++m)
#pragma unroll
                for (int bj = 0; bj < 2; ++bj) bres[ai][m][bj] = *(const u32x4*)(rp[bj] + (size_t)(ai * HALF + m * 16) * 64);
#pragma unroll
        for (int ai = 0; ai < 2; ++ai)
#pragma unroll
            for (int m = 0; m < 4; ++m) { const int row = row0 + ai * HALF + m * 16; float sq = 0.f;
#pragma unroll
                for (int bj = 0; bj < 2; ++bj) { const u32x4 b = bres[ai][m][bj];
                    f32x4 o0 = acc[ai][bj][m][0] * sc, o1 = acc[ai][bj][m][1] * sc;
                    o0[0] += __uint_as_float(b.x << 16); o0[1] += __uint_as_float(b.x & 0xffff0000u); o0[2] += __uint_as_float(b.y << 16); o0[3] += __uint_as_float(b.y & 0xffff0000u);
                    o1[0] += __uint_as_float(b.z << 16); o1[1] += __uint_as_float(b.z & 0xffff0000u); o1[2] += __uint_as_float(b.w << 16); o1[3] += __uint_as_float(b.w & 0xffff0000u);
                    const u32x4 w = pack8(o0, o1); *(u32x4*)(rp[bj] + (size_t)(ai * HALF + m * 16) * 64) = w;
                    const float r0 = __uint_as_float(w.x << 16), r1 = __uint_as_float(w.x & 0xffff0000u), r2 = __uint_as_float(w.y << 16), r3 = __uint_as_float(w.y & 0xffff0000u);
                    const float r4 = __uint_as_float(w.z << 16), r5 = __uint_as_float(w.z & 0xffff0000u), r6 = __uint_as_float(w.w << 16), r7 = __uint_as_float(w.w & 0xffff0000u);
                    sq += ((r0 * r0 + r1 * r1) + (r2 * r2 + r3 * r3)) + ((r4 * r4 + r5 * r5) + (r6 * r6 + r7 * r7)); }
                sq += xor16_get(sq); sq = xor32_sum(sq);
                if (fq == 0) ssq[(size_t)row * 16 + (u.pn * 4 + wc)] = sq; }
    }
};
struct EpiScale {
    static constexpr bool PERM = true, AFTER_DRAIN = false;
    bf16_t* O; int ldc; const float* ssq; const float* rdirect; float scale;
    __device__ __forceinline__ void operator()(const f32x4 (&acc)[2][2][4][2], const Unit& u, int wr, int wc, int fr, int fq) const {
        const int row0 = u.pm * BM + wr * 64 + fr, col0 = u.pn * BM + wc * 32 + 8 * fq;
        float rsv[2]; rs_rows(ssq, rdirect, u.pm * BM + wr * 64, fq * 16 + fr, rsv);
#pragma unroll
        for (int ai = 0; ai < 2; ++ai)
#pragma unroll
            for (int m = 0; m < 4; ++m) { const int row = row0 + ai * HALF + m * 16; const float rs = lane_get(rsv[ai], 16 * m + fr) * scale; bf16_t* rowp = O + (size_t)row * ldc + col0;
#pragma unroll
                for (int bj = 0; bj < 2; ++bj) *(u32x4*)(rowp + bj * HALF) = pack8(acc[ai][bj][m][0] * rs, acc[ai][bj][m][1] * rs); }
    }
};
struct EpiHgrn {
    static constexpr bool PERM = true, AFTER_DRAIN = false;
    bf16_t* P; size_t pstride; const float* ssq; const float* lb;
    __device__ __forceinline__ void operator()(const f32x4 (&acc)[2][2][4][2], const Unit& u, int wr, int wc, int fr, int fq) const {
        const int row0 = u.pm * BM + wr * 64 + fr, type = u.pn >> 2, col0 = (u.pn & 3) * BM + wc * 32 + 8 * fq;
        const int bb = u.pm >> 3, t0 = (u.pm & 7) * BM + wr * 64 + fr;
        bf16_t* base = P + (size_t)type * pstride + ((size_t)(bb * 8 + (u.pn & 3) * 2) * 2048 + t0) * 128 + wc * 32 + 8 * fq;
        float rsv[2]; rs_rows(ssq, nullptr, u.pm * BM + wr * 64, fq * 16 + fr, rsv);
        if (type == 1) {
#pragma unroll
            for (int bj = 0; bj < 2; ++bj) {
                const f32x4 l0 = *(const f32x4*)(lb + col0 + bj * HALF), l1 = *(const f32x4*)(lb + col0 + bj * HALF + 4);
#pragma unroll
                for (int ai = 0; ai < 2; ++ai)
#pragma unroll
                    for (int m = 0; m < 4; ++m) { const float rs = lane_get(rsv[ai], 16 * m + fr); f32x4 v0, v1;
#pragma unroll
                        for (int j = 0; j < 4; ++j) { const float s0 = sigm_f(acc[ai][bj][m][0][j] * rs), s1 = sigm_f(acc[ai][bj][m][1][j] * rs);
                            v0[j] = __log2f(l0[j] + (1.0f - l0[j]) * s0); v1[j] = __log2f(l1[j] + (1.0f - l1[j]) * s1); }
                        *(u32x4*)(base + (size_t)(ai * HALF + m * 16) * 128 + (size_t)bj * (2048 * 128)) = pack8(v0, v1); }
            }
        } else if (type == 2) {
#pragma unroll
            for (int ai = 0; ai < 2; ++ai)
#pragma unroll
                for (int m = 0; m < 4; ++m) { const float rs = lane_get(rsv[ai], 16 * m + fr);
#pragma unroll
                    for (int bj = 0; bj < 2; ++bj) *(u32x4*)(base + (size_t)(ai * HALF + m * 16) * 128 + (size_t)bj * (2048 * 128)) = pack8(acc[ai][bj][m][0] * rs, acc[ai][bj][m][1] * rs); }
        } else {
#pragma unroll
            for (int ai = 0; ai < 2; ++ai)
#pragma unroll
                for (int m = 0; m < 4; ++m) { const float rs = lane_get(rsv[ai], 16 * m + fr);
#pragma unroll
                    for (int bj = 0; bj < 2; ++bj) { f32x4 v0, v1;
#pragma unroll
                        for (int j = 0; j < 4; ++j) { v0[j] = silu_f(acc[ai][bj][m][0][j] * rs); v1[j] = silu_f(acc[ai][bj][m][1][j] * rs); }
                        *(u32x4*)(base + (size_t)(ai * HALF + m * 16) * 128 + (size_t)bj * (2048 * 128)) = pack8(v0, v1); } }
        }
    }
};
struct EpiColScale {
    static constexpr bool PERM = true, AFTER_DRAIN = false;
    bf16_t* O; int ldc; const float* cs;
    __device__ __forceinline__ void operator()(const f32x4 (&acc)[2][2][4][2], const Unit& u, int wr, int wc, int fr, int fq) const {
        const int row0 = u.pm * BM + wr * 64 + fr, col0 = u.pn * BM + wc * 32 + 8 * fq;
#pragma unroll
        for (int bj = 0; bj < 2; ++bj) { const f32x4 c0 = *(const f32x4*)(cs + col0 + bj * HALF), c1 = *(const f32x4*)(cs + col0 + bj * HALF + 4);
#pragma unroll
            for (int ai = 0; ai < 2; ++ai)
#pragma unroll
                for (int m = 0; m < 4; ++m) *(u32x4*)(O + (size_t)(row0 + ai * HALF + m * 16) * ldc + col0 + bj * HALF) = pack8(acc[ai][bj][m][0] * c0, acc[ai][bj][m][1] * c1); }
    }
};
template <class Epi, class Sched, bool ALIGN_EPI = false, bool SP2 = false>
__device__ __forceinline__ void gemm_phase(PG8_LAS unsigned char* lds, const Gemm g, const Sched& S, const Epi& E, const int wave_s) {
    unsigned z_ = 0u; asm volatile("" : "+v"(z_));
    int tid_ = (wave_s << 6) | (int)__builtin_amdgcn_mbcnt_hi(~0u, __builtin_amdgcn_mbcnt_lo(~0u, z_)); asm volatile("" : "+v"(tid_));
    const int tid = tid_, wid = __builtin_amdgcn_readfirstlane(tid >> 6), lane = tid & 63, wr = wid >> 2, wc = wid & 3, fr = lane & 15, fq = lane >> 4;
    const int K = g.K, nt = K / BK;
    const int lda = g.lda ? g.lda : K, ldb = g.ldb ? g.ldb : K;
    unsigned voffA[2], voffB[2];
#pragma unroll
    for (int i = 0; i < 2; ++i) { int R, C; stage_rc(tid * 16 + i * 8192, R, C); const int Rb = Epi::PERM ? ((R & ~31) + perm32(R & 31)) : R;
        voffA[i] = (unsigned)(R * lda + C) * 2u; voffB[i] = (unsigned)(Rb * ldb + C) * 2u; }
    const size_t kstep = (size_t)(BK * 2);
    const size_t kstepA = g.kstepA ? g.kstepA : kstep, hstepA = (size_t)HALF * lda * 2, tstepA = 2 * hstepA;
    const size_t hstep = (size_t)HALF * ldb * 2;
    const size_t kstepB = g.kstepB ? g.kstepB : kstep;
    const size_t tstep = 2 * hstep;
    const unsigned ldsw = (unsigned)wid * 1024u;
    const int aoff = lds_byte(wr * 64 + fr, fq * 8), boff = lds_byte(wc * 32 + fr, fq * 8);
#define PG8_SA(b, h) (((b) * 2 + (h)) * HTB)
#define PG8_SB(b, h) ((4 + (b) * 2 + (h)) * HTB)
#define PG8_STAGE(bufoff, gbase, voff) do { _Pragma("unroll") for (int _i = 0; _i < 2; ++_i) \
        __builtin_amdgcn_global_load_lds((const unsigned*)((const char*)(gbase) + (voff)[_i]), (PG8_LAS unsigned*)(lds + (bufoff) + ldsw + _i * 8192), 16, 0, 0); } while (0)
#define PG8_LDA(dst, b, h) do { _Pragma("unroll") for (int m = 0; m < 4; ++m) _Pragma("unroll") for (int k = 0; k < 2; ++k) dst[m][k] = *(const PG8_LAS bf16x8*)(lds + PG8_SA(b, h) + aoff + m * 2048 + k * 1024); } while (0)
#define PG8_LDB(dst, b, h) do { _Pragma("unroll") for (int n = 0; n < 2; ++n) _Pragma("unroll") for (int k = 0; k < 2; ++k) dst[n][k] = *(const PG8_LAS bf16x8*)(lds + PG8_SB(b, h) + boff + n * 2048 + k * 1024); } while (0)
#define PG8_MMA(ai, bj, At, Bt) do { __builtin_amdgcn_s_setprio(1); _Pragma("unroll") for (int m = 0; m < 4; ++m) _Pragma("unroll") for (int n = 0; n < 2; ++n) _Pragma("unroll") for (int k = 0; k < 2; ++k) \
        acc[ai][bj][m][n] = __builtin_amdgcn_mfma_f32_16x16x32_bf16(Bt[n][k], At[m][k], acc[ai][bj][m][n], 0, 0, 0); __builtin_amdgcn_s_setprio(0); } while (0)
#define PG8_WAIT_V(n) asm volatile("s_waitcnt vmcnt(" #n ")" ::: "memory")
#define PG8_WAIT_L(n) asm volatile("s_waitcnt lgkmcnt(" #n ")" ::: "memory")
#define PG8_BAR __builtin_amdgcn_s_barrier()
#define PG8_SCHED __builtin_amdgcn_sched_barrier(0)
    Unit cur, nxt; int ui = 0;
    if (!S.next(0, cur)) return;
    f32x4 acc[2][2][4][2];
#pragma unroll
    for (int a = 0; a < 2; ++a)
#pragma unroll
        for (int b = 0; b < 2; ++b)
#pragma unroll
            for (int m = 0; m < 4; ++m)
#pragma unroll
                for (int n = 0; n < 2; ++n) acc[a][b][m][n] = (f32x4){0.f, 0.f, 0.f, 0.f};
    bf16x8 At[4][2], B0[2][2], B1[2][2];
    const char* cA = (const char*)g.A + (size_t)cur.pm * tstepA; const char* cB = (const char*)g.Bt + (size_t)cur.pn * tstep;
    S.a_ready(cur);
    if constexpr (SP2) {
        PG8_STAGE(PG8_SB(0, 0), cB, voffB); PG8_STAGE(PG8_SB(0, 1), cB + hstep, voffB); PG8_STAGE(PG8_SA(0, 0), cA, voffA); PG8_STAGE(PG8_SA(0, 1), cA + hstepA, voffA);
        if (wr == 1) PG8_BAR;
        PG8_WAIT_V(2); PG8_BAR;
        PG8_STAGE(PG8_SB(1, 0), cB + kstepB, voffB); PG8_STAGE(PG8_SA(1, 0), cA + kstepA, voffA); PG8_STAGE(PG8_SB(1, 1), cB + hstep + kstepB, voffB);
        PG8_WAIT_V(6); PG8_BAR;
    } else {
        PG8_STAGE(PG8_SB(0, 0), cB, voffB); PG8_STAGE(PG8_SA(0, 0), cA, voffA); PG8_STAGE(PG8_SB(0, 1), cB + hstep, voffB); PG8_STAGE(PG8_SA(0, 1), cA + hstepA, voffA);
        if (wr == 1) PG8_BAR;
        PG8_WAIT_V(4); PG8_BAR;
        PG8_STAGE(PG8_SB(1, 0), cB + kstepB, voffB); PG8_STAGE(PG8_SA(1, 0), cA + kstepA, voffA); PG8_STAGE(PG8_SB(1, 1), cB + hstep + kstepB, voffB);
        PG8_WAIT_V(6); PG8_BAR;
    }
    for (;;) {
        const bool has_next = S.next(ui + 1, nxt);
        const char* nA = has_next ? (const char*)g.A + (size_t)nxt.pm * tstepA : cA; const char* nB = has_next ? (const char*)g.Bt + (size_t)nxt.pn * tstep : cB;
        for (int t = 0; t < nt; t += 2) {
            const bool last = (t == nt - 2);
            const char* a1 = cA + (size_t)(t + 1) * kstepA;
            const char* a2 = last ? nA : cA + (size_t)(t + 2) * kstepA; const char* b2 = last ? nB : cB + (size_t)(t + 2) * kstepB;
            const char* a3 = a2 + kstepA; const char* b3 = b2 + kstepB;
            if (last && has_next) S.a_ready(nxt);
            if constexpr (SP2) {
            PG8_LDB(B0, 0, 0); PG8_LDB(B1, 0, 1); PG8_SCHED; PG8_LDA(At, 0, 0); PG8_STAGE(PG8_SA(1, 1), a1 + hstepA, voffA);
            PG8_WAIT_V(8); PG8_WAIT_L(0); PG8_BAR; PG8_MMA(0, 0, At, B0); PG8_MMA(0, 1, At, B1); PG8_BAR; PG8_SCHED;
            PG8_LDA(At, 0, 1); PG8_STAGE(PG8_SB(0, 0), b2, voffB); PG8_STAGE(PG8_SB(0, 1), b2 + hstep, voffB); PG8_STAGE(PG8_SA(0, 0), a2, voffA);
            PG8_WAIT_V(8); PG8_WAIT_L(0); PG8_BAR; PG8_MMA(1, 0, At, B0); PG8_MMA(1, 1, At, B1); PG8_BAR; PG8_SCHED;
            PG8_LDB(B0, 1, 0); PG8_LDB(B1, 1, 1); PG8_SCHED; PG8_LDA(At, 1, 0); PG8_STAGE(PG8_SA(0, 1), a2 + hstepA, voffA);
            PG8_WAIT_V(8); PG8_WAIT_L(0); PG8_BAR; PG8_MMA(0, 0, At, B0); PG8_MMA(0, 1, At, B1); PG8_BAR; PG8_SCHED;
            PG8_LDA(At, 1, 1); PG8_STAGE(PG8_SB(1, 0), b3, voffB); PG8_STAGE(PG8_SB(1, 1), b3 + hstep, voffB); PG8_STAGE(PG8_SA(1, 0), a3, voffA);
            PG8_WAIT_V(8); PG8_WAIT_L(0); PG8_BAR; PG8_MMA(1, 0, At, B0); PG8_MMA(1, 1, At, B1); PG8_BAR; PG8_SCHED;
            } else {
            PG8_LDB(B0, 0, 0); PG8_SCHED; PG8_LDA(At, 0, 0); PG8_STAGE(PG8_SA(1, 1), a1 + hstepA, voffA);
            PG8_WAIT_L(8); PG8_BAR; PG8_WAIT_L(0); PG8_MMA(0, 0, At, B0); PG8_BAR; PG8_SCHED;
            PG8_LDB(B1, 0, 1); PG8_STAGE(PG8_SB(0, 0), b2, voffB);
            PG8_BAR; PG8_WAIT_L(0); PG8_MMA(0, 1, At, B1); PG8_BAR;
            PG8_LDA(At, 0, 1); PG8_STAGE(PG8_SA(0, 0), a2, voffA);
            PG8_BAR; PG8_WAIT_L(0); PG8_MMA(1, 0, At, B0); PG8_BAR; PG8_SCHED;
            PG8_STAGE(PG8_SB(0, 1), b2 + hstep, voffB);
            PG8_WAIT_V(6); PG8_BAR; PG8_MMA(1, 1, At, B1); PG8_BAR;
            PG8_LDB(B0, 1, 0); PG8_SCHED; PG8_LDA(At, 1, 0); PG8_STAGE(PG8_SA(0, 1), a2 + hstepA, voffA);
            PG8_WAIT_L(8); PG8_BAR; PG8_WAIT_L(0); PG8_MMA(0, 0, At, B0); PG8_BAR; PG8_SCHED;
            PG8_LDB(B1, 1, 1); PG8_STAGE(PG8_SB(1, 0), b3, voffB);
            PG8_BAR; PG8_WAIT_L(0); PG8_MMA(0, 1, At, B1); PG8_BAR;
            PG8_LDA(At, 1, 1); PG8_STAGE(PG8_SA(1, 0), a3, voffA);
            PG8_BAR; PG8_WAIT_L(0); PG8_MMA(1, 0, At, B0); PG8_BAR; PG8_SCHED;
            PG8_STAGE(PG8_SB(1, 1), b3 + hstep, voffB);
            PG8_WAIT_V(6); PG8_BAR; PG8_MMA(1, 1, At, B1); PG8_BAR;
            }
        }
        if constexpr (ALIGN_EPI) { if (wr == 0) PG8_BAR; }
        if constexpr (!Epi::AFTER_DRAIN) { Unit eu = cur; asm volatile("" : "+s"(eu.pm), "+s"(eu.pn));
            E(acc, eu, wr, wc, fr, fq); S.done(cur); }
        if (!has_next) break;
#pragma unroll
        for (int a = 0; a < 2; ++a)
#pragma unroll
            for (int b = 0; b < 2; ++b)
#pragma unroll
                for (int m = 0; m < 4; ++m)
#pragma unroll
                    for (int n = 0; n < 2; ++n) acc[a][b][m][n] = (f32x4){0.f, 0.f, 0.f, 0.f};
        cur = nxt; cA = nA; cB = nB; ++ui;
        if constexpr (ALIGN_EPI) { if (wr == 1) PG8_BAR; }
    }
    PG8_WAIT_V(0);
    if constexpr (!ALIGN_EPI) { if (wr == 0) PG8_BAR; }
    PG8_BAR;
    if constexpr (Epi::AFTER_DRAIN) { E.fused(acc, cur, wr, wc, fr, fq, lds, wid, lane); S.done(cur); }
#undef PG8_SA
#undef PG8_SB
#undef PG8_STAGE
#undef PG8_LDA
#undef PG8_LDB
#undef PG8_MMA
#undef PG8_WAIT_V
#undef PG8_WAIT_L
#undef PG8_BAR
#undef PG8_SCHED
}
__device__ __forceinline__ float bf2f(short s) { return __uint_as_float(((unsigned)(unsigned short)s) << 16); }
template <class Epi, class Sched>
__device__ __forceinline__ void gemm_phase_naive(const Gemm g, const Sched& S, const Epi& E) {
    int tid_ = threadIdx.x; asm volatile("" : "+v"(tid_));
    const int tid = tid_, wid = tid >> 6, lane = tid & 63, wr = wid >> 2, wc = wid & 3, fr = lane & 15, fq = lane >> 4;
    const int K = g.K; Unit u;
    for (int i = 0; S.next(i, u); ++i) {
        f32x4 acc[2][2][4][2];
#pragma unroll
        for (int a = 0; a < 2; ++a)
#pragma unroll
            for (int b = 0; b < 2; ++b)
#pragma unroll
                for (int m = 0; m < 4; ++m)
#pragma unroll
                    for (int n = 0; n < 2; ++n) acc[a][b][m][n] = (f32x4){0.f, 0.f, 0.f, 0.f};
        const bf16_t* Arow = g.A + (size_t)(u.pm * BM + wr * 64 + fr) * K;
#pragma unroll
        for (int bj = 0; bj < 2; ++bj) {
            const int cb = u.pn * BM + bj * HALF + wc * 32;
            const bf16_t* B0 = g.Bt + (size_t)(cb + (Epi::PERM ? 8 * fq : 4 * fq)) * K;
            const bf16_t* B1 = g.Bt + (size_t)(cb + (Epi::PERM ? 8 * fq + 4 : 16 + 4 * fq)) * K;
#pragma unroll 1
            for (int k0 = 0; k0 < K; k0 += 4) {
                float bf[2][4][4];
#pragma unroll
                for (int j = 0; j < 4; ++j) { const uint2 b0 = *(const uint2*)(B0 + (size_t)j * K + k0), b1 = *(const uint2*)(B1 + (size_t)j * K + k0);
                    bf[0][j][0] = __uint_as_float(b0.x << 16); bf[0][j][1] = __uint_as_float(b0.x & 0xffff0000u); bf[0][j][2] = __uint_as_float(b0.y << 16); bf[0][j][3] = __uint_as_float(b0.y & 0xffff0000u);
                    bf[1][j][0] = __uint_as_float(b1.x << 16); bf[1][j][1] = __uint_as_float(b1.x & 0xffff0000u); bf[1][j][2] = __uint_as_float(b1.y << 16); bf[1][j][3] = __uint_as_float(b1.y & 0xffff0000u); }
#pragma unroll
                for (int ai = 0; ai < 2; ++ai)
#pragma unroll
                    for (int m = 0; m < 4; ++m) { const uint2 a2 = *(const uint2*)(Arow + (size_t)(ai * HALF + m * 16) * K + k0);
                        const float a0 = __uint_as_float(a2.x << 16), a1 = __uint_as_float(a2.x & 0xffff0000u), a2f = __uint_as_float(a2.y << 16), a3 = __uint_as_float(a2.y & 0xffff0000u);
#pragma unroll
                        for (int n = 0; n < 2; ++n)
#pragma unroll
                            for (int j = 0; j < 4; ++j) acc[ai][bj][m][n][j] += a0 * bf[n][j][0] + a1 * bf[n][j][1] + a2f * bf[n][j][2] + a3 * bf[n][j][3]; }
            }
        }
        E(acc, u, wr, wc, fr, fq);
    }
}
}
#define GAS __attribute__((address_space(1)))
#define LAS __attribute__((address_space(3)))
typedef unsigned short bf16;
typedef unsigned v4u __attribute__((ext_vector_type(4)));
typedef float f32x4 __attribute__((ext_vector_type(4)));
typedef short bf16x8 __attribute__((ext_vector_type(8)));
typedef GAS unsigned gu32;
typedef GAS unsigned long long gu64;
#define RLX_AGENT __ATOMIC_RELAXED, __HIP_MEMORY_SCOPE_AGENT
#define LDS_WAIT() asm volatile("s_waitcnt lgkmcnt(0)" ::: "memory")
#define VM_WAIT() asm volatile("s_waitcnt vmcnt(0)" ::: "memory")
__device__ __forceinline__ unsigned long long rt() { return __builtin_amdgcn_s_memrealtime(); }
__device__ __forceinline__ unsigned pk2(float lo, float hi) { return pg8::cvt_pk_bf16(lo, hi); }
__device__ __forceinline__ unsigned f2bf(float f) { return pg8::cvt_pk_bf16(f, f) & 0xffffu; }
#define XB_TMO      128
#define XB_XCNT(j)  (256  + 64 * (j))
#define XB_XSUB(j)  (1280 + 64 * (j))
#define XB_XGEN(j)  (2304 + 64 * (j))
#define XB_TOP      3328
#define XB_TOPGEN   3392
#define XCD_BAR_WORDS 3456
#define XB_SPIN_CAP (1u << 22)

__device__ __forceinline__ unsigned xb_ld(unsigned* p)              { return __hip_atomic_load(p, __ATOMIC_RELAXED, __HIP_MEMORY_SCOPE_AGENT); }
__device__ __forceinline__ unsigned xb_add(unsigned* p, unsigned v) { return __hip_atomic_fetch_add(p, v, __ATOMIC_RELAXED, __HIP_MEMORY_SCOPE_AGENT); }
__device__ __forceinline__ unsigned xb_xcc_id() { return (unsigned)__builtin_amdgcn_s_getreg((3 << 11) | 20) & 0xFu; }
#define XB_SPIN(cond, bar) do { unsigned _sp = 0; while (cond) { __builtin_amdgcn_s_sleep(1); \
    if ((++_sp & 255u) == 0u) { if (xb_ld(&(bar)[XB_TMO])) break; if (_sp > XB_SPIN_CAP) { atomicAdd(&(bar)[XB_TMO], 1u); break; } } } } while (0)

struct XcdBarrier {
    unsigned* bar; unsigned x;
    volatile LAS unsigned* st;
};

__device__ __forceinline__ XcdBarrier xcd_barrier_post(unsigned* bar, volatile LAS unsigned* st) {
    XcdBarrier b; b.bar = bar; b.x = xb_xcc_id(); b.st = st;
    if (threadIdx.x == 0) (void)xb_add(&bar[XB_XCNT(b.x)], 1u);
    return b;
}
__device__ __forceinline__ void xcd_barrier_complete(unsigned* bar, unsigned x, unsigned& nloc, unsigned& nx) {
    const unsigned G = gridDim.x * gridDim.y * gridDim.z;
    unsigned sum, cnt, mine, sp = 0u;
    for (;;) {
        sum = 0u; cnt = 0u; mine = 0u;
#pragma unroll
        for (unsigned j = 0; j < 16; ++j) { const unsigned c = xb_ld(&bar[XB_XCNT(j)]); sum += c; cnt += (c > 0u) ? 1u : 0u; mine = (j == x) ? c : mine; }
        if (sum == G) break;
        __builtin_amdgcn_s_sleep(1);
        if ((++sp & 255u) == 0u) { if (xb_ld(&bar[XB_TMO])) break; if (sp > XB_SPIN_CAP) { atomicAdd(&bar[XB_TMO], 1u); break; } }
    }
    nloc = mine > 0u ? mine : 1u; nx = cnt > 0u ? cnt : 1u;
}

__device__ __forceinline__ void xcd_barrier(const XcdBarrier& b) {
    asm volatile("s_waitcnt vmcnt(0)" ::: "memory");
    __syncthreads();
    if (threadIdx.x == 0) {
        unsigned* bar = b.bar;
        __builtin_amdgcn_s_waitcnt(0);
        unsigned nloc = b.st[0], nx = b.st[1];
        if (nloc == 0u) { xcd_barrier_complete(bar, b.x, nloc, nx); b.st[0] = nloc; b.st[1] = nx; }
        const unsigned old = xb_add(&bar[XB_XSUB(b.x)], 1u);
        const unsigned gen = old / nloc;
        if (old + 1u == (gen + 1u) * nloc) {
            __builtin_amdgcn_fence(__ATOMIC_RELEASE, "agent");
            asm volatile("s_waitcnt vmcnt(0)" ::: "memory");
            const unsigned og = xb_add(&bar[XB_TOP], 1u);
            const unsigned tg = og / nx;
            if (og + 1u == (tg + 1u) * nx) xb_add(&bar[XB_TOPGEN], 1u);
            else XB_SPIN(xb_ld(&bar[XB_TOPGEN]) == tg, bar);
            __builtin_amdgcn_fence(__ATOMIC_ACQUIRE, "agent");
            xb_add(&bar[XB_XGEN(b.x)], 1u);
            asm volatile("s_waitcnt vmcnt(0)" ::: "memory");
        } else {
            XB_SPIN(xb_ld(&bar[XB_XGEN(b.x)]) == gen, bar);
            __builtin_amdgcn_fence(__ATOMIC_ACQUIRE, "agent");
            asm volatile("s_waitcnt vmcnt(0)" ::: "memory");
        }
    }
    __syncthreads();
}

constexpr int NWAVES = 8;
constexpr int DM = 1024, NBATCH = 16, SEQ = 2048, TT = NBATCH * SEQ, MEML = 256, TMEM = NBATCH * MEML, DFF = 2816, XH = 4, XHD = 256, HGH = 8, HGD = 128;
constexpr float EPS = 1e-6f;
constexpr float QSCALE = 0.0625f * 1.4426950408889634f;
static_assert(TT == pg8::TT_ROWS, "row count");
constexpr size_t MiB = 1u << 20;
constexpr size_t WS_CTL = 0, CTL_ZERO_BYTES = 1 * MiB;
constexpr size_t WS_SSQ = 1 * MiB;
constexpr size_t WS_RMEM = 3 * MiB;
constexpr size_t WS_LB = 3 * MiB + 65536;
constexpr size_t WS_WCIN = 4 * MiB, WS_WCOUT = 10 * MiB, WS_WHIN = 12 * MiB, WS_WHOUT = 20 * MiB, WS_WQ = 22 * MiB, WS_WKV = 26 * MiB, WS_WO = 34 * MiB, WS_WFIN = 38 * MiB, WS_WFOUT = 60 * MiB;
constexpr size_t SZ_WQ = 2 * MiB, SZ_WKV = 4 * MiB, SZ_WO = 2 * MiB, SZ_WFIN = 11 * MiB, SZ_WFOUT = 5 * MiB + 512 * 1024;
constexpr size_t WS_MEMB = 72 * MiB;
constexpr size_t WS_KV = 80 * MiB, SZ_KV = 16 * MiB, OFF_VT = 8 * MiB;
constexpr size_t WS_XB = 112 * MiB;
constexpr size_t WS_P = 176 * MiB, SZ_P = 64 * MiB;
constexpr size_t WS_Y = 432 * MiB;
constexpr size_t WS_END = 496 * MiB;
constexpr int CW_BAR = 4096;
constexpr int RING_OFF = 0, RING_BYTES = 131072;
constexpr int LDSCTL_OFF = RING_BYTES, MISC_OFF = LDSCTL_OFF + 320;
constexpr int LDS_BYTES = 147456;

struct Params { const float* in[19]; float* out; unsigned char* ws; };

__device__ __forceinline__ int opaque_tid(int wave_s) { unsigned z = 0u; asm volatile("" : "+v"(z));
    int t = (wave_s << 6) | (int)__builtin_amdgcn_mbcnt_hi(~0u, __builtin_amdgcn_mbcnt_lo(~0u, z)); asm volatile("" : "+v"(t)); return t; }
#define SWZ_XOR(x, m) __int_as_float(__builtin_amdgcn_ds_swizzle(__float_as_int(x), ((m) << 10) | 0x1f))
__device__ __forceinline__ float wave_sum(float v) {
    v += SWZ_XOR(v, 1); v += SWZ_XOR(v, 2); v += SWZ_XOR(v, 4); v += SWZ_XOR(v, 8); v += SWZ_XOR(v, 16);
    return pg8::xor32_sum(v);
}
__device__ __forceinline__ float wave_max(float v) {
    v = fmaxf(v, SWZ_XOR(v, 1)); v = fmaxf(v, SWZ_XOR(v, 2)); v = fmaxf(v, SWZ_XOR(v, 4)); v = fmaxf(v, SWZ_XOR(v, 8)); v = fmaxf(v, SWZ_XOR(v, 16));
    return pg8::xor32_max(v);
}
__device__ __forceinline__ float bfu2f(unsigned short s) { return __uint_as_float(((unsigned)s) << 16); }
__device__ __forceinline__ float bflo(unsigned w) { return __uint_as_float(w << 16); }
__device__ __forceinline__ float bfhi(unsigned w) { return __uint_as_float(w & 0xffff0000u); }

__device__ __forceinline__ int map_row(int mode, int n0) {
    if (mode == 1) { if (n0 < 1024) return 2048 + n0; if (n0 < 2048) { const int c = n0 - 1024; return 256 * (c >> 7) + (c & 127); } const int c = n0 - 2048; return 256 * (c >> 7) + 128 + (c & 127); }
    if (mode == 2) { if (n0 < DFF) return 256 * (n0 >> 7) + (n0 & 127); const int c = n0 - DFF; return 256 * (c >> 7) + 128 + (c & 127); }
    return n0;
}
struct TrItem { const float* W; const float* gain; bf16* WT; int K, N, mode, r, tm; };
__device__ __forceinline__ void tr_load(const TrItem& d, int lane, f32x4 (&v)[8]) {
    const int nblk = d.N / 32, kb = d.r / nblk, nb = d.r % nblk, k0 = 64 * kb, n0 = 32 * nb;
    const float* src = d.W + (size_t)(k0 + (lane >> 3)) * d.N + n0 + 4 * (lane & 7);
#pragma unroll
    for (int i = 0; i < 8; ++i) v[i] = *(const GAS f32x4*)(src + (size_t)(8 * i) * d.N);
}
__device__ __forceinline__ void tr_store(const TrItem& d, int lane, const f32x4 (&v)[8], LAS float* scr) {
    const int nblk = d.N / 32, kb = d.r / nblk, nb = d.r % nblk, k0 = 64 * kb, n0 = 32 * nb;
#pragma unroll
    for (int i = 0; i < 8; ++i) { LAS float* t = scr + (8 * i + (lane >> 3)) * 33 + 4 * (lane & 7); t[0] = v[i].x; t[1] = v[i].y; t[2] = v[i].z; t[3] = v[i].w; }
    LDS_WAIT(); asm volatile("" ::: "memory");
    const int c = lane & 7, r0 = map_row(d.mode, n0);
    f32x4 g0 = {1.f, 1.f, 1.f, 1.f}, g1 = {1.f, 1.f, 1.f, 1.f};
    if (d.gain) { g0 = *(const f32x4*)(d.gain + k0 + 8 * c); g1 = *(const f32x4*)(d.gain + k0 + 8 * c + 4); }
#pragma unroll
    for (int j = 0; j < 4; ++j) { const int n = (lane >> 3) + 8 * j; const LAS float* t = scr + (8 * c) * 33 + n;
        v4u o; o.x = pk2(t[0 * 33] * g0.x, t[1 * 33] * g0.y); o.y = pk2(t[2 * 33] * g0.z, t[3 * 33] * g0.w); o.z = pk2(t[4 * 33] * g1.x, t[5 * 33] * g1.y); o.w = pk2(t[6 * 33] * g1.z, t[7 * 33] * g1.w);
        *(GAS v4u*)(d.WT + (size_t)(r0 + n) * d.K + k0 + 8 * c) = o; }
    LDS_WAIT(); asm volatile("" ::: "memory");
}
constexpr int TR_ITEMS_EARLY = (1024 / 64) * ((3072 + 1024 + 4096 + 1024 + 2048 + 2048 + 1024 + 5632) / 32) + (DFF / 64) * (1024 / 32);
constexpr int TR_ITEMS_LATE = (1024 / 64) * ((1024 + 1024 + 1024 + 5632) / 32) + (DFF / 64) * (1024 / 32);
__device__ __forceinline__ TrItem tr_decode(const Params& p, unsigned char* ws, int it, int list) {
    int r = it; TrItem d;
#define TR_ITEM(Wp, K_, N_, Gp, WTp, MODE_, TM_) { constexpr int cnt_ = ((K_) / 64) * ((N_) / 32); if (r < cnt_) { d.W = (Wp); d.gain = (Gp); d.WT = (bf16*)(WTp); d.K = (K_); d.N = (N_); d.mode = (MODE_); d.tm = (TM_); d.r = r; return d; } r -= cnt_; }
    if (list == 0) {
        TR_ITEM(p.in[3], 1024, 3072, p.in[2], ws + WS_WCIN, 1, 1)
        TR_ITEM(p.in[5], 1024, 1024, (const float*)nullptr, ws + WS_WCOUT, 0, 1)
        TR_ITEM(p.in[6], 1024, 4096, p.in[2] + 1024, ws + WS_WHIN, 0, 1)
        TR_ITEM(p.in[12], 1024, 1024, p.in[10], ws + WS_WQ, 0, 1)
        TR_ITEM(p.in[13], 1024, 2048, p.in[11], ws + WS_WKV, 0, 0)
        TR_ITEM(p.in[13] + 1024 * 2048, 1024, 2048, p.in[11] + 1024, ws + WS_WKV + SZ_WKV, 0, 0)
        TR_ITEM(p.in[14], 1024, 1024, (const float*)nullptr, ws + WS_WO, 0, 1)
        TR_ITEM(p.in[16], 1024, 5632, p.in[15], ws + WS_WFIN, 2, 1)
        d.W = p.in[17]; d.gain = nullptr; d.WT = (bf16*)(ws + WS_WFOUT); d.K = DFF; d.N = 1024; d.mode = 0; d.tm = 1; d.r = r; return d;
    }
    TR_ITEM(p.in[7], 1024, 1024, (const float*)nullptr, ws + WS_WHOUT, 0, 1)
    TR_ITEM(p.in[12] + 1024 * 1024, 1024, 1024, p.in[10] + 1024, ws + WS_WQ + SZ_WQ, 0, 1)
    TR_ITEM(p.in[14] + 1024 * 1024, 1024, 1024, (const float*)nullptr, ws + WS_WO + SZ_WO, 0, 1)
    TR_ITEM(p.in[16] + 1024 * 5632, 1024, 5632, p.in[15] + 1024, ws + WS_WFIN + SZ_WFIN, 2, 1)
#undef TR_ITEM
    d.W = p.in[17] + DFF * 1024; d.gain = nullptr; d.WT = (bf16*)(ws + WS_WFOUT + SZ_WFOUT); d.K = DFF; d.N = 1024; d.mode = 0; d.tm = 1; d.r = r; return d;
}
__device__ __forceinline__ void tr_run(const Params& p, unsigned char* ws, LAS float* scr, int list, int nitems, int it0, int stride, int lane) {
    int it = it0; f32x4 v[8];
    if (it < nitems) { TrItem d = tr_decode(p, ws, it, list); tr_load(d, lane, v); }
    while (it < nitems) {
        const TrItem d = tr_decode(p, ws, it, list);
#pragma unroll
        for (int i = 0; i < 8; ++i) { LAS float* t = scr + (8 * i + (lane >> 3)) * 33 + 4 * (lane & 7); t[0] = v[i].x; t[1] = v[i].y; t[2] = v[i].z; t[3] = v[i].w; }
        const int nx = it + stride;
        if (nx < nitems) { const TrItem dn = tr_decode(p, ws, nx, list); tr_load(dn, lane, v); }
        LDS_WAIT(); asm volatile("" ::: "memory");
        { const int nblk = d.N / 32, kb = d.r / nblk, nb = d.r % nblk, k0 = 64 * kb, n0 = 32 * nb; const int c = lane & 7, r0 = map_row(d.mode, n0);
          f32x4 g0 = {1.f, 1.f, 1.f, 1.f}, g1 = {1.f, 1.f, 1.f, 1.f};
          if (d.gain) { g0 = *(const f32x4*)(d.gain + k0 + 8 * c); g1 = *(const f32x4*)(d.gain + k0 + 8 * c + 4); }
#pragma unroll
          for (int j = 0; j < 4; ++j) { const int n = (lane >> 3) + 8 * j; const LAS float* t = scr + (8 * c) * 33 + n;
              v4u o; o.x = pk2(t[0 * 33] * g0.x, t[1 * 33] * g0.y); o.y = pk2(t[2 * 33] * g0.z, t[3 * 33] * g0.w); o.z = pk2(t[4 * 33] * g1.x, t[5 * 33] * g1.y); o.w = pk2(t[6 * 33] * g1.z, t[7 * 33] * g1.w);
              if (d.tm) *(GAS v4u*)(d.WT + ((size_t)(k0 >> 6) * d.N + r0 + n) * 64 + 8 * c) = o;
              else *(GAS v4u*)(d.WT + (size_t)(r0 + n) * d.K + k0 + 8 * c) = o; } }
        LDS_WAIT(); asm volatile("" ::: "memory");
        it = nx;
    }
}
template <bool TILE_MAJOR, int NR> __device__ __forceinline__ void row_group(const float* src, bf16* dst, int m0, int lane, float (&ss)[NR]) {
    f32x4 v[NR][4];
#pragma unroll
    for (int i = 0; i < NR; ++i) { const GAS f32x4* xa = (const GAS f32x4*)(src + (size_t)(m0 + i) * DM) + lane;
#pragma unroll
        for (int j = 0; j < 4; ++j) v[i][j] = xa[64 * j]; }
#pragma unroll
    for (int i = 0; i < NR; ++i) { float s = 0.f;
#pragma unroll
        for (int j = 0; j < 4; ++j) s += (v[i][j].x * v[i][j].x + v[i][j].y * v[i][j].y) + (v[i][j].z * v[i][j].z + v[i][j].w * v[i][j].w);
        ss[i] = wave_sum(s);
#pragma unroll
        for (int j = 0; j < 4; ++j) { const unsigned long long w = (unsigned long long)pk2(v[i][j].x, v[i][j].y) | ((unsigned long long)pk2(v[i][j].z, v[i][j].w) << 32);
            if (TILE_MAJOR) *((GAS unsigned long long*)(dst + ((size_t)(4 * j + (lane >> 4)) * TT + m0 + i) * 64 + 4 * (lane & 15))) = w;
            else *((GAS unsigned long long*)(dst + (size_t)(m0 + i) * DM) + lane + 64 * j) = w; } }
}
__device__ __forceinline__ void p0_prologue(const Params& p, LAS unsigned char* lds, int wave_s) {
    const int tid = opaque_tid(wave_s), lane = tid & 63, wave = __builtin_amdgcn_readfirstlane(tid >> 6), gw = blockIdx.x * NWAVES + wave, NGW = gridDim.x * NWAVES;
    unsigned char* ws = p.ws;
    LAS float* scr = (LAS float*)(lds + RING_OFF + wave * 16384);
    { const float* x = p.in[0]; bf16* XB = (bf16*)(ws + WS_XB); float* SSQ = (float*)(ws + WS_SSQ);
      for (int m = 4 * gw; m < TT; m += 4 * NGW) { float ss[4]; row_group<true, 4>(x, XB, m, lane, ss);
          SSQ[(size_t)(m + (lane >> 4)) * 16 + (lane & 15)] = ((lane & 15) == 0) ? (((lane >> 4) == 0) ? ss[0] : ((lane >> 4) == 1) ? ss[1] : ((lane >> 4) == 2) ? ss[2] : ss[3]) : 0.f; }
      const float* mem = p.in[1]; bf16* MEMB = (bf16*)(ws + WS_MEMB); float* RMEM = (float*)(ws + WS_RMEM);
      for (int m = 2 * gw; m < TMEM; m += 2 * NGW) { float ss[2]; row_group<false, 2>(mem, MEMB, m, lane, ss);
          if (lane < 2) RMEM[m + lane] = rsqrtf((lane ? ss[1] : ss[0]) * (1.0f / DM) + EPS); } }
    tr_run(p, ws, scr, 0, TR_ITEMS_EARLY, gw, NGW, lane);
    if ((int)gridDim.x <= NBATCH * HGH) tr_run(p, ws, scr, 1, TR_ITEMS_LATE, gw, NGW, lane);
    { float* LB = (float*)(ws + WS_LB); const int gt = gw * 64 + lane; if (gt < DM) LB[gt] = 1.0f / (1.0f + __expf(p.in[9][gt] - p.in[9][DM + gt])); }
}

__device__ __forceinline__ void conv_pass(const bf16* U2, const bf16* GBp, const float* cw, bf16* V, int wave_s) {
    const int gtid = blockIdx.x * (NWAVES * 64) + opaque_tid(wave_s), NT = gridDim.x * NWAVES * 64;
    constexpr int RUN = 8;
    for (int idx = gtid; idx < (TT / RUN) * 128; idx += NT) {
        const int c8 = (idx & 127) * 8, row0 = (idx >> 7) * RUN, t0 = row0 & (SEQ - 1);
        const f32x4 w0a = *(const f32x4*)(cw + c8), w0b = *(const f32x4*)(cw + c8 + 4);
        const f32x4 w1a = *(const f32x4*)(cw + DM + c8), w1b = *(const f32x4*)(cw + DM + c8 + 4);
        const f32x4 w2a = *(const f32x4*)(cw + 2 * DM + c8), w2b = *(const f32x4*)(cw + 2 * DM + c8 + 4);
        const v4u z4 = {0u, 0u, 0u, 0u};
        v4u uc = (t0 >= 2) ? *(const v4u*)(U2 + (size_t)(row0 - 2) * DM + c8) : z4;
        v4u ub = (t0 >= 1) ? *(const v4u*)(U2 + (size_t)(row0 - 1) * DM + c8) : z4;
        v4u ur[RUN], gr[RUN];
#pragma unroll
        for (int i = 0; i < RUN; ++i) { ur[i] = *(const v4u*)(U2 + (size_t)(row0 + i) * DM + c8); gr[i] = *(const v4u*)(GBp + (size_t)(row0 + i) * DM + c8); }
#pragma unroll
        for (int i = 0; i < RUN; ++i) { const v4u ua = ur[i], g = gr[i]; v4u o;
#define CV(W, e0, e1, wA, wB, wC) { const float z0 = wA[e0] * bflo(uc.W) + wB[e0] * bflo(ub.W) + wC[e0] * bflo(ua.W); const float z1 = wA[e1] * bfhi(uc.W) + wB[e1] * bfhi(ub.W) + wC[e1] * bfhi(ua.W); \
            o.W = pk2(bflo(g.W) * z0, bfhi(g.W) * z1); }
            CV(x, 0, 1, w0a, w1a, w2a) CV(y, 2, 3, w0a, w1a, w2a) CV(z, 0, 1, w0b, w1b, w2b) CV(w, 2, 3, w0b, w1b, w2b)
#undef CV
            *(v4u*)(V + (size_t)(row0 + i) * DM + c8) = o; uc = ub; ub = ua; }
    }
}

__device__ __forceinline__ void attn_naive(const bf16* Q, const bf16* Kb, const bf16* VT, bf16* O, int wave_s) {
    const int tid = opaque_tid(wave_s), lane = tid & 63, gw = blockIdx.x * NWAVES + __builtin_amdgcn_readfirstlane(tid >> 6), NGW = gridDim.x * NWAVES;
    for (int item = gw; item < TT * XH; item += NGW) {
        const int row = item >> 2, h = item & 3, b = row >> 11;
        const bf16* q = Q + (size_t)row * DM + h * XHD;
        const bf16* Kh = Kb + (size_t)(b * MEML) * DM + h * XHD;
        float sc[4] = {0.f, 0.f, 0.f, 0.f};
        for (int c = 0; c < 32; ++c) {
            const v4u qv = *(const v4u*)(q + 8 * c);
#pragma unroll
            for (int j = 0; j < 4; ++j) { const v4u kv = *(const v4u*)(Kh + (size_t)(lane + 64 * j) * DM + 8 * c);
                sc[j] += bflo(qv.x) * bflo(kv.x) + bfhi(qv.x) * bfhi(kv.x) + bflo(qv.y) * bflo(kv.y) + bfhi(qv.y) * bfhi(kv.y)
                       + bflo(qv.z) * bflo(kv.z) + bfhi(qv.z) * bfhi(kv.z) + bflo(qv.w) * bflo(kv.w) + bfhi(qv.w) * bfhi(kv.w); }
        }
        const float mx = wave_max(fmaxf(fmaxf(sc[0], sc[1]), fmaxf(sc[2], sc[3])));
        float pr[4]; float sum = 0.f;
#pragma unroll
        for (int j = 0; j < 4; ++j) { pr[j] = exp2f(sc[j] - mx); sum += pr[j]; }
        sum = wave_sum(sum); const float inv = 1.0f / sum;
        const bf16* Vh = VT + (size_t)(h * XHD) * TMEM + b * MEML;
        float keep = 0.f;
        for (int d = 0; d < XHD; ++d) {
            float part = 0.f;
#pragma unroll
            for (int j = 0; j < 4; ++j) part += pr[j] * bfu2f(Vh[(size_t)d * TMEM + lane + 64 * j]);
            part = wave_sum(part);
            if ((d & 63) == lane) keep = part * inv;
            if ((d & 63) == 63) O[(size_t)row * DM + h * XHD + (d - 63) + lane] = (bf16)f2bf(keep);
        }
    }
}


namespace xat {
typedef short bf16x8 __attribute__((ext_vector_type(8)));
typedef float f32x16 __attribute__((ext_vector_type(16)));
#define XAT_WAITBAR() asm volatile("s_waitcnt vmcnt(0) lgkmcnt(0)\n\ts_barrier" ::: "memory")
__device__ __forceinline__ void dma_k_half(LAS unsigned char* buf, const bf16* Kbh, int kh, int wid, int lane) {
    const int rho = 2 * wid + (lane >> 5), c = (lane & 31) ^ rho, key0 = 128 * kh + ((rho & ~12) | ((rho & 4) << 1) | ((rho & 8) >> 1));
    const bf16* src = Kbh + (size_t)key0 * 1024 + 8 * c;
#pragma unroll
    for (int i = 0; i < 8; ++i) __builtin_amdgcn_global_load_lds((const unsigned*)(src + (size_t)i * 16 * 1024), (LAS unsigned*)(buf + (wid + 8 * i) * 1024), 16, 0, 0);
}
__device__ __forceinline__ void dma_v_half(LAS unsigned char* buf, const bf16* VTbh, int kh, int wid, int lane) {
    const int rho = 4 * wid + (lane >> 4), c = (lane & 15) ^ (rho & 15);
    const bf16* src = VTbh + (size_t)rho * TMEM + 128 * kh + 8 * c;
#pragma unroll
    for (int i = 0; i < 8; ++i) __builtin_amdgcn_global_load_lds((const unsigned*)(src + (size_t)i * 32 * TMEM), (LAS unsigned*)(buf + (wid + 8 * i) * 1024), 16, 0, 0);
}
__device__ __forceinline__ void attn_phase(LAS unsigned char* lds, const bf16* Q, const bf16* Kb, const bf16* VT, bf16* O, int wave_s) {
    const int tid0 = opaque_tid(wave_s), wid = __builtin_amdgcn_readfirstlane(tid0 >> 6);
    const int G = gridDim.x, bx = blockIdx.x;
    LAS unsigned char* buf0 = lds; LAS unsigned char* buf1 = lds + 65536;
    LAS float* lsw = (LAS float*)(lds + 131072 + 1024) + wid * 32;
    pg8::StaticOrder SO; SO.init(TT, DM, G, bx); pg8::Unit qu;
    for (int ui = 0; SO.next(ui, qu); ++ui) {
        int tid = tid0; asm volatile("" : "+v"(tid));
        const int lane = tid & 63, r = lane & 31, h = lane >> 5, xk = h ^ (r & 15);
        const int qb = qu.pm & 7, hd = qu.pn, b = qu.pm >> 3;
        const size_t row0 = (size_t)b * SEQ + qb * 256 + wid * 32;
        const bf16* Kbh = Kb + (size_t)(b * MEML) * DM + hd * XHD;
        const bf16* VTbh = VT + (size_t)(hd * XHD) * TMEM + b * MEML;
        XAT_WAITBAR();
        dma_k_half(buf0, Kbh, 0, wid, lane); dma_k_half(buf1, Kbh, 1, wid, lane);
        bf16x8 qf[16];
#pragma unroll
        for (int ks = 0; ks < 16; ++ks) qf[ks] = *(const bf16x8*)(Q + (row0 + r) * DM + hd * XHD + 16 * ks + 8 * h);
        XAT_WAITBAR();
        f32x16 sacc[8];
#pragma unroll
        for (int kb = 0; kb < 8; ++kb)
#pragma unroll
            for (int i = 0; i < 16; ++i) sacc[kb][i] = 0.f;
        {
            bf16x8 kc[4], kn[4];
#pragma unroll
            for (int kbl = 0; kbl < 4; ++kbl) kc[kbl] = *(const LAS bf16x8*)(buf0 + r * 512 + kbl * 16384 + (((0) ^ xk) << 4));
#pragma unroll
            for (int st = 0; st < 32; ++st) { const int hf = st >> 4, ks = st & 15;
                if (st + 1 < 32) { const int hn = (st + 1) >> 4, kx = (st + 1) & 15; LAS unsigned char* nb = (hn ? buf1 : buf0) + r * 512 + (((2 * kx) ^ xk) << 4);
#pragma unroll
                    for (int kbl = 0; kbl < 4; ++kbl) kn[kbl] = *(const LAS bf16x8*)(nb + kbl * 16384); }
#pragma unroll
                for (int kbl = 0; kbl < 4; ++kbl) sacc[hf * 4 + kbl] = __builtin_amdgcn_mfma_f32_32x32x16_bf16(kc[kbl], qf[ks], sacc[hf * 4 + kbl], 0, 0, 0);
#pragma unroll
                for (int kbl = 0; kbl < 4; ++kbl) kc[kbl] = kn[kbl];
            }
        }
        XAT_WAITBAR();
        dma_v_half(buf0, VTbh, 0, wid, lane); dma_v_half(buf1, VTbh, 1, wid, lane);
        float mx = sacc[0][0];
#pragma unroll
        for (int kb = 0; kb < 8; ++kb)
#pragma unroll
            for (int i = 0; i < 16; ++i) mx = fmaxf(mx, sacc[kb][i]);
        mx = pg8::xor32_max(mx);
        float lsum = 0.f; bf16x8 pf[8][2];
#pragma unroll
        for (int kb = 0; kb < 8; ++kb) {
#pragma unroll
            for (int i = 0; i < 16; ++i) { const float pv = __builtin_amdgcn_exp2f(sacc[kb][i] - mx); sacc[kb][i] = pv; lsum += pv; }
#pragma unroll
            for (int s = 0; s < 2; ++s) { v4u w; w.x = pg8::cvt_pk_bf16(sacc[kb][8 * s + 0], sacc[kb][8 * s + 1]); w.y = pg8::cvt_pk_bf16(sacc[kb][8 * s + 2], sacc[kb][8 * s + 3]);
                w.z = pg8::cvt_pk_bf16(sacc[kb][8 * s + 4], sacc[kb][8 * s + 5]); w.w = pg8::cvt_pk_bf16(sacc[kb][8 * s + 6], sacc[kb][8 * s + 7]); pf[kb][s] = __builtin_bit_cast(bf16x8, w); }
        }
        lsum = pg8::xor32_sum(lsum);
        if (h == 0) lsw[r] = lsum;
        XAT_WAITBAR();
        f32x16 oacc[8];
#pragma unroll
        for (int db = 0; db < 8; ++db)
#pragma unroll
            for (int i = 0; i < 16; ++i) oacc[db][i] = 0.f;
        {
            bf16x8 vc[4], vn[4];
#pragma unroll
            for (int d4 = 0; d4 < 4; ++d4) vc[d4] = *(const LAS bf16x8*)(buf0 + r * 256 + d4 * 8192 + ((((h)) ^ (r & 15)) << 4));
#pragma unroll
            for (int st = 0; st < 32; ++st) { const int hf = st >> 4, kbl = (st >> 2) & 3, sx = (st >> 1) & 1, dh = st & 1;
                if (st + 1 < 32) { const int s1 = st + 1, hn = s1 >> 4, kn_ = (s1 >> 2) & 3, sn = (s1 >> 1) & 1, dn = s1 & 1;
                    LAS unsigned char* nb = (hn ? buf1 : buf0) + r * 256 + dn * 32768 + ((((4 * kn_ + 2 * sn + h)) ^ (r & 15)) << 4);
#pragma unroll
                    for (int d4 = 0; d4 < 4; ++d4) vn[d4] = *(const LAS bf16x8*)(nb + d4 * 8192); }
#pragma unroll
                for (int d4 = 0; d4 < 4; ++d4) oacc[dh * 4 + d4] = __builtin_amdgcn_mfma_f32_32x32x16_bf16(pf[hf * 4 + kbl][sx], vc[d4], oacc[dh * 4 + d4], 0, 0, 0);
#pragma unroll
                for (int d4 = 0; d4 < 4; ++d4) vc[d4] = vn[d4];
            }
        }
        float inv[16];
#pragma unroll
        for (int i = 0; i < 16; ++i) inv[i] = __builtin_amdgcn_rcpf(lsw[(i & 3) + 8 * (i >> 2) + 4 * h]);
        bf16* Ow = O + row0 * DM + hd * XHD + r;
#pragma unroll
        for (int db = 0; db < 8; ++db)
#pragma unroll
            for (int i = 0; i < 16; ++i) { const float ov = oacc[db][i] * inv[i]; Ow[(size_t)((i & 3) + 8 * (i >> 2) + 4 * h) * DM + db * 32] = (bf16)(pg8::cvt_pk_bf16(ov, ov) & 0xffffu); }
    }
    XAT_WAITBAR();
}
}


namespace hg {
typedef short bf16x8 __attribute__((ext_vector_type(8)));
typedef float f32x16 __attribute__((ext_vector_type(16)));
typedef unsigned u32x2v __attribute__((ext_vector_type(2)));
typedef float f32x2v __attribute__((ext_vector_type(2)));
#define HG_BAR() asm volatile("s_waitcnt lgkmcnt(0)\n\ts_barrier" ::: "memory")
#define HG_WAITBAR() asm volatile("s_waitcnt vmcnt(0) lgkmcnt(0)\n\ts_barrier" ::: "memory")
constexpr int QT = 0, QB = 16384, KT = 32768, KTT = 49152, VTI = 65536, ST = 81920, YS = 114688, TAB = 131072 + 2048;
__device__ __forceinline__ int sig(int x) { return (x & ~12) | ((x & 4) << 1) | ((x & 8) >> 1); }
__device__ __forceinline__ float ex2(float x) { return __builtin_amdgcn_exp2f(x); }
struct RawL { unsigned lg[8]; };
struct RawQV { unsigned q[8]; v4u v[2]; };
__device__ __forceinline__ void load_lg(RawL& R, const bf16* P1h, int c, int tid, int wid) {
    const unsigned* pl = (const unsigned*)(P1h + (size_t)(c * 64 + 8 * wid) * HGD + 2 * (tid & 63));
#pragma unroll
    for (int j = 0; j < 8; ++j) R.lg[j] = pl[j * (HGD / 2)];
}
__device__ __forceinline__ void load_qv(RawQV& R, const bf16* P0h, const bf16* P2h, int c, int tid, int wid) {
    const unsigned* pq = (const unsigned*)(P0h + (size_t)(c * 64 + 8 * wid) * HGD + 2 * (tid & 63));
#pragma unroll
    for (int j = 0; j < 8; ++j) R.q[j] = pq[j * (HGD / 2)];
    const v4u* pv = (const v4u*)(P2h + (size_t)(c * 64 + 2 * (tid & 31)) * HGD + 8 * (tid >> 5));
    R.v[0] = pv[0]; R.v[1] = pv[HGD / 8];
}
__device__ __forceinline__ void load_og(u32x2v (&og)[4], const bf16* P3h, int c, int tid, int tb, int vb) {
    const int lane = tid & 63, r = lane & 31, h = lane >> 5;
    const u32x2v* po = (const u32x2v*)(P3h + (size_t)(c * 64 + 32 * tb + r) * HGD + 32 * vb + 4 * h);
#pragma unroll
    for (int q = 0; q < 4; ++q) og[q] = po[2 * q];
}
__device__ __forceinline__ void chunk_body(LAS unsigned char* lds, RawL& RL, RawQV& QV, f32x16 (&Sst)[2], const int c, const int tid0, const int wid,
                                           const bf16* P0h, const bf16* P1h, const bf16* P2h, const bf16* P3h, const float* gnh, bf16* Yb) {
    LAS float* TOT = (LAS float*)(lds + TAB); LAS float* DL = TOT + 1024; LAS float* DMT = DL + 128; LAS float* SSQX = DMT + 128;
    const int tb = wid >> 2, vb = wid & 3, kb0 = 2 * (wid >> 2);
    int tid = tid0; asm volatile("" : "+v"(tid));
    if (c >= 0) {
    const int lane = tid & 63, r = lane & 31, h = lane >> 5, kp = lane, k0 = 2 * lane, sw256 = r & 15, sw128 = (r >> 1) & 7;
    u32x2v ogr[4]; load_og(ogr, P3h, c, tid, tb, vb);
    { float r0 = 0.f, r1 = 0.f;
#pragma unroll
      for (int j = 0; j < 8; ++j) { r0 += bflo(RL.lg[j]); r1 += bfhi(RL.lg[j]); }
      *(LAS f32x2v*)(TOT + wid * 128 + k0) = (f32x2v){r0, r1}; }
    HG_BAR();
    { const int sp = tid & 31, vg = tid >> 5, s = 2 * sp;
      const unsigned a4[4] = {QV.v[0].x, QV.v[0].y, QV.v[0].z, QV.v[0].w}, b4[4] = {QV.v[1].x, QV.v[1].y, QV.v[1].z, QV.v[1].w};
#pragma unroll
      for (int e = 0; e < 8; ++e) { const int v = 8 * vg + e;
          const unsigned lo = (e & 1) ? (a4[e >> 1] >> 16) : (a4[e >> 1] & 0xffffu), hi = (e & 1) ? (b4[e >> 1] & 0xffff0000u) : (b4[e >> 1] << 16);
          *(LAS unsigned*)(lds + VTI + v * 128 + ((((s >> 3) ^ ((v >> 1) & 7))) << 4) + (s & 7) * 2) = lo | hi; } }
    { float off0 = 0.f, off1 = 0.f, bm0 = 0.f, bm1 = 0.f, bl0 = 0.f, bl1 = 0.f;
#pragma unroll
      for (int sgi = 0; sgi < 8; ++sgi) { const f32x2v tt = *(const LAS f32x2v*)(TOT + sgi * 128 + k0);
          if (sgi < wid) { off0 += tt[0]; off1 += tt[1]; } if (sgi < 4) { bm0 += tt[0]; bm1 += tt[1]; } bl0 += tt[0]; bl1 += tt[1]; }
      const float em0 = ex2(bm0), em1 = ex2(bm1);
      unsigned ktA[4], ktB[4];
      float pk0 = 0.f, pk1 = 0.f, run0 = off0 - bm0, run1 = off1 - bm1;
#pragma unroll
      for (int j = 0; j < 8; ++j) { const int t = 8 * wid + j, rho = sig(t);
          const float l0 = bflo(RL.lg[j]), l1 = bfhi(RL.lg[j]); run0 += l0; run1 += l1;
          const float d0 = run0, d1 = run1;
          const float E0 = ex2(fminf(d0, 115.f)), E1 = ex2(fminf(d1, 115.f)), I0 = ex2(fminf(-d0, 115.f)), I1 = ex2(fminf(-d1, 115.f));
          const float q0 = bflo(QV.q[j]) * E0, q1 = bfhi(QV.q[j]) * E1, kt0 = (1.0f - ex2(l0)) * I0, kt1 = (1.0f - ex2(l1)) * I1;
          const int co = (k0 & 7) * 2;
          *(LAS unsigned*)(lds + QT + t * 256 + ((((k0 >> 3) ^ (t & 15))) << 4) + co) = pg8::cvt_pk_bf16(q0, q1);
          *(LAS unsigned*)(lds + QB + t * 256 + ((((k0 >> 3) ^ (t & 15))) << 4) + co) = pg8::cvt_pk_bf16(q0 * em0, q1 * em1);
          *(LAS unsigned*)(lds + KT + rho * 256 + ((((k0 >> 3) ^ (rho & 15))) << 4) + co) = pg8::cvt_pk_bf16(kt0, kt1);
          if (j & 1) { ktA[j >> 1] = pg8::cvt_pk_bf16(pk0, kt0); ktB[j >> 1] = pg8::cvt_pk_bf16(pk1, kt1); } else { pk0 = kt0; pk1 = kt1; } }
      *(LAS v4u*)(lds + KTT + k0 * 128 + ((((wid) ^ (kp & 7))) << 4)) = (v4u){ktA[0], ktA[1], ktA[2], ktA[3]};
      *(LAS v4u*)(lds + KTT + (k0 + 1) * 128 + ((((wid) ^ (kp & 7))) << 4)) = (v4u){ktB[0], ktB[1], ktB[2], ktB[3]};
      if (wid == 0) *(LAS f32x2v*)(DL + k0) = (f32x2v){ex2(bl0), ex2(bl1)};
      if (wid == 1) *(LAS f32x2v*)(DMT + k0) = (f32x2v){ex2(bl0 - bm0), ex2(bl1 - bm1)}; }
    if (c > 0) {
#pragma unroll
        for (int i = 0; i < 2; ++i) { const int id = tid + 512 * i, t = id >> 4, ch = id & 15;
            const v4u w = *(const LAS v4u*)(lds + YS + t * 256 + (((ch ^ (t & 15))) << 4));
            *(v4u*)(Yb + (size_t)(64 * (c - 1) + t) * DM + 8 * ch) = w; } }
    if (c + 2 < SEQ / 64) load_lg(RL, P1h, c + 2, tid, wid);
    if (c + 1 < SEQ / 64) load_qv(QV, P0h, P2h, c + 1, tid, wid);
    HG_BAR();
    f32x16 oT;
#pragma unroll
    for (int i = 0; i < 16; ++i) oT[i] = 0.f;
    { bf16x8 qfr[8];
#pragma unroll
      for (int ks = 0; ks < 8; ++ks) qfr[ks] = *(const LAS bf16x8*)(lds + QT + (32 * tb + r) * 256 + ((((2 * ks + h) ^ sw256)) << 4));
#pragma unroll
      for (int sb = 0; sb < 2; ++sb) {
        if (sb <= tb) {
            f32x16 x;
#pragma unroll
            for (int i = 0; i < 16; ++i) x[i] = 0.f;
#pragma unroll
            for (int ks = 0; ks < 8; ++ks) { const bf16x8 a = *(const LAS bf16x8*)(lds + KT + (32 * sb + r) * 256 + ((((2 * ks + h) ^ sw256)) << 4));
                x = __builtin_amdgcn_mfma_f32_32x32x16_bf16(a, qfr[ks], x, 0, 0, 0); }
            if (sb == tb) {
#pragma unroll
                for (int i = 0; i < 16; ++i) { const int sl = (i & 3) + 4 * ((i >> 2) & 1) + 8 * h + 16 * (i >> 3); if (sl > r) x[i] = 0.f; } }
#pragma unroll
            for (int ss = 0; ss < 2; ++ss) { v4u w; w.x = pg8::cvt_pk_bf16(x[8 * ss + 0], x[8 * ss + 1]); w.y = pg8::cvt_pk_bf16(x[8 * ss + 2], x[8 * ss + 3]);
                w.z = pg8::cvt_pk_bf16(x[8 * ss + 4], x[8 * ss + 5]); w.w = pg8::cvt_pk_bf16(x[8 * ss + 6], x[8 * ss + 7]);
                const bf16x8 a = *(const LAS bf16x8*)(lds + VTI + (32 * vb + r) * 128 + ((((4 * sb + 2 * ss + h) ^ sw128)) << 4));
                oT = __builtin_amdgcn_mfma_f32_32x32x16_bf16(a, __builtin_bit_cast(bf16x8, w), oT, 0, 0, 0); }
        }
      } }
#pragma unroll
    for (int ks = 0; ks < 8; ++ks) { const bf16x8 a = *(const LAS bf16x8*)(lds + ST + (32 * vb + r) * 256 + ((((2 * ks + h) ^ sw256)) << 4));
        const bf16x8 qb = *(const LAS bf16x8*)(lds + QB + (32 * tb + r) * 256 + ((((2 * ks + h) ^ sw256)) << 4));
        oT = __builtin_amdgcn_mfma_f32_32x32x16_bf16(a, qb, oT, 0, 0, 0); }
#pragma unroll
    for (int blk = 0; blk < 2; ++blk) { f32x16 U[2];
#pragma unroll
        for (int i = 0; i < 16; ++i) U[blk][i] = 0.f;
#pragma unroll
        for (int st = 0; st < 4; ++st) { const bf16x8 a = *(const LAS bf16x8*)(lds + KTT + (32 * (kb0 + blk) + r) * 128 + ((((2 * st + h) ^ sw128)) << 4));
            const bf16x8 bv = *(const LAS bf16x8*)(lds + VTI + (32 * vb + r) * 128 + ((((2 * st + h) ^ sw128)) << 4));
            U[blk] = __builtin_amdgcn_mfma_f32_32x32x16_bf16(a, bv, U[blk], 0, 0, 0); }
#pragma unroll
        for (int q = 0; q < 4; ++q) { const int kbase = 32 * (kb0 + blk) + 8 * q + 4 * h; const f32x4 dl = *(const LAS f32x4*)(DL + kbase), dm = *(const LAS f32x4*)(DMT + kbase);
#pragma unroll
            for (int e = 0; e < 4; ++e) Sst[blk][4 * q + e] = dl[e] * Sst[blk][4 * q + e] + dm[e] * U[blk][4 * q + e]; }
    }
    { float part = 0.f;
#pragma unroll
      for (int i = 0; i < 16; ++i) part += oT[i] * oT[i];
      part = pg8::xor32_sum(part);
      if (h == 0) SSQX[(32 * tb + r) * 4 + vb] = part; }
    HG_BAR();
    { const f32x4 sx = *(const LAS f32x4*)(SSQX + (32 * tb + r) * 4); const float rs = rsqrtf(((sx[0] + sx[1]) + (sx[2] + sx[3])) * (1.0f / HGD) + EPS);
#pragma unroll
      for (int q = 0; q < 4; ++q) { const f32x4 gn4 = *(const LAS f32x4*)(SSQX + 256 + 32 * vb + 8 * q + 4 * h);
          const float y0 = oT[4 * q + 0] * rs * gn4[0] * bflo(ogr[q].x), y1 = oT[4 * q + 1] * rs * gn4[1] * bfhi(ogr[q].x);
          const float y2 = oT[4 * q + 2] * rs * gn4[2] * bflo(ogr[q].y), y3 = oT[4 * q + 3] * rs * gn4[3] * bfhi(ogr[q].y);
          *(LAS u32x2v*)(lds + YS + (32 * tb + r) * 256 + ((((4 * vb + q) ^ (r & 15))) << 4) + 8 * h) = (u32x2v){pg8::cvt_pk_bf16(y0, y1), pg8::cvt_pk_bf16(y2, y3)}; } }
#pragma unroll
    for (int blk = 0; blk < 2; ++blk)
#pragma unroll
        for (int q = 0; q < 4; ++q) { const int kbase = 32 * (kb0 + blk) + 8 * q + 4 * h;
            *(LAS u32x2v*)(lds + ST + (32 * vb + r) * 256 + ((((kbase >> 3) ^ sw256)) << 4) + (kbase & 7) * 2) =
                (u32x2v){pg8::cvt_pk_bf16(Sst[blk][4 * q + 0], Sst[blk][4 * q + 1]), pg8::cvt_pk_bf16(Sst[blk][4 * q + 2], Sst[blk][4 * q + 3])}; }
    } else {
        load_lg(RL, P1h, c + 2, tid, wid);
        if (c == -1) load_qv(QV, P0h, P2h, 0, tid, wid);
    }
}
__device__ __forceinline__ void scan_phase(LAS unsigned char* lds, const bf16* P0  , const bf16* P1  , const bf16* P2  , const bf16* P3  , const float* gnorm, bf16* Y, int wave_s) {
    const int tid0 = opaque_tid(wave_s), wid = __builtin_amdgcn_readfirstlane(tid0 >> 6);
    const int tb = wid >> 2, vb = wid & 3, G = gridDim.x;
    for (int item = blockIdx.x; item < NBATCH * HGH; item += G) {
        const int b = item >> 3, hh = item & 7;
        const size_t hoff = (size_t)item * SEQ * HGD;
        const bf16* P0h = P0 + hoff; const bf16* P1h = P1 + hoff; const bf16* P2h = P2 + hoff; const bf16* P3h = P3 + hoff;
        bf16* Yb = Y + (size_t)b * SEQ * DM + hh * HGD; const float* gnh = gnorm + hh * HGD;
        f32x16 Sst[2];
#pragma unroll
        for (int i = 0; i < 16; ++i) { Sst[0][i] = 0.f; Sst[1][i] = 0.f; }
        HG_WAITBAR();
        RawL LA, LB; RawQV QV;
#pragma unroll
        for (int i = 0; i < 16; ++i) *(LAS unsigned*)(lds + ST + (tid0 * 16 + i) * 4) = 0u;
        if (tid0 < HGD) ((LAS float*)(lds + TAB))[1024 + 128 + 128 + 256 + tid0] = gnh[tid0];
#pragma unroll 1
        for (int c = -2; c < SEQ / 64; c += 2) {
            chunk_body(lds, LA, QV, Sst, c, tid0, wid, P0h, P1h, P2h, P3h, gnh, Yb);
            chunk_body(lds, LB, QV, Sst, c + 1, tid0, wid, P0h, P1h, P2h, P3h, gnh, Yb);
        }
        HG_BAR();
#pragma unroll
        for (int i = 0; i < 2; ++i) { const int id = tid0 + 512 * i, t = id >> 4, ch = id & 15;
            const v4u w = *(const LAS v4u*)(lds + YS + t * 256 + (((ch ^ (t & 15))) << 4));
            *(v4u*)(Yb + (size_t)(SEQ - 64 + t) * DM + 8 * ch) = w; }
    }
    HG_WAITBAR();
}
}
__device__ __forceinline__ void late_weights(const Params& p, LAS unsigned char* lds, int wave_s) {
    const int G = gridDim.x, nside = G - NBATCH * HGH, my = (int)blockIdx.x - NBATCH * HGH;
    if (nside <= 0 || my < 0) return;
    const int tid = opaque_tid(wave_s), lane = tid & 63, wave = __builtin_amdgcn_readfirstlane(tid >> 6);
    tr_run(p, p.ws, (LAS float*)(lds + RING_OFF + wave * 16384), 1, TR_ITEMS_LATE, my * NWAVES + wave, nside * NWAVES, lane);
}

__device__ __forceinline__ void scan_naive(bf16* P0  , const bf16* P1  , const bf16* P2  , const bf16* P3  , const float* gnorm, unsigned char* lds_generic, int G) {
    float* q_s = (float*)lds_generic;
    float* g_s = q_s + 16 * 128;
    float* v_s = g_s + 16 * 128;
    float* part = v_s + 16 * 128;
    const int tid = threadIdx.x, lane = tid & 63, wave = tid >> 6, vv = tid & 127, kq = tid >> 7;
    for (int item = blockIdx.x; item < NBATCH * HGH; item += G) {
        const int b = item >> 3, h = item & 7;
        const size_t base = (size_t)b * SEQ * DM + h * HGD;
        float S[32];
#pragma unroll
        for (int i = 0; i < 32; ++i) S[i] = 0.f;
        for (int t0 = 0; t0 < SEQ; t0 += 16) {
            __syncthreads();
            { const int r = tid >> 5, c4 = (tid & 31) * 4; const size_t off = base + (size_t)(t0 + r) * DM + c4;
              const uint2 a = *(const uint2*)(P0 + off), l = *(const uint2*)(P1 + off), i2 = *(const uint2*)(P2 + off);
              float* qd = q_s + r * 128 + c4; float* gd = g_s + r * 128 + c4; float* vd = v_s + r * 128 + c4;
              qd[0] = bflo(a.x); qd[1] = bfhi(a.x); qd[2] = bflo(a.y); qd[3] = bfhi(a.y);
              gd[0] = exp2f(bflo(l.x)); gd[1] = exp2f(bfhi(l.x)); gd[2] = exp2f(bflo(l.y)); gd[3] = exp2f(bfhi(l.y));
              vd[0] = bflo(i2.x); vd[1] = bfhi(i2.x); vd[2] = bflo(i2.y); vd[3] = bfhi(i2.y); }
            __syncthreads();
            for (int s = 0; s < 16; ++s) {
                const float vval = v_s[s * 128 + vv]; float acc = 0.f;
#pragma unroll
                for (int i = 0; i < 32; ++i) { const float gk = g_s[s * 128 + kq * 32 + i]; S[i] = gk * S[i] + (1.0f - gk) * vval; acc += q_s[s * 128 + kq * 32 + i] * S[i]; }
                part[(s * 4 + kq) * 128 + vv] = acc;
            }
            __syncthreads();
#pragma unroll
            for (int ss = 0; ss < 2; ++ss) { const int s = wave * 2 + ss; const int t = t0 + s;
                float o0 = 0.f, o1 = 0.f;
#pragma unroll
                for (int k = 0; k < 4; ++k) { o0 += part[(s * 4 + k) * 128 + lane]; o1 += part[(s * 4 + k) * 128 + 64 + lane]; }
                const float ssq = wave_sum(o0 * o0 + o1 * o1); const float rs = rsqrtf(ssq * (1.0f / HGD) + EPS);
                const size_t off = base + (size_t)t * DM;
                const float y0 = o0 * rs * gnorm[h * HGD + lane] * bfu2f(P3[off + lane]), y1 = o1 * rs * gnorm[h * HGD + 64 + lane] * bfu2f(P3[off + 64 + lane]);
                P0[off + lane] = (bf16)f2bf(y0); P0[off + 64 + lane] = (bf16)f2bf(y1); }
        }
    }
}

__device__ __forceinline__ void final_norm(const bf16* XBp, const float* gfin, float* out, int wave_s) {
    const int tid = opaque_tid(wave_s), lane = tid & 63, gw = blockIdx.x * NWAVES + __builtin_amdgcn_readfirstlane(tid >> 6), NGW = gridDim.x * NWAVES;
    constexpr int RB = 4;
    f32x4 g[2][2];
#pragma unroll
    for (int j = 0; j < 2; ++j)
#pragma unroll
        for (int q = 0; q < 2; ++q) g[j][q] = *(const f32x4*)(gfin + 512 * j + 8 * lane + 4 * q);
    for (int m0 = RB * gw; m0 < TT; m0 += RB * NGW) {
        v4u a[RB], b[RB];
#pragma unroll
        for (int i = 0; i < RB; ++i) { const bf16* xr = XBp + ((size_t)(lane >> 3) * TT + m0 + i) * 64 + 8 * (lane & 7);
            a[i] = *(const v4u*)xr; b[i] = *(const v4u*)(xr + (size_t)8 * TT * 64); }
#pragma unroll
        for (int i = 0; i < RB; ++i) {
            float v[16] = {bflo(a[i].x), bfhi(a[i].x), bflo(a[i].y), bfhi(a[i].y), bflo(a[i].z), bfhi(a[i].z), bflo(a[i].w), bfhi(a[i].w),
                           bflo(b[i].x), bfhi(b[i].x), bflo(b[i].y), bfhi(b[i].y), bflo(b[i].z), bfhi(b[i].z), bflo(b[i].w), bfhi(b[i].w)};
            float s = 0.f;
#pragma unroll
            for (int k = 0; k < 16; ++k) s += v[k] * v[k];
            s = wave_sum(s); const float rs = rsqrtf(s * (1.0f / DM) + EPS);
#pragma unroll
            for (int j = 0; j < 2; ++j)
#pragma unroll
                for (int q = 0; q < 2; ++q) { const int col = 512 * j + 8 * lane + 4 * q;
                    f32x4 o; o[0] = v[8 * j + 4 * q + 0] * rs * g[j][q][0]; o[1] = v[8 * j + 4 * q + 1] * rs * g[j][q][1]; o[2] = v[8 * j + 4 * q + 2] * rs * g[j][q][2]; o[3] = v[8 * j + 4 * q + 3] * rs * g[j][q][3];
                    *(f32x4*)(out + (size_t)(m0 + i) * DM + col) = o; }
        }
    }
}

#ifndef MK_DUP_G2
#define MK_DUP_G2 0
#endif
#ifndef MK_DUP_GQ
#define MK_DUP_GQ 0
#endif
#ifndef MK_DUP_SCAN
#define MK_DUP_SCAN 0
#endif
#ifndef MK_DUP_ATTN
#define MK_DUP_ATTN 0
#endif
#ifndef MK_DUP_FFN
#define MK_DUP_FFN 0
#endif
#ifndef MK_DUP_PRO
#define MK_DUP_PRO 0
#endif
#ifndef MK_DUP_CONV
#define MK_DUP_CONV 0
#endif
#ifndef MK_EXTRA_BAR
#define MK_EXTRA_BAR 0
#endif
#ifndef MK_SCAN_MFMA
#define MK_SCAN_MFMA 1
#endif
#ifndef MK_ATTN_MFMA
#define MK_ATTN_MFMA 1
#endif
#ifndef MK_ALIGN_EPI
#define MK_ALIGN_EPI true
#endif
#ifndef MK_SP2
#define MK_SP2 true
#endif
#ifndef MK_NAIVE_GEMM
#define MK_NAIVE_GEMM 1
#endif
#if MK_NAIVE_GEMM
#define RUN_GEMM(EPI_T, g_, S_, E_) pg8::gemm_phase_naive<EPI_T, pg8::StaticOrder>(g_, S_, E_)
#else
#define RUN_GEMM(EPI_T, g_, S_, E_) pg8::gemm_phase<EPI_T, pg8::StaticOrder, MK_ALIGN_EPI, MK_SP2>(lds + RING_OFF, g_, S_, E_, wave_s)
#endif

__global__ void __launch_bounds__(NWAVES * 64, 2) mk_fwd(Params p) {
    extern __shared__ __attribute__((aligned(16))) unsigned char lds_raw[];
    LAS unsigned char* lds = (LAS unsigned char*)lds_raw;
    volatile LAS unsigned* MISC = (volatile LAS unsigned*)(lds + MISC_OFF);
    const int tid = threadIdx.x;
    const int wave_s = __builtin_amdgcn_readfirstlane(tid >> 6);
    const int G = gridDim.x, bid = blockIdx.x;
    unsigned char* const ws0 = p.ws;
    gu32* ctl = (gu32*)(ws0 + WS_CTL);
    for (int u = tid; u < (LDS_BYTES - LDSCTL_OFF) / 4; u += NWAVES * 64) ((LAS unsigned*)(lds + LDSCTL_OFF))[u] = 0u;
    __syncthreads();
    XcdBarrier bar = xcd_barrier_post((unsigned*)(ctl + CW_BAR), MISC + 8);
#define GRID_BAR() xcd_barrier(bar)

#define OPQ_WS() (ws0)

    p0_prologue(p, lds, wave_s);
#if MK_DUP_PRO
    p0_prologue(p, lds, wave_s);
#endif
    GRID_BAR();

#pragma unroll 1
    for (int l = 0; l < 2; ++l) {
        unsigned char* ws = OPQ_WS();
        { pg8::Gemm g{(const pg8::bf16_t*)(ws + WS_MEMB), (const pg8::bf16_t*)(ws + WS_WKV + l * SZ_WKV), TMEM, 1024, 1024}; pg8::StaticOrder S; S.init(TMEM, 1024, G, (bid + G - (128 * l) % G) % G);
          pg8::EpiScale E{(pg8::bf16_t*)(ws + WS_KV + l * SZ_KV), 1024, nullptr, (const float*)(ws + WS_RMEM), 1.0f};
          RUN_GEMM(pg8::EpiScale, g, S, E); }
        { pg8::Gemm g{(const pg8::bf16_t*)(ws + WS_WKV + l * SZ_WKV) + 1024 * 1024, (const pg8::bf16_t*)(ws + WS_MEMB), 1024, TMEM, 1024}; pg8::StaticOrder S; S.init(1024, TMEM, G, (bid + G - (128 * l + 64) % G) % G);
          pg8::EpiColScale E{(pg8::bf16_t*)(ws + WS_KV + l * SZ_KV + OFF_VT), TMEM, (const float*)(ws + WS_RMEM)};
          RUN_GEMM(pg8::EpiColScale, g, S, E); }
    }

#pragma unroll 1
    for (int l = 0; l < 2; ++l) {
        unsigned char* ws = OPQ_WS();
        float* SSQ = (float*)(ws + WS_SSQ);
        pg8::bf16_t* XB = (pg8::bf16_t*)(ws + WS_XB);
        pg8::bf16_t* P0 = (pg8::bf16_t*)(ws + WS_P), *P1 = (pg8::bf16_t*)(ws + WS_P + SZ_P), *P2 = (pg8::bf16_t*)(ws + WS_P + 2 * SZ_P), *P3 = (pg8::bf16_t*)(ws + WS_P + 3 * SZ_P);
        pg8::bf16_t* HB = P0;
        if (l == 0) {
            { pg8::Gemm g{XB, (const pg8::bf16_t*)(ws + WS_WCIN), TT, 3072, 1024, 64, (size_t)TT * 128, 64, (size_t)3072 * 128}; pg8::StaticOrder S; S.init(TT, 3072, G, bid);
              pg8::EpiPair<0> E{P0, 1024, P1, SSQ};
              RUN_GEMM(pg8::EpiPair<0>, g, S, E); }
            GRID_BAR();
            conv_pass(P0, P1, p.in[4], P2, wave_s);
#if MK_DUP_CONV
            conv_pass(P0, P1, p.in[4], P2, wave_s);
#endif
            GRID_BAR();
            { pg8::Gemm g{P2, (const pg8::bf16_t*)(ws + WS_WCOUT), TT, 1024, 1024, 0, 0, 64, (size_t)1024 * 128}; pg8::StaticOrder S; S.init(TT, 1024, G, bid);
              pg8::EpiResid E{XB, SSQ, 1.0f};
              RUN_GEMM(pg8::EpiResid, g, S, E);
#if MK_DUP_G2
              RUN_GEMM(pg8::EpiResid, g, S, E);
#endif
            }
            GRID_BAR();
        } else {
            { pg8::Gemm g{XB, (const pg8::bf16_t*)(ws + WS_WHIN), TT, 4096, 1024, 64, (size_t)TT * 128, 64, (size_t)4096 * 128}; pg8::StaticOrder S; S.init(TT, 4096, G, bid);
              pg8::EpiHgrn E{P0, (size_t)TT * DM, SSQ, (const float*)(ws + WS_LB)};
              RUN_GEMM(pg8::EpiHgrn, g, S, E); }
            GRID_BAR();
#if MK_SCAN_MFMA
            late_weights(p, lds, wave_s);
            hg::scan_phase(lds, P0, P1, P2, P3, p.in[8], (bf16*)(ws + WS_Y), wave_s);
#if MK_DUP_SCAN
            hg::scan_phase(lds, P0, P1, P2, P3, p.in[8], (bf16*)(ws + WS_Y), wave_s);
#endif
            GRID_BAR();
            { pg8::Gemm g{(const pg8::bf16_t*)(ws + WS_Y), (const pg8::bf16_t*)(ws + WS_WHOUT), TT, 1024, 1024, 0, 0, 64, (size_t)1024 * 128};
#else
            scan_naive(P0, P1, P2, P3, p.in[8], lds_raw, G);
            GRID_BAR();
            { pg8::Gemm g{P0, (const pg8::bf16_t*)(ws + WS_WHOUT), TT, 1024, 1024};
#endif
              pg8::StaticOrder S; S.init(TT, 1024, G, bid);
              pg8::EpiResid E{XB, SSQ, 1.0f};
              RUN_GEMM(pg8::EpiResid, g, S, E); }
            GRID_BAR();
        }
        { pg8::Gemm g{XB, (const pg8::bf16_t*)(ws + WS_WQ + l * SZ_WQ), TT, 1024, 1024, 64, (size_t)TT * 128, 64, (size_t)1024 * 128}; pg8::StaticOrder S; S.init(TT, 1024, G, bid);
          pg8::EpiScale E{P0, 1024, SSQ, nullptr, QSCALE};
          RUN_GEMM(pg8::EpiScale, g, S, E);
#if MK_DUP_GQ
          if (l == 0) { RUN_GEMM(pg8::EpiScale, g, S, E); }
#endif
        }
#if MK_ATTN_MFMA
        asm volatile("s_waitcnt vmcnt(0) lgkmcnt(0)" ::: "memory"); __syncthreads();
#else
        GRID_BAR();
#endif
#if MK_ATTN_MFMA
        xat::attn_phase(lds, P0, (const bf16*)(ws + WS_KV + l * SZ_KV), (const bf16*)(ws + WS_KV + l * SZ_KV + OFF_VT), P1, wave_s);
#if MK_DUP_ATTN
        xat::attn_phase(lds, P0, (const bf16*)(ws + WS_KV + l * SZ_KV), (const bf16*)(ws + WS_KV + l * SZ_KV + OFF_VT), P1, wave_s);
#endif
#else
        attn_naive(P0, (const bf16*)(ws + WS_KV + l * SZ_KV), (const bf16*)(ws + WS_KV + l * SZ_KV + OFF_VT), P1, wave_s);
#endif
        GRID_BAR();
        { pg8::Gemm g{P1, (const pg8::bf16_t*)(ws + WS_WO + l * SZ_WO), TT, 1024, 1024, 0, 0, 64, (size_t)1024 * 128}; pg8::StaticOrder S; S.init(TT, 1024, G, bid);
          pg8::EpiResid E{XB, SSQ, 1.0f};
          RUN_GEMM(pg8::EpiResid, g, S, E); }
        GRID_BAR();
        { pg8::Gemm g{XB, (const pg8::bf16_t*)(ws + WS_WFIN + l * SZ_WFIN), TT, 2 * DFF, 1024, 64, (size_t)TT * 128, 64, (size_t)(2 * DFF) * 128}; pg8::StaticOrder S; S.init(TT, 2 * DFF, G, bid);
          pg8::EpiPair<1> E{HB, DFF, nullptr, SSQ};
          RUN_GEMM(pg8::EpiPair<1>, g, S, E);
#if MK_DUP_FFN
          if (l == 0) { RUN_GEMM(pg8::EpiPair<1>, g, S, E); }
#endif
        }
        GRID_BAR();
        { pg8::Gemm g{HB, (const pg8::bf16_t*)(ws + WS_WFOUT + l * SZ_WFOUT), TT, 1024, DFF, 64, (size_t)TT * 128, 64, (size_t)1024 * 128};     pg8::StaticOrder S; S.init(TT, 1024, G, bid);
          pg8::EpiResid E{XB, SSQ, 1.0f};
          RUN_GEMM(pg8::EpiResid, g, S, E);
#if MK_DUP_G6
          if (l == 0) { pg8::EpiResid E0{XB, SSQ, 0.0f}; RUN_GEMM(pg8::EpiResid, g, S, E0); }
#endif
        }
        GRID_BAR();
    }
#if MK_EXTRA_BAR
#pragma unroll 1
    for (int eb = 0; eb < MK_EXTRA_BAR; ++eb) GRID_BAR();
#endif
    final_norm((const bf16*)(OPQ_WS() + WS_XB), p.in[18], p.out, wave_s);
}

extern "C" void kernel_launch(void* const* d_in, const int* in_sizes, int n_in, void* d_out, int out_size, void* d_ws, size_t ws_size, hipStream_t stream) {
    static int grid = 0;
    if (grid == 0) {
        if (n_in != 19 || out_size != TT * DM || ws_size < WS_END) { fprintf(stderr, "kernel_launch: unexpected shapes (n_in %d, out %d, ws %zu); nothing launched\n", n_in, out_size, ws_size); grid = -1; return; }
        int dev = 0, cus = 0, per_cu = 0;
        if (hipGetDevice(&dev) != hipSuccess || hipDeviceGetAttribute(&cus, hipDeviceAttributeMultiprocessorCount, dev) != hipSuccess) { fprintf(stderr, "kernel_launch: device query failed\n"); grid = -1; return; }
        if (hipFuncSetAttribute((const void*)mk_fwd, hipFuncAttributeMaxDynamicSharedMemorySize, LDS_BYTES) != hipSuccess) { fprintf(stderr, "kernel_launch: hipFuncSetAttribute failed\n"); grid = -1; return; }
        if (hipOccupancyMaxActiveBlocksPerMultiprocessor(&per_cu, (const void*)mk_fwd, NWAVES * 64, LDS_BYTES) != hipSuccess || per_cu < 1) { fprintf(stderr, "kernel_launch: occupancy query says %d blocks per CU\n", per_cu); per_cu = 1; }
        (void)hipGetLastError();
        grid = cus;
    }
    if (grid < 0) return;
    if (hipMemsetAsync((char*)d_ws + WS_CTL, 0, CTL_ZERO_BYTES, stream) != hipSuccess) { fprintf(stderr, "kernel_launch: memset failed\n"); return; }
    Params a{};
    for (int i = 0; i < 19; ++i) a.in[i] = (const float*)d_in[i];
    a.out = (float*)d_out; a.ws = (unsigned char*)d_ws;
    hipLaunchKernelGGL(mk_fwd, dim3(grid), dim3(NWAVES * 64), LDS_BYTES, stream, a);
    const hipError_t le = hipPeekAtLastError();
    if (le != hipSuccess) fprintf(stderr, "kernel_launch: launch failed: %s\n", hipGetErrorName(le));
}
```

```cpp
#define MK_NAIVE_GEMM 0
#include <hip/hip_runtime.h>
#include <cstdio>
#include <cstdint>
namespace pg8 {
#define PG8_LAS __attribute__((address_space(3)))
typedef unsigned short bf16_t;
typedef short bf16x8 __attribute__((ext_vector_type(8)));
typedef float f32x4 __attribute__((ext_vector_type(4)));
typedef unsigned u32x4 __attribute__((ext_vector_type(4)));
constexpr int BM = 256, BK = 64, HALF = 128, HTB = HALF * BK * 2  , STAGE_BYTES = 8 * HTB, NXCD = 8, WGM = 8;

__host__ __device__ __forceinline__ int lds_byte(int r, int c) { const int st = (r >> 4) * 2 + (c >> 5), rr = r & 15, cc = c & 31, ob = rr * 64 + cc * 2; return st * 1024 + (ob ^ (((ob >> 9) & 1) << 5)); }
__host__ __device__ __forceinline__ void stage_rc(int b, int& R, int& C) { const int st = b / 1024, sb = b % 1024, swz = sb ^ (((sb >> 9) & 1) << 5); R = (st >> 1) * 16 + swz / 64; C = (st & 1) * 32 + (swz % 64) / 2; }
__host__ __device__ __forceinline__ int perm32(int rho) { const int n = rho >> 4, i = rho & 15; return 8 * (i >> 2) + 4 * n + (i & 3); }

struct Unit { int pm, pn; };
struct Gemm { const bf16_t* A; const bf16_t* Bt; int M, N, K; int lda; size_t kstepA; int ldb; size_t kstepB; };

struct StaticOrder {
    int nM, nN, nwg, G, c, rev;
    __host__ __device__ void init(int M, int N, int G_, int c_, int rev_ = 0) { nM = M / BM; nN = N / BM; nwg = nM * nN; G = G_; c = c_; rev = rev_; }
    __host__ __device__ bool next(int i, Unit& u) const {
        const long L = (long)i * G + c; if (L >= nwg) return false;
        int wgid = (int)L; { const int q = nwg / NXCD, r = nwg % NXCD, xcd = wgid % NXCD, off = wgid / NXCD; wgid = (xcd < r ? xcd * (q + 1) : r * (q + 1) + (xcd - r) * q) + off; }
        const int nig = WGM * nN, gid = wgid / nig, fm = gid * WGM, gsz = (nM - fm) < WGM ? (nM - fm) : WGM;
        u.pm = fm + ((wgid % nig) % gsz); u.pn = (wgid % nig) / gsz; if (rev) u.pm = nM - 1 - u.pm; return true;
    }
    __device__ __forceinline__ void a_ready(const Unit&) const {}
    __device__ __forceinline__ void done(const Unit&) const {}
};

typedef float f32x2_cv __attribute__((ext_vector_type(2))); typedef __bf16 bf16x2_cv __attribute__((ext_vector_type(2)));
__device__ __forceinline__ unsigned cvt_pk_bf16(float lo, float hi) { f32x2_cv v = {lo, hi}; bf16x2_cv b = __builtin_convertvector(v, bf16x2_cv); return __builtin_bit_cast(unsigned, b); }
__device__ __forceinline__ float xor16_get(float x) { return __int_as_float(__builtin_amdgcn_ds_swizzle(__float_as_int(x), 0x401F)); }
__device__ __forceinline__ float xor32_sum(float x) { const auto rr = __builtin_amdgcn_permlane32_swap(__float_as_uint(x), __float_as_uint(x), false, false); return __uint_as_float(rr[0]) + __uint_as_float(rr[1]); }
__device__ __forceinline__ float xor32_max(float x) { const auto rr = __builtin_amdgcn_permlane32_swap(__float_as_uint(x), __float_as_uint(x), false, false); return fmaxf(__uint_as_float(rr[0]), __uint_as_float(rr[1])); }
__device__ __forceinline__ float lane_get(float x, int srclane) { return __int_as_float(__builtin_amdgcn_ds_bpermute(srclane << 2, __float_as_int(x))); }
typedef unsigned u32x2 __attribute__((ext_vector_type(2)));
constexpr int TT_ROWS = 32768;
__device__ __forceinline__ void rs_rows(const float* ssq, const float* rdirect, int rowbase, int lane, float (&v)[2]) {
#pragma unroll
    for (int ai = 0; ai < 2; ++ai) {
        const int row = rowbase + ai * HALF + lane;
        if (rdirect) v[ai] = rdirect[row];
        else { const f32x4* sp = (const f32x4*)(ssq + (size_t)row * 16);
            const f32x4 s0 = sp[0], s1 = sp[1], s2 = sp[2], s3 = sp[3];
            const float s = (((s0[0] + s0[1]) + (s0[2] + s0[3])) + ((s1[0] + s1[1]) + (s1[2] + s1[3]))) + (((s2[0] + s2[1]) + (s2[2] + s2[3])) + ((s3[0] + s3[1]) + (s3[2] + s3[3])));
            v[ai] = rsqrtf(s * (1.0f / 1024.0f) + 1e-6f); }
    }
}
__device__ __forceinline__ float sigm_f(float x) { return __builtin_amdgcn_rcpf(1.0f + __builtin_amdgcn_exp2f(x * -1.4426950408889634f)); }
__device__ __forceinline__ float silu_f(float x) { return x * sigm_f(x); }
__device__ __forceinline__ u32x4 pack8(const f32x4 v0, const f32x4 v1) { u32x4 w; w.x = cvt_pk_bf16(v0[0], v0[1]); w.y = cvt_pk_bf16(v0[2], v0[3]); w.z = cvt_pk_bf16(v1[0], v1[1]); w.w = cvt_pk_bf16(v1[2], v1[3]); return w; }

template <int MODE> struct EpiPair {
    static constexpr bool PERM = true, AFTER_DRAIN = false;
    bf16_t* OUT; int ldo; bf16_t* GB; const float* ssq;
    __device__ __forceinline__ void operator()(const f32x4 (&acc)[2][2][4][2], const Unit& u, int wr, int wc, int fr, int fq) const {
        const int row0 = u.pm * BM + wr * 64 + fr;
        float rsv[2]; rs_rows(ssq, nullptr, u.pm * BM + wr * 64, fq * 16 + fr, rsv);
        if (MODE == 0 && u.pn >= 8) {
            const int col0 = (u.pn - 8) * 256 + wc * 32 + 8 * fq;
#pragma unroll
            for (int ai = 0; ai < 2; ++ai)
#pragma unroll
                for (int m = 0; m < 4; ++m) { const int row = row0 + ai * HALF + m * 16; const float rs = lane_get(rsv[ai], 16 * m + fr); bf16_t* rowp = GB + (size_t)row * 1024 + col0;
#pragma unroll
                    for (int bj = 0; bj < 2; ++bj) *(u32x4*)(rowp + bj * HALF) = pack8(acc[ai][bj][m][0] * rs, acc[ai][bj][m][1] * rs); }
        } else {
            const int col0 = u.pn * 128 + wc * 32 + 8 * fq;
#if MK_EPI_REP
#pragma unroll 1
            for (int rep_ = 0; rep_ < (MODE == 1 ? 2 : 1); ++rep_)
#endif
#pragma unroll
            for (int ai = 0; ai < 2; ++ai)
#pragma unroll
                for (int m = 0; m < 4; ++m) { const int row = row0 + ai * HALF + m * 16; const float rs = lane_get(rsv[ai], 16 * m + fr);
                    const f32x4 a0 = acc[ai][0][m][0] * rs, a1 = acc[ai][0][m][1] * rs, b0 = acc[ai][1][m][0] * rs, b1 = acc[ai][1][m][1] * rs; f32x4 v0, v1;
                    if (MODE == 0) { v0 = a0 * b0; v1 = a1 * b1; }
                    else {
#pragma unroll
                        for (int j = 0; j < 4; ++j) { v0[j] = silu_f(a0[j]) * b0[j]; v1[j] = silu_f(a1[j]) * b1[j]; } }
                    if (MODE == 1) {
                        const int kt = 2 * u.pn + (wc >> 1), within = (wc & 1) * 32 + 8 * fq;
                        *(u32x4*)(OUT + ((size_t)kt * TT_ROWS + row) * 64 + within) = pack8(v0, v1);
                    } else *(u32x4*)(OUT + (size_t)row * ldo + col0) = pack8(v0, v1); }
        }
    }
};
struct EpiResid {
    static constexpr bool PERM = true, AFTER_DRAIN = false;
    bf16_t* xb; float* ssq; float sc;
    __device__ __forceinline__ void operator()(const f32x4 (&acc)[2][2][4][2], const Unit& u, int wr, int wc, int fr, int fq) const {
        const int row0 = u.pm * BM + wr * 64 + fr;
        bf16_t* rp[2]; u32x4 bres[2][4][2];
#pragma unroll
        for (int bj = 0; bj < 2; ++bj) rp[bj] = xb + ((size_t)(4 * u.pn + 2 * bj + (wc >> 1)) * TT_ROWS + row0) * 64 + (wc & 1) * 32 + 8 * fq;
#pragma unroll
        for (int ai = 0; ai < 2; ++ai)
#pragma unroll
            for (int m = 0; m < 4; ++m)
#pragma unroll
                for (int bj = 0; bj < 2; ++bj) bres[ai][m][bj] = *(const u32x4*)(rp[bj] + (size_t)(ai * HALF + m * 16) * 64);
#pragma unroll
        for (int ai = 0; ai < 2; ++ai)
#pragma unroll
            for (int m = 0; m < 4; ++m) { const int row = row0 + ai * HALF + m * 16; float sq = 0.f;
#pragma unroll
                for (int bj = 0; bj < 2; ++bj) { const u32x4 b = bres[ai][m][bj];
                    f32x4 o0 = acc[ai][bj][m][0] * sc, o1 = acc[ai][bj][m][1] * sc;
                    o0[0] += __uint_as_float(b.x << 16); o0[1] += __uint_as_float(b.x & 0xffff0000u); o0[2] += __uint_as_float(b.y << 16); o0[3] += __uint_as_float(b.y & 0xffff0000u);
                    o1[0] += __uint_as_float(b.z << 16); o1[1] += __uint_as_float(b.z & 0xffff0000u); o1[2] += __uint_as_float(b.w << 16); o1[3] += __uint_as_float(b.w & 0xffff0000u);
                    const u32x4 w = pack8(o0, o1); *(u32x4*)(rp[bj] + (size_t)(ai * HALF + m * 16) * 64) = w;
                    const float r0 = __uint_as_float(w.x << 16), r1 = __uint_as_float(w.x & 0xffff0000u), r2 = __uint_as_float(w.y << 16), r3 = __uint_as_float(w.y & 0xffff0000u);
                    const float r4 = __uint_as_float(w.z << 16), r5 = __uint_as_float(w.z & 0xffff0000u), r6 = __uint_as_float(w.w << 16), r7 = __uint_as_float(w.w & 0xffff0000u);
                    sq += ((r0 * r0 + r1 * r1) + (r2 * r2 + r3 * r3)) + ((r4 * r4 + r5 * r5) + (r6 * r6 + r7 * r7)); }
                sq += xor16_get(sq); sq = xor32_sum(sq);
                if (fq == 0) ssq[(size_t)row * 16 + (u.pn * 4 + wc)] = sq; }
    }
};
struct EpiScale {
    static constexpr bool PERM = true, AFTER_DRAIN = false;
    bf16_t* O; int ldc; const float* ssq; const float* rdirect; float scale;
    __device__ __forceinline__ void operator()(const f32x4 (&acc)[2][2][4][2], const Unit& u, int wr, int wc, int fr, int fq) const {
        const int row0 = u.pm * BM + wr * 64 + fr, col0 = u.pn * BM + wc * 32 + 8 * fq;
        float rsv[2]; rs_rows(ssq, rdirect, u.pm * BM + wr * 64, fq * 16 + fr, rsv);
#pragma unroll
        for (int ai = 0; ai < 2; ++ai)
#pragma unroll
            for (int m = 0; m < 4; ++m) { const int row = row0 + ai * HALF + m * 16; const float rs = lane_get(rsv[ai], 16 * m + fr) * scale; bf16_t* rowp = O + (size_t)row * ldc + col0;
#pragma unroll
                for (int bj = 0; bj < 2; ++bj) *(u32x4*)(rowp + bj * HALF) = pack8(acc[ai][bj][m][0] * rs, acc[ai][bj][m][1] * rs); }
    }
};
struct EpiHgrn {
    static constexpr bool PERM = true, AFTER_DRAIN = false;
    bf16_t* P; size_t pstride; const float* ssq; const float* lb;
    __device__ __forceinline__ void operator()(const f32x4 (&acc)[2][2][4][2], const Unit& u, int wr, int wc, int fr, int fq) const {
        const int row0 = u.pm * BM + wr * 64 + fr, type = u.pn >> 2, col0 = (u.pn & 3) * BM + wc * 32 + 8 * fq;
        const int bb = u.pm >> 3, t0 = (u.pm & 7) * BM + wr * 64 + fr;
        bf16_t* base = P + (size_t)type * pstride + ((size_t)(bb * 8 + (u.pn & 3) * 2) * 2048 + t0) * 128 + wc * 32 + 8 * fq;
        float rsv[2]; rs_rows(ssq, nullptr, u.pm * BM + wr * 64, fq * 16 + fr, rsv);
        if (type == 1) {
#pragma unroll
            for (int bj = 0; bj < 2; ++bj) {
                const f32x4 l0 = *(const f32x4*)(lb + col0 + bj * HALF), l1 = *(const f32x4*)(lb + col0 + bj * HALF + 4);
#pragma unroll
                for (int ai = 0; ai < 2; ++ai)
#pragma unroll
                    for (int m = 0; m < 4; ++m) { const float rs = lane_get(rsv[ai], 16 * m + fr); f32x4 v0, v1;
#pragma unroll
                        for (int j = 0; j < 4; ++j) { const float s0 = sigm_f(acc[ai][bj][m][0][j] * rs), s1 = sigm_f(acc[ai][bj][m][1][j] * rs);
                            v0[j] = __log2f(l0[j] + (1.0f - l0[j]) * s0); v1[j] = __log2f(l1[j] + (1.0f - l1[j]) * s1); }
                        *(u32x4*)(base + (size_t)(ai * HALF + m * 16) * 128 + (size_t)bj * (2048 * 128)) = pack8(v0, v1); }
            }
        } else if (type == 2) {
#pragma unroll
            for (int ai = 0; ai < 2; ++ai)
#pragma unroll
                for (int m = 0; m < 4; ++m) { const float rs = lane_get(rsv[ai], 16 * m + fr);
#pragma unroll
                    for (int bj = 0; bj < 2; ++bj) *(u32x4*)(base + (size_t)(ai * HALF + m * 16) * 128 + (size_t)bj * (2048 * 128)) = pack8(acc[ai][bj][m][0] * rs, acc[ai][bj][m][1] * rs); }
        } else {
#pragma unroll
            for (int ai = 0; ai < 2; ++ai)
#pragma unroll
                for (int m = 0; m < 4; ++m) { const float rs = lane_get(rsv[ai], 16 * m + fr);
#pragma unroll
                    for (int bj = 0; bj < 2; ++bj) { f32x4 v0, v1;
#pragma unroll
                        for (int j = 0; j < 4; ++j) { v0[j] = silu_f(acc[ai][bj][m][0][j] * rs); v1[j] = silu_f(acc[ai][bj][m][1][j] * rs); }
                        *(u32x4*)(base + (size_t)(ai * HALF + m * 16) * 128 + (size_t)bj * (2048 * 128)) = pack8(v0, v1); } }
        }
    }
};
struct EpiColScale {
    static constexpr bool PERM = true, AFTER_DRAIN = false;
    bf16_t* O; int ldc; const float* cs;
    __device__ __forceinline__ void operator()(const f32x4 (&acc)[2][2][4][2], const Unit& u, int wr, int wc, int fr, int fq) const {
        const int row0 = u.pm * BM + wr * 64 + fr, col0 = u.pn * BM + wc * 32 + 8 * fq;
#pragma unroll
        for (int bj = 0; bj < 2; ++bj) { const f32x4 c0 = *(const f32x4*)(cs + col0 + bj * HALF), c1 = *(const f32x4*)(cs + col0 + bj * HALF + 4);
#pragma unroll
            for (int ai = 0; ai < 2; ++ai)
#pragma unroll
                for (int m = 0; m < 4; ++m) *(u32x4*)(O + (size_t)(row0 + ai * HALF + m * 16) * ldc + col0 + bj * HALF) = pack8(acc[ai][bj][m][0] * c0, acc[ai][bj][m][1] * c1); }
    }
};
template <class Epi, class Sched, bool ALIGN_EPI = false, bool SP2 = false>
__device__ __forceinline__ void gemm_phase(PG8_LAS unsigned char* lds, const Gemm g, const Sched& S, const Epi& E, const int wave_s) {
    unsigned z_ = 0u; asm volatile("" : "+v"(z_));
    int tid_ = (wave_s << 6) | (int)__builtin_amdgcn_mbcnt_hi(~0u, __builtin_amdgcn_mbcnt_lo(~0u, z_)); asm volatile("" : "+v"(tid_));
    const int tid = tid_, wid = __builtin_amdgcn_readfirstlane(tid >> 6), lane = tid & 63, wr = wid >> 2, wc = wid & 3, fr = lane & 15, fq = lane >> 4;
    const int K = g.K, nt = K / BK;
    const int lda = g.lda ? g.lda : K, ldb = g.ldb ? g.ldb : K;
    unsigned voffA[2], voffB[2];
#pragma unroll
    for (int i = 0; i < 2; ++i) { int R, C; stage_rc(tid * 16 + i * 8192, R, C); const int Rb = Epi::PERM ? ((R & ~31) + perm32(R & 31)) : R;
        voffA[i] = (unsigned)(R * lda + C) * 2u; voffB[i] = (unsigned)(Rb * ldb + C) * 2u; }
    const size_t kstep = (size_t)(BK * 2);
    const size_t kstepA = g.kstepA ? g.kstepA : kstep, hstepA = (size_t)HALF * lda * 2, tstepA = 2 * hstepA;
    const size_t hstep = (size_t)HALF * ldb * 2;
    const size_t kstepB = g.kstepB ? g.kstepB : kstep;
    const size_t tstep = 2 * hstep;
    const unsigned ldsw = (unsigned)wid * 1024u;
    const int aoff = lds_byte(wr * 64 + fr, fq * 8), boff = lds_byte(wc * 32 + fr, fq * 8);
#define PG8_SA(b, h) (((b) * 2 + (h)) * HTB)
#define PG8_SB(b, h) ((4 + (b) * 2 + (h)) * HTB)
#define PG8_STAGE(bufoff, gbase, voff) do { _Pragma("unroll") for (int _i = 0; _i < 2; ++_i) \
        __builtin_amdgcn_global_load_lds((const unsigned*)((const char*)(gbase) + (voff)[_i]), (PG8_LAS unsigned*)(lds + (bufoff) + ldsw + _i * 8192), 16, 0, 0); } while (0)
#define PG8_LDA(dst, b, h) do { _Pragma("unroll") for (int m = 0; m < 4; ++m) _Pragma("unroll") for (int k = 0; k < 2; ++k) dst[m][k] = *(const PG8_LAS bf16x8*)(lds + PG8_SA(b, h) + aoff + m * 2048 + k * 1024); } while (0)
#define PG8_LDB(dst, b, h) do { _Pragma("unroll") for (int n = 0; n < 2; ++n) _Pragma("unroll") for (int k = 0; k < 2; ++k) dst[n][k] = *(const PG8_LAS bf16x8*)(lds + PG8_SB(b, h) + boff + n * 2048 + k * 1024); } while (0)
#define PG8_MMA(ai, bj, At, Bt) do { __builtin_amdgcn_s_setprio(1); _Pragma("unroll") for (int m = 0; m < 4; ++m) _Pragma("unroll") for (int n = 0; n < 2; ++n) _Pragma("unroll") for (int k = 0; k < 2; ++k) \
        acc[ai][bj][m][n] = __builtin_amdgcn_mfma_f32_16x16x32_bf16(Bt[n][k], At[m][k], acc[ai][bj][m][n], 0, 0, 0); __builtin_amdgcn_s_setprio(0); } while (0)
#define PG8_WAIT_V(n) asm volatile("s_waitcnt vmcnt(" #n ")" ::: "memory")
#define PG8_WAIT_L(n) asm volatile("s_waitcnt lgkmcnt(" #n ")" ::: "memory")
#define PG8_BAR __builtin_amdgcn_s_barrier()
#define PG8_SCHED __builtin_amdgcn_sched_barrier(0)
    Unit cur, nxt; int ui = 0;
    if (!S.next(0, cur)) return;
    f32x4 acc[2][2][4][2];
#pragma unroll
    for (int a = 0; a < 2; ++a)
#pragma unroll
        for (int b = 0; b < 2; ++b)
#pragma unroll
            for (int m = 0; m < 4; ++m)
#pragma unroll
                for (int n = 0; n < 2; ++n) acc[a][b][m][n] = (f32x4){0.f, 0.f, 0.f, 0.f};
    bf16x8 At[4][2], B0[2][2], B1[2][2];
    const char* cA = (const char*)g.A + (size_t)cur.pm * tstepA; const char* cB = (const char*)g.Bt + (size_t)cur.pn * tstep;
    S.a_ready(cur);
    if constexpr (SP2) {
        PG8_STAGE(PG8_SB(0, 0), cB, voffB); PG8_STAGE(PG8_SB(0, 1), cB + hstep, voffB); PG8_STAGE(PG8_SA(0, 0), cA, voffA); PG8_STAGE(PG8_SA(0, 1), cA + hstepA, voffA);
        if (wr == 1) PG8_BAR;
        PG8_WAIT_V(2); PG8_BAR;
        PG8_STAGE(PG8_SB(1, 0), cB + kstepB, voffB); PG8_STAGE(PG8_SA(1, 0), cA + kstepA, voffA); PG8_STAGE(PG8_SB(1, 1), cB + hstep + kstepB, voffB);
        PG8_WAIT_V(6); PG8_BAR;
    } else {
        PG8_STAGE(PG8_SB(0, 0), cB, voffB); PG8_STAGE(PG8_SA(0, 0), cA, voffA); PG8_STAGE(PG8_SB(0, 1), cB + hstep, voffB); PG8_STAGE(PG8_SA(0, 1), cA + hstepA, voffA);
        if (wr == 1) PG8_BAR;
        PG8_WAIT_V(4); PG8_BAR;
        PG8_STAGE(PG8_SB(1, 0), cB + kstepB, voffB); PG8_STAGE(PG8_SA(1, 0), cA + kstepA, voffA); PG8_STAGE(PG8_SB(1, 1), cB + hstep + kstepB, voffB);
        PG8_WAIT_V(6); PG8_BAR;
    }
    for (;;) {
        const bool has_next = S.next(ui + 1, nxt);
        const char* nA = has_next ? (const char*)g.A + (size_t)nxt.pm * tstepA : cA; const char* nB = has_next ? (const char*)g.Bt + (size_t)nxt.pn * tstep : cB;
        for (int t = 0; t < nt; t += 2) {
            const bool last = (t == nt - 2);
            const char* a1 = cA + (size_t)(t + 1) * kstepA;
            const char* a2 = last ? nA : cA + (size_t)(t + 2) * kstepA; const char* b2 = last ? nB : cB + (size_t)(t + 2) * kstepB;
            const char* a3 = a2 + kstepA; const char* b3 = b2 + kstepB;
            if (last && has_next) S.a_ready(nxt);
            if constexpr (SP2) {
            PG8_LDB(B0, 0, 0); PG8_LDB(B1, 0, 1); PG8_SCHED; PG8_LDA(At, 0, 0); PG8_STAGE(PG8_SA(1, 1), a1 + hstepA, voffA);
            PG8_WAIT_V(8); PG8_WAIT_L(0); PG8_BAR; PG8_MMA(0, 0, At, B0); PG8_MMA(0, 1, At, B1); PG8_BAR; PG8_SCHED;
            PG8_LDA(At, 0, 1); PG8_STAGE(PG8_SB(0, 0), b2, voffB); PG8_STAGE(PG8_SB(0, 1), b2 + hstep, voffB); PG8_STAGE(PG8_SA(0, 0), a2, voffA);
            PG8_WAIT_V(8); PG8_WAIT_L(0); PG8_BAR; PG8_MMA(1, 0, At, B0); PG8_MMA(1, 1, At, B1); PG8_BAR; PG8_SCHED;
            PG8_LDB(B0, 1, 0); PG8_LDB(B1, 1, 1); PG8_SCHED; PG8_LDA(At, 1, 0); PG8_STAGE(PG8_SA(0, 1), a2 + hstepA, voffA);
            PG8_WAIT_V(8); PG8_WAIT_L(0); PG8_BAR; PG8_MMA(0, 0, At, B0); PG8_MMA(0, 1, At, B1); PG8_BAR; PG8_SCHED;
            PG8_LDA(At, 1, 1); PG8_STAGE(PG8_SB(1, 0), b3, voffB); PG8_STAGE(PG8_SB(1, 1), b3 + hstep, voffB); PG8_STAGE(PG8_SA(1, 0), a3, voffA);
            PG8_WAIT_V(8); PG8_WAIT_L(0); PG8_BAR; PG8_MMA(1, 0, At, B0); PG8_MMA(1, 1, At, B1); PG8_BAR; PG8_SCHED;
            } else {
            PG8_LDB(B0, 0, 0); PG8_SCHED; PG8_LDA(At, 0, 0); PG8_STAGE(PG8_SA(1, 1), a1 + hstepA, voffA);
            PG8_WAIT_L(8); PG8_BAR; PG8_WAIT_L(0); PG8_MMA(0, 0, At, B0); PG8_BAR; PG8_SCHED;
            PG8_LDB(B1, 0, 1); PG8_STAGE(PG8_SB(0, 0), b2, voffB);
            PG8_BAR; PG8_WAIT_L(0); PG8_MMA(0, 1, At, B1); PG8_BAR;
            PG8_LDA(At, 0, 1); PG8_STAGE(PG8_SA(0, 0), a2, voffA);
            PG8_BAR; PG8_WAIT_L(0); PG8_MMA(1, 0, At, B0); PG8_BAR; PG8_SCHED;
            PG8_STAGE(PG8_SB(0, 1), b2 + hstep, voffB);
            PG8_WAIT_V(6); PG8_BAR; PG8_MMA(1, 1, At, B1); PG8_BAR;
            PG8_LDB(B0, 1, 0); PG8_SCHED; PG8_LDA(At, 1, 0); PG8_STAGE(PG8_SA(0, 1), a2 + hstepA, voffA);
            PG8_WAIT_L(8); PG8_BAR; PG8_WAIT_L(0); PG8_MMA(0, 0, At, B0); PG8_BAR; PG8_SCHED;
            PG8_LDB(B1, 1, 1); PG8_STAGE(PG8_SB(1, 0), b3, voffB);
            PG8_BAR; PG8_WAIT_L(0); PG8_MMA(0, 1, At, B1); PG8_BAR;
            PG8_LDA(At, 1, 1); PG8_STAGE(PG8_SA(1, 0), a3, voffA);
            PG8_BAR; PG8_WAIT_L(0); PG8_MMA(1, 0, At, B0); PG8_BAR; PG8_SCHED;
            PG8_STAGE(PG8_SB(1, 1), b3 + hstep, voffB);
            PG8_WAIT_V(6); PG8_BAR; PG8_MMA(1, 1, At, B1); PG8_BAR;
            }
        }
        if constexpr (ALIGN_EPI) { if (wr == 0) PG8_BAR; }
        if constexpr (!Epi::AFTER_DRAIN) { Unit eu = cur; asm volatile("" : "+s"(eu.pm), "+s"(eu.pn));
            E(acc, eu, wr, wc, fr, fq); S.done(cur); }
        if (!has_next) break;
#pragma unroll
        for (int a = 0; a < 2; ++a)
#pragma unroll
            for (int b = 0; b < 2; ++b)
#pragma unroll
                for (int m = 0; m < 4; ++m)
#pragma unroll
                    for (int n = 0; n < 2; ++n) acc[a][b][m][n] = (f32x4){0.f, 0.f, 0.f, 0.f};
        cur = nxt; cA = nA; cB = nB; ++ui;
        if constexpr (ALIGN_EPI) { if (wr == 1) PG8_BAR; }
    }
    PG8_WAIT_V(0);
    if constexpr (!ALIGN_EPI) { if (wr == 0) PG8_BAR; }
    PG8_BAR;
    if constexpr (Epi::AFTER_DRAIN) { E.fused(acc, cur, wr, wc, fr, fq, lds, wid, lane); S.done(cur); }
#undef PG8_SA
#undef PG8_SB
#undef PG8_STAGE
#undef PG8_LDA
#undef PG8_LDB
#undef PG8_MMA
#undef PG8_WAIT_V
#undef PG8_WAIT_L
#undef PG8_BAR
#undef PG8_SCHED
}
__device__ __forceinline__ float bf2f(short s) { return __uint_as_float(((unsigned)(unsigned short)s) << 16); }
template <class Epi, class Sched>
__device__ __forceinline__ void gemm_phase_naive(const Gemm g, const Sched& S, const Epi& E) {
    int tid_ = threadIdx.x; asm volatile("" : "+v"(tid_));
    const int tid = tid_, wid = tid >> 6, lane = tid & 63, wr = wid >> 2, wc = wid & 3, fr = lane & 15, fq = lane >> 4;
    const int K = g.K; Unit u;
    for (int i = 0; S.next(i, u); ++i) {
        f32x4 acc[2][2][4][2];
#pragma unroll
        for (int a = 0; a < 2; ++a)
#pragma unroll
            for (int b = 0; b < 2; ++b)
#pragma unroll
                for (int m = 0; m < 4; ++m)
#pragma unroll
                    for (int n = 0; n < 2; ++n) acc[a][b][m][n] = (f32x4){0.f, 0.f, 0.f, 0.f};
        const bf16_t* Arow = g.A + (size_t)(u.pm * BM + wr * 64 + fr) * K;
#pragma unroll
        for (int bj = 0; bj < 2; ++bj) {
            const int cb = u.pn * BM + bj * HALF + wc * 32;
            const bf16_t* B0 = g.Bt + (size_t)(cb + (Epi::PERM ? 8 * fq : 4 * fq)) * K;
            const bf16_t* B1 = g.Bt + (size_t)(cb + (Epi::PERM ? 8 * fq + 4 : 16 + 4 * fq)) * K;
#pragma unroll 1
            for (int k0 = 0; k0 < K; k0 += 4) {
                float bf[2][4][4];
#pragma unroll
                for (int j = 0; j < 4; ++j) { const uint2 b0 = *(const uint2*)(B0 + (size_t)j * K + k0), b1 = *(const uint2*)(B1 + (size_t)j * K + k0);
                    bf[0][j][0] = __uint_as_float(b0.x << 16); bf[0][j][1] = __uint_as_float(b0.x & 0xffff0000u); bf[0][j][2] = __uint_as_float(b0.y << 16); bf[0][j][3] = __uint_as_float(b0.y & 0xffff0000u);
                    bf[1][j][0] = __uint_as_float(b1.x << 16); bf[1][j][1] = __uint_as_float(b1.x & 0xffff0000u); bf[1][j][2] = __uint_as_float(b1.y << 16); bf[1][j][3] = __uint_as_float(b1.y & 0xffff0000u); }
#pragma unroll
                for (int ai = 0; ai < 2; ++ai)
#pragma unroll
                    for (int m = 0; m < 4; ++m) { const uint2 a2 = *(const uint2*)(Arow + (size_t)(ai * HALF + m * 16) * K + k0);
                        const float a0 = __uint_as_float(a2.x << 16), a1 = __uint_as_float(a2.x & 0xffff0000u), a2f = __uint_as_float(a2.y << 16), a3 = __uint_as_float(a2.y & 0xffff0000u);
#pragma unroll
                        for (int n = 0; n < 2; ++n)
#pragma unroll
                            for (int j = 0; j < 4; ++j) acc[ai][bj][m][n][j] += a0 * bf[n][j][0] + a1 * bf[n][j][1] + a2f * bf[n][j][2] + a3 * bf[n][j][3]; }
            }
        }
        E(acc, u, wr, wc, fr, fq);
    }
}
}
#define GAS __attribute__((address_space(1)))
#define LAS __attribute__((address_space(3)))
typedef unsigned short bf16;
typedef unsigned v4u __attribute__((ext_vector_type(4)));
typedef float f32x4 __attribute__((ext_vector_type(4)));
typedef short bf16x8 __attribute__((ext_vector_type(8)));
typedef GAS unsigned gu32;
typedef GAS unsigned long long gu64;
#define RLX_AGENT __ATOMIC_RELAXED, __HIP_MEMORY_SCOPE_AGENT
#define LDS_WAIT() asm volatile("s_waitcnt lgkmcnt(0)" ::: "memory")
#define VM_WAIT() asm volatile("s_waitcnt vmcnt(0)" ::: "memory")
__device__ __forceinline__ unsigned long long rt() { return __builtin_amdgcn_s_memrealtime(); }
__device__ __forceinline__ unsigned pk2(float lo, float hi) { return pg8::cvt_pk_bf16(lo, hi); }
__device__ __forceinline__ unsigned f2bf(float f) { return pg8::cvt_pk_bf16(f, f) & 0xffffu; }
#define XB_TMO      128
#define XB_XCNT(j)  (256  + 64 * (j))
#define XB_XSUB(j)  (1280 + 64 * (j))
#define XB_XGEN(j)  (2304 + 64 * (j))
#define XB_TOP      3328
#define XB_TOPGEN   3392
#define XCD_BAR_WORDS 3456
#define XB_SPIN_CAP (1u << 22)

__device__ __forceinline__ unsigned xb_ld(unsigned* p)              { return __hip_atomic_load(p, __ATOMIC_RELAXED, __HIP_MEMORY_SCOPE_AGENT); }
__device__ __forceinline__ unsigned xb_add(unsigned* p, unsigned v) { return __hip_atomic_fetch_add(p, v, __ATOMIC_RELAXED, __HIP_MEMORY_SCOPE_AGENT); }
__device__ __forceinline__ unsigned xb_xcc_id() { return (unsigned)__builtin_amdgcn_s_getreg((3 << 11) | 20) & 0xFu; }
#define XB_SPIN(cond, bar) do { unsigned _sp = 0; while (cond) { __builtin_amdgcn_s_sleep(1); \
    if ((++_sp & 255u) == 0u) { if (xb_ld(&(bar)[XB_TMO])) break; if (_sp > XB_SPIN_CAP) { atomicAdd(&(bar)[XB_TMO], 1u); break; } } } } while (0)

struct XcdBarrier {
    unsigned* bar; unsigned x;
    volatile LAS unsigned* st;
};

__device__ __forceinline__ XcdBarrier xcd_barrier_post(unsigned* bar, volatile LAS unsigned* st) {
    XcdBarrier b; b.bar = bar; b.x = xb_xcc_id(); b.st = st;
    if (threadIdx.x == 0) (void)xb_add(&bar[XB_XCNT(b.x)], 1u);
    return b;
}
__device__ __forceinline__ void xcd_barrier_complete(unsigned* bar, unsigned x, unsigned& nloc, unsigned& nx) {
    const unsigned G = gridDim.x * gridDim.y * gridDim.z;
    unsigned sum, cnt, mine, sp = 0u;
    for (;;) {
        sum = 0u; cnt = 0u; mine = 0u;
#pragma unroll
        for (unsigned j = 0; j < 16; ++j) { const unsigned c = xb_ld(&bar[XB_XCNT(j)]); sum += c; cnt += (c > 0u) ? 1u : 0u; mine = (j == x) ? c : mine; }
        if (sum == G) break;
        __builtin_amdgcn_s_sleep(1);
        if ((++sp & 255u) == 0u) { if (xb_ld(&bar[XB_TMO])) break; if (sp > XB_SPIN_CAP) { atomicAdd(&bar[XB_TMO], 1u); break; } }
    }
    nloc = mine > 0u ? mine : 1u; nx = cnt > 0u ? cnt : 1u;
}

__device__ __forceinline__ void xcd_barrier(const XcdBarrier& b) {
    asm volatile("s_waitcnt vmcnt(0)" ::: "memory");
    __syncthreads();
    if (threadIdx.x == 0) {
        unsigned* bar = b.bar;
        __builtin_amdgcn_s_waitcnt(0);
        unsigned nloc = b.st[0], nx = b.st[1];
        if (nloc == 0u) { xcd_barrier_complete(bar, b.x, nloc, nx); b.st[0] = nloc; b.st[1] = nx; }
        const unsigned old = xb_add(&bar[XB_XSUB(b.x)], 1u);
        const unsigned gen = old / nloc;
        if (old + 1u == (gen + 1u) * nloc) {
            __builtin_amdgcn_fence(__ATOMIC_RELEASE, "agent");
            asm volatile("s_waitcnt vmcnt(0)" ::: "memory");
            const unsigned og = xb_add(&bar[XB_TOP], 1u);
            const unsigned tg = og / nx;
            if (og + 1u == (tg + 1u) * nx) xb_add(&bar[XB_TOPGEN], 1u);
            else XB_SPIN(xb_ld(&bar[XB_TOPGEN]) == tg, bar);
            __builtin_amdgcn_fence(__ATOMIC_ACQUIRE, "agent");
            xb_add(&bar[XB_XGEN(b.x)], 1u);
            asm volatile("s_waitcnt vmcnt(0)" ::: "memory");
        } else {
            XB_SPIN(xb_ld(&bar[XB_XGEN(b.x)]) == gen, bar);
            __builtin_amdgcn_fence(__ATOMIC_ACQUIRE, "agent");
            asm volatile("s_waitcnt vmcnt(0)" ::: "memory");
        }
    }
    __syncthreads();
}

constexpr int NWAVES = 8;
constexpr int DM = 1024, NBATCH = 16, SEQ = 2048, TT = NBATCH * SEQ, MEML = 256, TMEM = NBATCH * MEML, DFF = 2816, XH = 4, XHD = 256, HGH = 8, HGD = 128;
constexpr float EPS = 1e-6f;
constexpr float QSCALE = 0.0625f * 1.4426950408889634f;
static_assert(TT == pg8::TT_ROWS, "row count");
constexpr size_t MiB = 1u << 20;
constexpr size_t WS_CTL = 0, CTL_ZERO_BYTES = 1 * MiB;
constexpr size_t WS_SSQ = 1 * MiB;
constexpr size_t WS_RMEM = 3 * MiB;
constexpr size_t WS_LB = 3 * MiB + 65536;
constexpr size_t WS_WCIN = 4 * MiB, WS_WCOUT = 10 * MiB, WS_WHIN = 12 * MiB, WS_WHOUT = 20 * MiB, WS_WQ = 22 * MiB, WS_WKV = 26 * MiB, WS_WO = 34 * MiB, WS_WFIN = 38 * MiB, WS_WFOUT = 60 * MiB;
constexpr size_t SZ_WQ = 2 * MiB, SZ_WKV = 4 * MiB, SZ_WO = 2 * MiB, SZ_WFIN = 11 * MiB, SZ_WFOUT = 5 * MiB + 512 * 1024;
constexpr size_t WS_MEMB = 72 * MiB;
constexpr size_t WS_KV = 80 * MiB, SZ_KV = 16 * MiB, OFF_VT = 8 * MiB;
constexpr size_t WS_XB = 112 * MiB;
constexpr size_t WS_P = 176 * MiB, SZ_P = 64 * MiB;
constexpr size_t WS_Y = 432 * MiB;
constexpr size_t WS_END = 496 * MiB;
constexpr int CW_BAR = 4096;
constexpr int RING_OFF = 0, RING_BYTES = 131072;
constexpr int LDSCTL_OFF = RING_BYTES, MISC_OFF = LDSCTL_OFF + 320;
constexpr int LDS_BYTES = 147456;

struct Params { const float* in[19]; float* out; unsigned char* ws; };

__device__ __forceinline__ int opaque_tid(int wave_s) { unsigned z = 0u; asm volatile("" : "+v"(z));
    int t = (wave_s << 6) | (int)__builtin_amdgcn_mbcnt_hi(~0u, __builtin_amdgcn_mbcnt_lo(~0u, z)); asm volatile("" : "+v"(t)); return t; }
#define SWZ_XOR(x, m) __int_as_float(__builtin_amdgcn_ds_swizzle(__float_as_int(x), ((m) << 10) | 0x1f))
__device__ __forceinline__ float wave_sum(float v) {
    v += SWZ_XOR(v, 1); v += SWZ_XOR(v, 2); v += SWZ_XOR(v, 4); v += SWZ_XOR(v, 8); v += SWZ_XOR(v, 16);
    return pg8::xor32_sum(v);
}
__device__ __forceinline__ float wave_max(float v) {
    v = fmaxf(v, SWZ_XOR(v, 1)); v = fmaxf(v, SWZ_XOR(v, 2)); v = fmaxf(v, SWZ_XOR(v, 4)); v = fmaxf(v, SWZ_XOR(v, 8)); v = fmaxf(v, SWZ_XOR(v, 16));
    return pg8::xor32_max(v);
}
__device__ __forceinline__ float bfu2f(unsigned short s) { return __uint_as_float(((unsigned)s) << 16); }
__device__ __forceinline__ float bflo(unsigned w) { return __uint_as_float(w << 16); }
__device__ __forceinline__ float bfhi(unsigned w) { return __uint_as_float(w & 0xffff0000u); }

__device__ __forceinline__ int map_row(int mode, int n0) {
    if (mode == 1) { if (n0 < 1024) return 2048 + n0; if (n0 < 2048) { const int c = n0 - 1024; return 256 * (c >> 7) + (c & 127); } const int c = n0 - 2048; return 256 * (c >> 7) + 128 + (c & 127); }
    if (mode == 2) { if (n0 < DFF) return 256 * (n0 >> 7) + (n0 & 127); const int c = n0 - DFF; return 256 * (c >> 7) + 128 + (c & 127); }
    return n0;
}
struct TrItem { const float* W; const float* gain; bf16* WT; int K, N, mode, r, tm; };
__device__ __forceinline__ void tr_load(const TrItem& d, int lane, f32x4 (&v)[8]) {
    const int nblk = d.N / 32, kb = d.r / nblk, nb = d.r % nblk, k0 = 64 * kb, n0 = 32 * nb;
    const float* src = d.W + (size_t)(k0 + (lane >> 3)) * d.N + n0 + 4 * (lane & 7);
#pragma unroll
    for (int i = 0; i < 8; ++i) v[i] = *(const GAS f32x4*)(src + (size_t)(8 * i) * d.N);
}
__device__ __forceinline__ void tr_store(const TrItem& d, int lane, const f32x4 (&v)[8], LAS float* scr) {
    const int nblk = d.N / 32, kb = d.r / nblk, nb = d.r % nblk, k0 = 64 * kb, n0 = 32 * nb;
#pragma unroll
    for (int i = 0; i < 8; ++i) { LAS float* t = scr + (8 * i + (lane >> 3)) * 33 + 4 * (lane & 7); t[0] = v[i].x; t[1] = v[i].y; t[2] = v[i].z; t[3] = v[i].w; }
    LDS_WAIT(); asm volatile("" ::: "memory");
    const int c = lane & 7, r0 = map_row(d.mode, n0);
    f32x4 g0 = {1.f, 1.f, 1.f, 1.f}, g1 = {1.f, 1.f, 1.f, 1.f};
    if (d.gain) { g0 = *(const f32x4*)(d.gain + k0 + 8 * c); g1 = *(const f32x4*)(d.gain + k0 + 8 * c + 4); }
#pragma unroll
    for (int j = 0; j < 4; ++j) { const int n = (lane >> 3) + 8 * j; const LAS float* t = scr + (8 * c) * 33 + n;
        v4u o; o.x = pk2(t[0 * 33] * g0.x, t[1 * 33] * g0.y); o.y = pk2(t[2 * 33] * g0.z, t[3 * 33] * g0.w); o.z = pk2(t[4 * 33] * g1.x, t[5 * 33] * g1.y); o.w = pk2(t[6 * 33] * g1.z, t[7 * 33] * g1.w);
        *(GAS v4u*)(d.WT + (size_t)(r0 + n) * d.K + k0 + 8 * c) = o; }
    LDS_WAIT(); asm volatile("" ::: "memory");
}
constexpr int TR_ITEMS_EARLY = (1024 / 64) * ((3072 + 1024 + 4096 + 1024 + 2048 + 2048 + 1024 + 5632) / 32) + (DFF / 64) * (1024 / 32);
constexpr int TR_ITEMS_LATE = (1024 / 64) * ((1024 + 1024 + 1024 + 5632) / 32) + (DFF / 64) * (1024 / 32);
__device__ __forceinline__ TrItem tr_decode(const Params& p, unsigned char* ws, int it, int list) {
    int r = it; TrItem d;
#define TR_ITEM(Wp, K_, N_, Gp, WTp, MODE_, TM_) { constexpr int cnt_ = ((K_) / 64) * ((N_) / 32); if (r < cnt_) { d.W = (Wp); d.gain = (Gp); d.WT = (bf16*)(WTp); d.K = (K_); d.N = (N_); d.mode = (MODE_); d.tm = (TM_); d.r = r; return d; } r -= cnt_; }
    if (list == 0) {
        TR_ITEM(p.in[3], 1024, 3072, p.in[2], ws + WS_WCIN, 1, 1)
        TR_ITEM(p.in[5], 1024, 1024, (const float*)nullptr, ws + WS_WCOUT, 0, 1)
        TR_ITEM(p.in[6], 1024, 4096, p.in[2] + 1024, ws + WS_WHIN, 0, 1)
        TR_ITEM(p.in[12], 1024, 1024, p.in[10], ws + WS_WQ, 0, 1)
        TR_ITEM(p.in[13], 1024, 2048, p.in[11], ws + WS_WKV, 0, 0)
        TR_ITEM(p.in[13] + 1024 * 2048, 1024, 2048, p.in[11] + 1024, ws + WS_WKV + SZ_WKV, 0, 0)
        TR_ITEM(p.in[14], 1024, 1024, (const float*)nullptr, ws + WS_WO, 0, 1)
        TR_ITEM(p.in[16], 1024, 5632, p.in[15], ws + WS_WFIN, 2, 1)
        d.W = p.in[17]; d.gain = nullptr; d.WT = (bf16*)(ws + WS_WFOUT); d.K = DFF; d.N = 1024; d.mode = 0; d.tm = 1; d.r = r; return d;
    }
    TR_ITEM(p.in[7], 1024, 1024, (const float*)nullptr, ws + WS_WHOUT, 0, 1)
    TR_ITEM(p.in[12] + 1024 * 1024, 1024, 1024, p.in[10] + 1024, ws + WS_WQ + SZ_WQ, 0, 1)
    TR_ITEM(p.in[14] + 1024 * 1024, 1024, 1024, (const float*)nullptr, ws + WS_WO + SZ_WO, 0, 1)
    TR_ITEM(p.in[16] + 1024 * 5632, 1024, 5632, p.in[15] + 1024, ws + WS_WFIN + SZ_WFIN, 2, 1)
#undef TR_ITEM
    d.W = p.in[17] + DFF * 1024; d.gain = nullptr; d.WT = (bf16*)(ws + WS_WFOUT + SZ_WFOUT); d.K = DFF; d.N = 1024; d.mode = 0; d.tm = 1; d.r = r; return d;
}
__device__ __forceinline__ void tr_run(const Params& p, unsigned char* ws, LAS float* scr, int list, int nitems, int it0, int stride, int lane) {
    int it = it0; f32x4 v[8];
    if (it < nitems) { TrItem d = tr_decode(p, ws, it, list); tr_load(d, lane, v); }
    while (it < nitems) {
        const TrItem d = tr_decode(p, ws, it, list);
#pragma unroll
        for (int i = 0; i < 8; ++i) { LAS float* t = scr + (8 * i + (lane >> 3)) * 33 + 4 * (lane & 7); t[0] = v[i].x; t[1] = v[i].y; t[2] = v[i].z; t[3] = v[i].w; }
        const int nx = it + stride;
        if (nx < nitems) { const TrItem dn = tr_decode(p, ws, nx, list); tr_load(dn, lane, v); }
        LDS_WAIT(); asm volatile("" ::: "memory");
        { const int nblk = d.N / 32, kb = d.r / nblk, nb = d.r % nblk, k0 = 64 * kb, n0 = 32 * nb; const int c = lane & 7, r0 = map_row(d.mode, n0);
          f32x4 g0 = {1.f, 1.f, 1.f, 1.f}, g1 = {1.f, 1.f, 1.f, 1.f};
          if (d.gain) { g0 = *(const f32x4*)(d.gain + k0 + 8 * c); g1 = *(const f32x4*)(d.gain + k0 + 8 * c + 4); }
#pragma unroll
          for (int j = 0; j < 4; ++j) { const int n = (lane >> 3) + 8 * j; const LAS float* t = scr + (8 * c) * 33 + n;
              v4u o; o.x = pk2(t[0 * 33] * g0.x, t[1 * 33] * g0.y); o.y = pk2(t[2 * 33] * g0.z, t[3 * 33] * g0.w); o.z = pk2(t[4 * 33] * g1.x, t[5 * 33] * g1.y); o.w = pk2(t[6 * 33] * g1.z, t[7 * 33] * g1.w);
              if (d.tm) *(GAS v4u*)(d.WT + ((size_t)(k0 >> 6) * d.N + r0 + n) * 64 + 8 * c) = o;
              else *(GAS v4u*)(d.WT + (size_t)(r0 + n) * d.K + k0 + 8 * c) = o; } }
        LDS_WAIT(); asm volatile("" ::: "memory");
        it = nx;
    }
}
template <bool TILE_MAJOR, int NR> __device__ __forceinline__ void row_group(const float* src, bf16* dst, int m0, int lane, float (&ss)[NR]) {
    f32x4 v[NR][4];
#pragma unroll
    for (int i = 0; i < NR; ++i) { const GAS f32x4* xa = (const GAS f32x4*)(src + (size_t)(m0 + i) * DM) + lane;
#pragma unroll
        for (int j = 0; j < 4; ++j) v[i][j] = xa[64 * j]; }
#pragma unroll
    for (int i = 0; i < NR; ++i) { float s = 0.f;
#pragma unroll
        for (int j = 0; j < 4; ++j) s += (v[i][j].x * v[i][j].x + v[i][j].y * v[i][j].y) + (v[i][j].z * v[i][j].z + v[i][j].w * v[i][j].w);
        ss[i] = wave_sum(s);
#pragma unroll
        for (int j = 0; j < 4; ++j) { const unsigned long long w = (unsigned long long)pk2(v[i][j].x, v[i][j].y) | ((unsigned long long)pk2(v[i][j].z, v[i][j].w) << 32);
            if (TILE_MAJOR) *((GAS unsigned long long*)(dst + ((size_t)(4 * j + (lane >> 4)) * TT + m0 + i) * 64 + 4 * (lane & 15))) = w;
            else *((GAS unsigned long long*)(dst + (size_t)(m0 + i) * DM) + lane + 64 * j) = w; } }
}
__device__ __forceinline__ void p0_prologue(const Params& p, LAS unsigned char* lds, int wave_s) {
    const int tid = opaque_tid(wave_s), lane = tid & 63, wave = __builtin_amdgcn_readfirstlane(tid >> 6), gw = blockIdx.x * NWAVES + wave, NGW = gridDim.x * NWAVES;
    unsigned char* ws = p.ws;
    LAS float* scr = (LAS float*)(lds + RING_OFF + wave * 16384);
    { const float* x = p.in[0]; bf16* XB = (bf16*)(ws + WS_XB); float* SSQ = (float*)(ws + WS_SSQ);
      for (int m = 4 * gw; m < TT; m += 4 * NGW) { float ss[4]; row_group<true, 4>(x, XB, m, lane, ss);
          SSQ[(size_t)(m + (lane >> 4)) * 16 + (lane & 15)] = ((lane & 15) == 0) ? (((lane >> 4) == 0) ? ss[0] : ((lane >> 4) == 1) ? ss[1] : ((lane >> 4) == 2) ? ss[2] : ss[3]) : 0.f; }
      const float* mem = p.in[1]; bf16* MEMB = (bf16*)(ws + WS_MEMB); float* RMEM = (float*)(ws + WS_RMEM);
      for (int m = 2 * gw; m < TMEM; m += 2 * NGW) { float ss[2]; row_group<false, 2>(mem, MEMB, m, lane, ss);
          if (lane < 2) RMEM[m + lane] = rsqrtf((lane ? ss[1] : ss[0]) * (1.0f / DM) + EPS); } }
    tr_run(p, ws, scr, 0, TR_ITEMS_EARLY, gw, NGW, lane);
    if ((int)gridDim.x <= NBATCH * HGH) tr_run(p, ws, scr, 1, TR_ITEMS_LATE, gw, NGW, lane);
    { float* LB = (float*)(ws + WS_LB); const int gt = gw * 64 + lane; if (gt < DM) LB[gt] = 1.0f / (1.0f + __expf(p.in[9][gt] - p.in[9][DM + gt])); }
}

__device__ __forceinline__ void conv_pass(const bf16* U2, const bf16* GBp, const float* cw, bf16* V, int wave_s) {
    const int gtid = blockIdx.x * (NWAVES * 64) + opaque_tid(wave_s), NT = gridDim.x * NWAVES * 64;
    constexpr int RUN = 8;
    for (int idx = gtid; idx < (TT / RUN) * 128; idx += NT) {
        const int c8 = (idx & 127) * 8, row0 = (idx >> 7) * RUN, t0 = row0 & (SEQ - 1);
        const f32x4 w0a = *(const f32x4*)(cw + c8), w0b = *(const f32x4*)(cw + c8 + 4);
        const f32x4 w1a = *(const f32x4*)(cw + DM + c8), w1b = *(const f32x4*)(cw + DM + c8 + 4);
        const f32x4 w2a = *(const f32x4*)(cw + 2 * DM + c8), w2b = *(const f32x4*)(cw + 2 * DM + c8 + 4);
        const v4u z4 = {0u, 0u, 0u, 0u};
        v4u uc = (t0 >= 2) ? *(const v4u*)(U2 + (size_t)(row0 - 2) * DM + c8) : z4;
        v4u ub = (t0 >= 1) ? *(const v4u*)(U2 + (size_t)(row0 - 1) * DM + c8) : z4;
        v4u ur[RUN], gr[RUN];
#pragma unroll
        for (int i = 0; i < RUN; ++i) { ur[i] = *(const v4u*)(U2 + (size_t)(row0 + i) * DM + c8); gr[i] = *(const v4u*)(GBp + (size_t)(row0 + i) * DM + c8); }
#pragma unroll
        for (int i = 0; i < RUN; ++i) { const v4u ua = ur[i], g = gr[i]; v4u o;
#define CV(W, e0, e1, wA, wB, wC) { const float z0 = wA[e0] * bflo(uc.W) + wB[e0] * bflo(ub.W) + wC[e0] * bflo(ua.W); const float z1 = wA[e1] * bfhi(uc.W) + wB[e1] * bfhi(ub.W) + wC[e1] * bfhi(ua.W); \
            o.W = pk2(bflo(g.W) * z0, bfhi(g.W) * z1); }
            CV(x, 0, 1, w0a, w1a, w2a) CV(y, 2, 3, w0a, w1a, w2a) CV(z, 0, 1, w0b, w1b, w2b) CV(w, 2, 3, w0b, w1b, w2b)
#undef CV
            *(v4u*)(V + ((size_t)(c8 >> 6) * TT + row0 + i) * 64 + (c8 & 63)) = o; uc = ub; ub = ua; }
    }
}

__device__ __forceinline__ void attn_naive(const bf16* Q, const bf16* Kb, const bf16* VT, bf16* O, int wave_s) {
    const int tid = opaque_tid(wave_s), lane = tid & 63, gw = blockIdx.x * NWAVES + __builtin_amdgcn_readfirstlane(tid >> 6), NGW = gridDim.x * NWAVES;
    for (int item = gw; item < TT * XH; item += NGW) {
        const int row = item >> 2, h = item & 3, b = row >> 11;
        const bf16* q = Q + (size_t)row * DM + h * XHD;
        const bf16* Kh = Kb + (size_t)(b * MEML) * DM + h * XHD;
        float sc[4] = {0.f, 0.f, 0.f, 0.f};
        for (int c = 0; c < 32; ++c) {
            const v4u qv = *(const v4u*)(q + 8 * c);
#pragma unroll
            for (int j = 0; j < 4; ++j) { const v4u kv = *(const v4u*)(Kh + (size_t)(lane + 64 * j) * DM + 8 * c);
                sc[j] += bflo(qv.x) * bflo(kv.x) + bfhi(qv.x) * bfhi(kv.x) + bflo(qv.y) * bflo(kv.y) + bfhi(qv.y) * bfhi(kv.y)
                       + bflo(qv.z) * bflo(kv.z) + bfhi(qv.z) * bfhi(kv.z) + bflo(qv.w) * bflo(kv.w) + bfhi(qv.w) * bfhi(kv.w); }
        }
        const float mx = wave_max(fmaxf(fmaxf(sc[0], sc[1]), fmaxf(sc[2], sc[3])));
        float pr[4]; float sum = 0.f;
#pragma unroll
        for (int j = 0; j < 4; ++j) { pr[j] = exp2f(sc[j] - mx); sum += pr[j]; }
        sum = wave_sum(sum); const float inv = 1.0f / sum;
        const bf16* Vh = VT + (size_t)(h * XHD) * TMEM + b * MEML;
        float keep = 0.f;
        for (int d = 0; d < XHD; ++d) {
            float part = 0.f;
#pragma unroll
            for (int j = 0; j < 4; ++j) part += pr[j] * bfu2f(Vh[(size_t)d * TMEM + lane + 64 * j]);
            part = wave_sum(part);
            if ((d & 63) == lane) keep = part * inv;
            if ((d & 63) == 63) O[(size_t)row * DM + h * XHD + (d - 63) + lane] = (bf16)f2bf(keep);
        }
    }
}


namespace xat {
typedef short bf16x8 __attribute__((ext_vector_type(8)));
typedef float f32x16 __attribute__((ext_vector_type(16)));
#define XAT_WAITBAR() asm volatile("s_waitcnt vmcnt(0) lgkmcnt(0)\n\ts_barrier" ::: "memory")
__device__ __forceinline__ void dma_k_half(LAS unsigned char* buf, const bf16* Kbh, int kh, int wid, int lane) {
    const int rho = 2 * wid + (lane >> 5), c = (lane & 31) ^ rho, key0 = 128 * kh + ((rho & ~12) | ((rho & 4) << 1) | ((rho & 8) >> 1));
    const bf16* src = Kbh + (size_t)key0 * 1024 + 8 * c;
#pragma unroll
    for (int i = 0; i < 8; ++i) __builtin_amdgcn_global_load_lds((const unsigned*)(src + (size_t)i * 16 * 1024), (LAS unsigned*)(buf + (wid + 8 * i) * 1024), 16, 0, 0);
}
__device__ __forceinline__ void dma_v_half(LAS unsigned char* buf, const bf16* VTbh, int kh, int wid, int lane) {
    const int rho = 4 * wid + (lane >> 4), c = (lane & 15) ^ (rho & 15);
    const bf16* src = VTbh + (size_t)rho * TMEM + 128 * kh + 8 * c;
#pragma unroll
    for (int i = 0; i < 8; ++i) __builtin_amdgcn_global_load_lds((const unsigned*)(src + (size_t)i * 32 * TMEM), (LAS unsigned*)(buf + (wid + 8 * i) * 1024), 16, 0, 0);
}
__device__ __forceinline__ void attn_phase(LAS unsigned char* lds, const bf16* Q, const bf16* Kb, const bf16* VT, bf16* O, int wave_s) {
    const int tid0 = opaque_tid(wave_s), wid = __builtin_amdgcn_readfirstlane(tid0 >> 6);
    const int G = gridDim.x, bx = blockIdx.x;
    LAS unsigned char* buf0 = lds; LAS unsigned char* buf1 = lds + 65536;
    LAS float* lsw = (LAS float*)(lds + 131072 + 1024) + wid * 32;
    pg8::StaticOrder SO; SO.init(TT, DM, G, bx); pg8::Unit qu;
    for (int ui = 0; SO.next(ui, qu); ++ui) {
        int tid = tid0; asm volatile("" : "+v"(tid));
        const int lane = tid & 63, r = lane & 31, h = lane >> 5, xk = h ^ (r & 15);
        const int qb = qu.pm & 7, hd = qu.pn, b = qu.pm >> 3;
        const size_t row0 = (size_t)b * SEQ + qb * 256 + wid * 32;
        const bf16* Kbh = Kb + (size_t)(b * MEML) * DM + hd * XHD;
        const bf16* VTbh = VT + (size_t)(hd * XHD) * TMEM + b * MEML;
        XAT_WAITBAR();
        dma_k_half(buf0, Kbh, 0, wid, lane); dma_k_half(buf1, Kbh, 1, wid, lane);
        bf16x8 qf[16];
#pragma unroll
        for (int ks = 0; ks < 16; ++ks) qf[ks] = *(const bf16x8*)(Q + (row0 + r) * DM + hd * XHD + 16 * ks + 8 * h);
        XAT_WAITBAR();
        f32x16 sacc[8];
#pragma unroll
        for (int kb = 0; kb < 8; ++kb)
#pragma unroll
            for (int i = 0; i < 16; ++i) sacc[kb][i] = 0.f;
        {
            bf16x8 kc[4], kn[4];
#pragma unroll
            for (int kbl = 0; kbl < 4; ++kbl) kc[kbl] = *(const LAS bf16x8*)(buf0 + r * 512 + kbl * 16384 + (((0) ^ xk) << 4));
#pragma unroll
            for (int st = 0; st < 32; ++st) { const int hf = st >> 4, ks = st & 15;
                if (st + 1 < 32) { const int hn = (st + 1) >> 4, kx = (st + 1) & 15; LAS unsigned char* nb = (hn ? buf1 : buf0) + r * 512 + (((2 * kx) ^ xk) << 4);
#pragma unroll
                    for (int kbl = 0; kbl < 4; ++kbl) kn[kbl] = *(const LAS bf16x8*)(nb + kbl * 16384); }
#pragma unroll
                for (int kbl = 0; kbl < 4; ++kbl) sacc[hf * 4 + kbl] = __builtin_amdgcn_mfma_f32_32x32x16_bf16(kc[kbl], qf[ks], sacc[hf * 4 + kbl], 0, 0, 0);
#pragma unroll
                for (int kbl = 0; kbl < 4; ++kbl) kc[kbl] = kn[kbl];
            }
        }
        XAT_WAITBAR();
        dma_v_half(buf0, VTbh, 0, wid, lane); dma_v_half(buf1, VTbh, 1, wid, lane);
        float mx = sacc[0][0];
#pragma unroll
        for (int kb = 0; kb < 8; ++kb)
#pragma unroll
            for (int i = 0; i < 16; ++i) mx = fmaxf(mx, sacc[kb][i]);
        mx = pg8::xor32_max(mx);
        float lsum = 0.f; bf16x8 pf[8][2];
#pragma unroll
        for (int kb = 0; kb < 8; ++kb) {
#pragma unroll
            for (int i = 0; i < 16; ++i) { const float pv = __builtin_amdgcn_exp2f(sacc[kb][i] - mx); sacc[kb][i] = pv; lsum += pv; }
#pragma unroll
            for (int s = 0; s < 2; ++s) { v4u w; w.x = pg8::cvt_pk_bf16(sacc[kb][8 * s + 0], sacc[kb][8 * s + 1]); w.y = pg8::cvt_pk_bf16(sacc[kb][8 * s + 2], sacc[kb][8 * s + 3]);
                w.z = pg8::cvt_pk_bf16(sacc[kb][8 * s + 4], sacc[kb][8 * s + 5]); w.w = pg8::cvt_pk_bf16(sacc[kb][8 * s + 6], sacc[kb][8 * s + 7]); pf[kb][s] = __builtin_bit_cast(bf16x8, w); }
        }
        lsum = pg8::xor32_sum(lsum);
        if (h == 0) lsw[r] = lsum;
        XAT_WAITBAR();
        f32x16 oacc[8];
#pragma unroll
        for (int db = 0; db < 8; ++db)
#pragma unroll
            for (int i = 0; i < 16; ++i) oacc[db][i] = 0.f;
        {
            bf16x8 vc[4], vn[4];
#pragma unroll
            for (int d4 = 0; d4 < 4; ++d4) vc[d4] = *(const LAS bf16x8*)(buf0 + r * 256 + d4 * 8192 + ((((h)) ^ (r & 15)) << 4));
#pragma unroll
            for (int st = 0; st < 32; ++st) { const int hf = st >> 4, kbl = (st >> 2) & 3, sx = (st >> 1) & 1, dh = st & 1;
                if (st + 1 < 32) { const int s1 = st + 1, hn = s1 >> 4, kn_ = (s1 >> 2) & 3, sn = (s1 >> 1) & 1, dn = s1 & 1;
                    LAS unsigned char* nb = (hn ? buf1 : buf0) + r * 256 + dn * 32768 + ((((4 * kn_ + 2 * sn + h)) ^ (r & 15)) << 4);
#pragma unroll
                    for (int d4 = 0; d4 < 4; ++d4) vn[d4] = *(const LAS bf16x8*)(nb + d4 * 8192); }
#pragma unroll
                for (int d4 = 0; d4 < 4; ++d4) oacc[dh * 4 + d4] = __builtin_amdgcn_mfma_f32_32x32x16_bf16(pf[hf * 4 + kbl][sx], vc[d4], oacc[dh * 4 + d4], 0, 0, 0);
#pragma unroll
                for (int d4 = 0; d4 < 4; ++d4) vc[d4] = vn[d4];
            }
        }
        float inv[16];
#pragma unroll
        for (int i = 0; i < 16; ++i) inv[i] = __builtin_amdgcn_rcpf(lsw[(i & 3) + 8 * (i >> 2) + 4 * h]);
        bf16* Ow = O + ((size_t)(4 * hd) * TT + row0) * 64 + r;
#pragma unroll
        for (int db = 0; db < 8; ++db)
#pragma unroll
            for (int i = 0; i < 16; ++i) { const float ov = oacc[db][i] * inv[i]; Ow[((size_t)(db >> 1) * TT + ((i & 3) + 8 * (i >> 2) + 4 * h)) * 64 + (db & 1) * 32] = (bf16)(pg8::cvt_pk_bf16(ov, ov) & 0xffffu); }
    }
    XAT_WAITBAR();
}
}


namespace hg {
typedef short bf16x8 __attribute__((ext_vector_type(8)));
typedef float f32x16 __attribute__((ext_vector_type(16)));
typedef unsigned u32x2v __attribute__((ext_vector_type(2)));
typedef float f32x2v __attribute__((ext_vector_type(2)));
#define HG_BAR() asm volatile("s_waitcnt lgkmcnt(0)\n\ts_barrier" ::: "memory")
#define HG_WAITBAR() asm volatile("s_waitcnt vmcnt(0) lgkmcnt(0)\n\ts_barrier" ::: "memory")
constexpr int QT = 0, QB = 16384, KT = 32768, KTT = 49152, VTI = 65536, ST = 81920, TAB = 131072 + 2048;
__device__ __forceinline__ int sig(int x) { return (x & ~12) | ((x & 4) << 1) | ((x & 8) >> 1); }
__device__ __forceinline__ float ex2(float x) { return __builtin_amdgcn_exp2f(x); }
struct RawL { unsigned lg[8]; };
struct RawQV { unsigned q[8]; v4u v[2]; };
__device__ __forceinline__ void load_lg(RawL& R, const bf16* P1h, int c, int tid, int wid) {
    const unsigned* pl = (const unsigned*)(P1h + (size_t)(c * 64 + 8 * wid) * HGD + 2 * (tid & 63));
#pragma unroll
    for (int j = 0; j < 8; ++j) R.lg[j] = pl[j * (HGD / 2)];
}
__device__ __forceinline__ void load_qv(RawQV& R, const bf16* P0h, const bf16* P2h, int c, int tid, int wid) {
    const unsigned* pq = (const unsigned*)(P0h + (size_t)(c * 64 + 8 * wid) * HGD + 2 * (tid & 63));
#pragma unroll
    for (int j = 0; j < 8; ++j) R.q[j] = pq[j * (HGD / 2)];
    const v4u* pv = (const v4u*)(P2h + (size_t)(c * 64 + 2 * (tid & 31)) * HGD + 8 * (tid >> 5));
    R.v[0] = pv[0]; R.v[1] = pv[HGD / 8];
}
__device__ __forceinline__ void load_og(u32x2v (&og)[4], const bf16* P3h, int c, int tid, int tb, int vb) {
    const int lane = tid & 63, r = lane & 31, h = lane >> 5;
    const u32x2v* po = (const u32x2v*)(P3h + (size_t)(c * 64 + 32 * tb + r) * HGD + 32 * vb + 4 * h);
#pragma unroll
    for (int q = 0; q < 4; ++q) og[q] = po[2 * q];
}
__device__ __forceinline__ void chunk_body(LAS unsigned char* lds, RawL& RL, RawQV& QV, f32x16 (&Sst)[2], const int c, const int tid0, const int wid,
                                           const bf16* P0h, const bf16* P1h, const bf16* P2h, const bf16* P3h, const float* gnh, bf16* Yb) {
    LAS float* TOT = (LAS float*)(lds + TAB); LAS float* DL = TOT + 1024; LAS float* DMT = DL + 128; LAS float* SSQX = DMT + 128;
    const int tb = wid >> 2, vb = wid & 3, kb0 = 2 * (wid >> 2);
    int tid = tid0; asm volatile("" : "+v"(tid));
    if (c >= 0) {
    const int lane = tid & 63, r = lane & 31, h = lane >> 5, kp = lane, k0 = 2 * lane, sw256 = r & 15, sw128 = (r >> 1) & 7;
    u32x2v ogr[4]; load_og(ogr, P3h, c, tid, tb, vb);
    { float r0 = 0.f, r1 = 0.f;
#pragma unroll
      for (int j = 0; j < 8; ++j) { r0 += bflo(RL.lg[j]); r1 += bfhi(RL.lg[j]); }
      *(LAS f32x2v*)(TOT + wid * 128 + k0) = (f32x2v){r0, r1}; }
    HG_BAR();
    { const int sp = tid & 31, vg = tid >> 5, s = 2 * sp;
      const unsigned a4[4] = {QV.v[0].x, QV.v[0].y, QV.v[0].z, QV.v[0].w}, b4[4] = {QV.v[1].x, QV.v[1].y, QV.v[1].z, QV.v[1].w};
#pragma unroll
      for (int e = 0; e < 8; ++e) { const int v = 8 * vg + e;
          const unsigned lo = (e & 1) ? (a4[e >> 1] >> 16) : (a4[e >> 1] & 0xffffu), hi = (e & 1) ? (b4[e >> 1] & 0xffff0000u) : (b4[e >> 1] << 16);
          *(LAS unsigned*)(lds + VTI + v * 128 + ((((s >> 3) ^ ((v >> 1) & 7))) << 4) + (s & 7) * 2) = lo | hi; } }
    { float off0 = 0.f, off1 = 0.f, bm0 = 0.f, bm1 = 0.f, bl0 = 0.f, bl1 = 0.f;
#pragma unroll
      for (int sgi = 0; sgi < 8; ++sgi) { const f32x2v tt = *(const LAS f32x2v*)(TOT + sgi * 128 + k0);
          if (sgi < wid) { off0 += tt[0]; off1 += tt[1]; } if (sgi < 4) { bm0 += tt[0]; bm1 += tt[1]; } bl0 += tt[0]; bl1 += tt[1]; }
      const float em0 = ex2(bm0), em1 = ex2(bm1);
      unsigned ktA[4], ktB[4];
      float pk0 = 0.f, pk1 = 0.f, run0 = off0 - bm0, run1 = off1 - bm1;
#pragma unroll
      for (int j = 0; j < 8; ++j) { const int t = 8 * wid + j, rho = sig(t);
          const float l0 = bflo(RL.lg[j]), l1 = bfhi(RL.lg[j]); run0 += l0; run1 += l1;
          const float d0 = run0, d1 = run1;
          const float E0 = ex2(fminf(d0, 115.f)), E1 = ex2(fminf(d1, 115.f)), I0 = ex2(fminf(-d0, 115.f)), I1 = ex2(fminf(-d1, 115.f));
          const float q0 = bflo(QV.q[j]) * E0, q1 = bfhi(QV.q[j]) * E1, kt0 = (1.0f - ex2(l0)) * I0, kt1 = (1.0f - ex2(l1)) * I1;
          const int co = (k0 & 7) * 2;
          *(LAS unsigned*)(lds + QT + t * 256 + ((((k0 >> 3) ^ (t & 15))) << 4) + co) = pg8::cvt_pk_bf16(q0, q1);
          *(LAS unsigned*)(lds + QB + t * 256 + ((((k0 >> 3) ^ (t & 15))) << 4) + co) = pg8::cvt_pk_bf16(q0 * em0, q1 * em1);
          *(LAS unsigned*)(lds + KT + rho * 256 + ((((k0 >> 3) ^ (rho & 15))) << 4) + co) = pg8::cvt_pk_bf16(kt0, kt1);
          if (j & 1) { ktA[j >> 1] = pg8::cvt_pk_bf16(pk0, kt0); ktB[j >> 1] = pg8::cvt_pk_bf16(pk1, kt1); } else { pk0 = kt0; pk1 = kt1; } }
      *(LAS v4u*)(lds + KTT + k0 * 128 + ((((wid) ^ (kp & 7))) << 4)) = (v4u){ktA[0], ktA[1], ktA[2], ktA[3]};
      *(LAS v4u*)(lds + KTT + (k0 + 1) * 128 + ((((wid) ^ (kp & 7))) << 4)) = (v4u){ktB[0], ktB[1], ktB[2], ktB[3]};
      if (wid == 0) *(LAS f32x2v*)(DL + k0) = (f32x2v){ex2(bl0), ex2(bl1)};
      if (wid == 1) *(LAS f32x2v*)(DMT + k0) = (f32x2v){ex2(bl0 - bm0), ex2(bl1 - bm1)}; }
    if (c + 2 < SEQ / 64) load_lg(RL, P1h, c + 2, tid, wid);
    if (c + 1 < SEQ / 64) load_qv(QV, P0h, P2h, c + 1, tid, wid);
    HG_BAR();
    f32x16 oT;
#pragma unroll
    for (int i = 0; i < 16; ++i) oT[i] = 0.f;
    { bf16x8 qfr[8];
#pragma unroll
      for (int ks = 0; ks < 8; ++ks) qfr[ks] = *(const LAS bf16x8*)(lds + QT + (32 * tb + r) * 256 + ((((2 * ks + h) ^ sw256)) << 4));
#pragma unroll
      for (int sb = 0; sb < 2; ++sb) {
        if (sb <= tb) {
            f32x16 x;
#pragma unroll
            for (int i = 0; i < 16; ++i) x[i] = 0.f;
#pragma unroll
            for (int ks = 0; ks < 8; ++ks) { const bf16x8 a = *(const LAS bf16x8*)(lds + KT + (32 * sb + r) * 256 + ((((2 * ks + h) ^ sw256)) << 4));
                x = __builtin_amdgcn_mfma_f32_32x32x16_bf16(a, qfr[ks], x, 0, 0, 0); }
            if (sb == tb) {
#pragma unroll
                for (int i = 0; i < 16; ++i) { const int sl = (i & 3) + 4 * ((i >> 2) & 1) + 8 * h + 16 * (i >> 3); if (sl > r) x[i] = 0.f; } }
#pragma unroll
            for (int ss = 0; ss < 2; ++ss) { v4u w; w.x = pg8::cvt_pk_bf16(x[8 * ss + 0], x[8 * ss + 1]); w.y = pg8::cvt_pk_bf16(x[8 * ss + 2], x[8 * ss + 3]);
                w.z = pg8::cvt_pk_bf16(x[8 * ss + 4], x[8 * ss + 5]); w.w = pg8::cvt_pk_bf16(x[8 * ss + 6], x[8 * ss + 7]);
                const bf16x8 a = *(const LAS bf16x8*)(lds + VTI + (32 * vb + r) * 128 + ((((4 * sb + 2 * ss + h) ^ sw128)) << 4));
                oT = __builtin_amdgcn_mfma_f32_32x32x16_bf16(a, __builtin_bit_cast(bf16x8, w), oT, 0, 0, 0); }
        }
      } }
#pragma unroll
    for (int ks = 0; ks < 8; ++ks) { const bf16x8 a = *(const LAS bf16x8*)(lds + ST + (32 * vb + r) * 256 + ((((2 * ks + h) ^ sw256)) << 4));
        const bf16x8 qb = *(const LAS bf16x8*)(lds + QB + (32 * tb + r) * 256 + ((((2 * ks + h) ^ sw256)) << 4));
        oT = __builtin_amdgcn_mfma_f32_32x32x16_bf16(a, qb, oT, 0, 0, 0); }
#pragma unroll
    for (int blk = 0; blk < 2; ++blk) { f32x16 U[2];
#pragma unroll
        for (int i = 0; i < 16; ++i) U[blk][i] = 0.f;
#pragma unroll
        for (int st = 0; st < 4; ++st) { const bf16x8 a = *(const LAS bf16x8*)(lds + KTT + (32 * (kb0 + blk) + r) * 128 + ((((2 * st + h) ^ sw128)) << 4));
            const bf16x8 bv = *(const LAS bf16x8*)(lds + VTI + (32 * vb + r) * 128 + ((((2 * st + h) ^ sw128)) << 4));
            U[blk] = __builtin_amdgcn_mfma_f32_32x32x16_bf16(a, bv, U[blk], 0, 0, 0); }
#pragma unroll
        for (int q = 0; q < 4; ++q) { const int kbase = 32 * (kb0 + blk) + 8 * q + 4 * h; const f32x4 dl = *(const LAS f32x4*)(DL + kbase), dm = *(const LAS f32x4*)(DMT + kbase);
#pragma unroll
            for (int e = 0; e < 4; ++e) Sst[blk][4 * q + e] = dl[e] * Sst[blk][4 * q + e] + dm[e] * U[blk][4 * q + e]; }
    }
    { float part = 0.f;
#pragma unroll
      for (int i = 0; i < 16; ++i) part += oT[i] * oT[i];
      part = pg8::xor32_sum(part);
      if (h == 0) SSQX[(32 * tb + r) * 4 + vb] = part; }
    HG_BAR();
    { const f32x4 sx = *(const LAS f32x4*)(SSQX + (32 * tb + r) * 4); const float rs = rsqrtf(((sx[0] + sx[1]) + (sx[2] + sx[3])) * (1.0f / HGD) + EPS);
#pragma unroll
      for (int q = 0; q < 4; ++q) { const f32x4 gn4 = *(const LAS f32x4*)(SSQX + 256 + 32 * vb + 8 * q + 4 * h);
          const float y0 = oT[4 * q + 0] * rs * gn4[0] * bflo(ogr[q].x), y1 = oT[4 * q + 1] * rs * gn4[1] * bfhi(ogr[q].x);
          const float y2 = oT[4 * q + 2] * rs * gn4[2] * bflo(ogr[q].y), y3 = oT[4 * q + 3] * rs * gn4[3] * bfhi(ogr[q].y);
          *(u32x2v*)(Yb + ((size_t)(vb >> 1) * TT + (64 * c + 32 * tb + r)) * 64 + (vb & 1) * 32 + 8 * q + 4 * h) = (u32x2v){pg8::cvt_pk_bf16(y0, y1), pg8::cvt_pk_bf16(y2, y3)}; } }
#pragma unroll
    for (int blk = 0; blk < 2; ++blk)
#pragma unroll
        for (int q = 0; q < 4; ++q) { const int kbase = 32 * (kb0 + blk) + 8 * q + 4 * h;
            *(LAS u32x2v*)(lds + ST + (32 * vb + r) * 256 + ((((kbase >> 3) ^ sw256)) << 4) + (kbase & 7) * 2) =
                (u32x2v){pg8::cvt_pk_bf16(Sst[blk][4 * q + 0], Sst[blk][4 * q + 1]), pg8::cvt_pk_bf16(Sst[blk][4 * q + 2], Sst[blk][4 * q + 3])}; }
    } else {
        load_lg(RL, P1h, c + 2, tid, wid);
        if (c == -1) load_qv(QV, P0h, P2h, 0, tid, wid);
    }
}
__device__ __forceinline__ void scan_phase(LAS unsigned char* lds, const bf16* P0  , const bf16* P1  , const bf16* P2  , const bf16* P3  , const float* gnorm, bf16* Y, int wave_s) {
    const int tid0 = opaque_tid(wave_s), wid = __builtin_amdgcn_readfirstlane(tid0 >> 6);
    const int tb = wid >> 2, vb = wid & 3, G = gridDim.x;
    for (int item = blockIdx.x; item < NBATCH * HGH; item += G) {
        const int b = item >> 3, hh = item & 7;
        const size_t hoff = (size_t)item * SEQ * HGD;
        const bf16* P0h = P0 + hoff; const bf16* P1h = P1 + hoff; const bf16* P2h = P2 + hoff; const bf16* P3h = P3 + hoff;
        bf16* Yb = Y + ((size_t)(2 * hh) * TT + (size_t)b * SEQ) * 64; const float* gnh = gnorm + hh * HGD;
        f32x16 Sst[2];
#pragma unroll
        for (int i = 0; i < 16; ++i) { Sst[0][i] = 0.f; Sst[1][i] = 0.f; }
        HG_WAITBAR();
        RawL LA, LB; RawQV QV;
#pragma unroll
        for (int i = 0; i < 16; ++i) *(LAS unsigned*)(lds + ST + (tid0 * 16 + i) * 4) = 0u;
        if (tid0 < HGD) ((LAS float*)(lds + TAB))[1024 + 128 + 128 + 256 + tid0] = gnh[tid0];
#pragma unroll 1
        for (int c = -2; c < SEQ / 64; c += 2) {
            chunk_body(lds, LA, QV, Sst, c, tid0, wid, P0h, P1h, P2h, P3h, gnh, Yb);
            chunk_body(lds, LB, QV, Sst, c + 1, tid0, wid, P0h, P1h, P2h, P3h, gnh, Yb);
        }
    }
    HG_WAITBAR();
}
}
__device__ __forceinline__ void late_weights(const Params& p, LAS unsigned char* lds, int wave_s) {
    const int G = gridDim.x, nside = G - NBATCH * HGH, my = (int)blockIdx.x - NBATCH * HGH;
    if (nside <= 0 || my < 0) return;
    const int tid = opaque_tid(wave_s), lane = tid & 63, wave = __builtin_amdgcn_readfirstlane(tid >> 6);
    tr_run(p, p.ws, (LAS float*)(lds + RING_OFF + wave * 16384), 1, TR_ITEMS_LATE, my * NWAVES + wave, nside * NWAVES, lane);
}

__device__ __forceinline__ void scan_naive(bf16* P0  , const bf16* P1  , const bf16* P2  , const bf16* P3  , const float* gnorm, unsigned char* lds_generic, int G) {
    float* q_s = (float*)lds_generic;
    float* g_s = q_s + 16 * 128;
    float* v_s = g_s + 16 * 128;
    float* part = v_s + 16 * 128;
    const int tid = threadIdx.x, lane = tid & 63, wave = tid >> 6, vv = tid & 127, kq = tid >> 7;
    for (int item = blockIdx.x; item < NBATCH * HGH; item += G) {
        const int b = item >> 3, h = item & 7;
        const size_t base = (size_t)b * SEQ * DM + h * HGD;
        float S[32];
#pragma unroll
        for (int i = 0; i < 32; ++i) S[i] = 0.f;
        for (int t0 = 0; t0 < SEQ; t0 += 16) {
            __syncthreads();
            { const int r = tid >> 5, c4 = (tid & 31) * 4; const size_t off = base + (size_t)(t0 + r) * DM + c4;
              const uint2 a = *(const uint2*)(P0 + off), l = *(const uint2*)(P1 + off), i2 = *(const uint2*)(P2 + off);
              float* qd = q_s + r * 128 + c4; float* gd = g_s + r * 128 + c4; float* vd = v_s + r * 128 + c4;
              qd[0] = bflo(a.x); qd[1] = bfhi(a.x); qd[2] = bflo(a.y); qd[3] = bfhi(a.y);
              gd[0] = exp2f(bflo(l.x)); gd[1] = exp2f(bfhi(l.x)); gd[2] = exp2f(bflo(l.y)); gd[3] = exp2f(bfhi(l.y));
              vd[0] = bflo(i2.x); vd[1] = bfhi(i2.x); vd[2] = bflo(i2.y); vd[3] = bfhi(i2.y); }
            __syncthreads();
            for (int s = 0; s < 16; ++s) {
                const float vval = v_s[s * 128 + vv]; float acc = 0.f;
#pragma unroll
                for (int i = 0; i < 32; ++i) { const float gk = g_s[s * 128 + kq * 32 + i]; S[i] = gk * S[i] + (1.0f - gk) * vval; acc += q_s[s * 128 + kq * 32 + i] * S[i]; }
                part[(s * 4 + kq) * 128 + vv] = acc;
            }
            __syncthreads();
#pragma unroll
            for (int ss = 0; ss < 2; ++ss) { const int s = wave * 2 + ss; const int t = t0 + s;
                float o0 = 0.f, o1 = 0.f;
#pragma unroll
                for (int k = 0; k < 4; ++k) { o0 += part[(s * 4 + k) * 128 + lane]; o1 += part[(s * 4 + k) * 128 + 64 + lane]; }
                const float ssq = wave_sum(o0 * o0 + o1 * o1); const float rs = rsqrtf(ssq * (1.0f / HGD) + EPS);
                const size_t off = base + (size_t)t * DM;
                const float y0 = o0 * rs * gnorm[h * HGD + lane] * bfu2f(P3[off + lane]), y1 = o1 * rs * gnorm[h * HGD + 64 + lane] * bfu2f(P3[off + 64 + lane]);
                P0[off + lane] = (bf16)f2bf(y0); P0[off + 64 + lane] = (bf16)f2bf(y1); }
        }
    }
}

__device__ __forceinline__ void final_norm(const bf16* XBp, const float* gfin, float* out, int wave_s) {
    const int tid = opaque_tid(wave_s), lane = tid & 63, gw = blockIdx.x * NWAVES + __builtin_amdgcn_readfirstlane(tid >> 6), NGW = gridDim.x * NWAVES;
    constexpr int RB = 4;
    f32x4 g[2][2];
#pragma unroll
    for (int j = 0; j < 2; ++j)
#pragma unroll
        for (int q = 0; q < 2; ++q) g[j][q] = *(const f32x4*)(gfin + 512 * j + 8 * lane + 4 * q);
    for (int m0 = RB * gw; m0 < TT; m0 += RB * NGW) {
        v4u a[RB], b[RB];
#pragma unroll
        for (int i = 0; i < RB; ++i) { const bf16* xr = XBp + ((size_t)(lane >> 3) * TT + m0 + i) * 64 + 8 * (lane & 7);
            a[i] = *(const v4u*)xr; b[i] = *(const v4u*)(xr + (size_t)8 * TT * 64); }
#pragma unroll
        for (int i = 0; i < RB; ++i) {
            float v[16] = {bflo(a[i].x), bfhi(a[i].x), bflo(a[i].y), bfhi(a[i].y), bflo(a[i].z), bfhi(a[i].z), bflo(a[i].w), bfhi(a[i].w),
                           bflo(b[i].x), bfhi(b[i].x), bflo(b[i].y), bfhi(b[i].y), bflo(b[i].z), bfhi(b[i].z), bflo(b[i].w), bfhi(b[i].w)};
            float s = 0.f;
#pragma unroll
            for (int k = 0; k < 16; ++k) s += v[k] * v[k];
            s = wave_sum(s); const float rs = rsqrtf(s * (1.0f / DM) + EPS);
#pragma unroll
            for (int j = 0; j < 2; ++j)
#pragma unroll
                for (int q = 0; q < 2; ++q) { const int col = 512 * j + 8 * lane + 4 * q;
                    f32x4 o; o[0] = v[8 * j + 4 * q + 0] * rs * g[j][q][0]; o[1] = v[8 * j + 4 * q + 1] * rs * g[j][q][1]; o[2] = v[8 * j + 4 * q + 2] * rs * g[j][q][2]; o[3] = v[8 * j + 4 * q + 3] * rs * g[j][q][3];
                    *(f32x4*)(out + (size_t)(m0 + i) * DM + col) = o; }
        }
    }
}

#ifndef MK_DUP_G2
#define MK_DUP_G2 0
#endif
#ifndef MK_DUP_GQ
#define MK_DUP_GQ 0
#endif
#ifndef MK_DUP_SCAN
#define MK_DUP_SCAN 0
#endif
#ifndef MK_DUP_ATTN
#define MK_DUP_ATTN 0
#endif
#ifndef MK_DUP_FFN
#define MK_DUP_FFN 0
#endif
#ifndef MK_DUP_PRO
#define MK_DUP_PRO 0
#endif
#ifndef MK_DUP_CONV
#define MK_DUP_CONV 0
#endif
#ifndef MK_EXTRA_BAR
#define MK_EXTRA_BAR 0
#endif
#ifndef MK_SCAN_MFMA
#define MK_SCAN_MFMA 1
#endif
#ifndef MK_ATTN_MFMA
#define MK_ATTN_MFMA 1
#endif
#ifndef MK_G6_REV
#define MK_G6_REV 0
#endif
#ifndef MK_ALIGN_EPI
#define MK_ALIGN_EPI true
#endif
#ifndef MK_SP2
#define MK_SP2 true
#endif
#ifndef MK_NAIVE_GEMM
#define MK_NAIVE_GEMM 1
#endif
#if MK_NAIVE_GEMM
#define RUN_GEMM(EPI_T, g_, S_, E_) pg8::gemm_phase_naive<EPI_T, pg8::StaticOrder>(g_, S_, E_)
#else
#define RUN_GEMM(EPI_T, g_, S_, E_) pg8::gemm_phase<EPI_T, pg8::StaticOrder, MK_ALIGN_EPI, MK_SP2>(lds + RING_OFF, g_, S_, E_, wave_s)
#endif

__global__ void __launch_bounds__(NWAVES * 64, 2) mk_fwd(Params p) {
    extern __shared__ __attribute__((aligned(16))) unsigned char lds_raw[];
    LAS unsigned char* lds = (LAS unsigned char*)lds_raw;
    volatile LAS unsigned* MISC = (volatile LAS unsigned*)(lds + MISC_OFF);
    const int tid = threadIdx.x;
    const int wave_s = __builtin_amdgcn_readfirstlane(tid >> 6);
    const int G = gridDim.x, bid = blockIdx.x;
    unsigned char* const ws0 = p.ws;
    gu32* ctl = (gu32*)(ws0 + WS_CTL);
    for (int u = tid; u < (LDS_BYTES - LDSCTL_OFF) / 4; u += NWAVES * 64) ((LAS unsigned*)(lds + LDSCTL_OFF))[u] = 0u;
    __syncthreads();
    XcdBarrier bar = xcd_barrier_post((unsigned*)(ctl + CW_BAR), MISC + 8);
#define GRID_BAR() xcd_barrier(bar)

#define OPQ_WS() (ws0)

    p0_prologue(p, lds, wave_s);
#if MK_DUP_PRO
    p0_prologue(p, lds, wave_s);
#endif
    GRID_BAR();

#pragma unroll 1
    for (int l = 0; l < 2; ++l) {
        unsigned char* ws = OPQ_WS();
        { pg8::Gemm g{(const pg8::bf16_t*)(ws + WS_MEMB), (const pg8::bf16_t*)(ws + WS_WKV + l * SZ_WKV), TMEM, 1024, 1024}; pg8::StaticOrder S; S.init(TMEM, 1024, G, (bid + G - (128 * l) % G) % G);
          pg8::EpiScale E{(pg8::bf16_t*)(ws + WS_KV + l * SZ_KV), 1024, nullptr, (const float*)(ws + WS_RMEM), 1.0f};
          RUN_GEMM(pg8::EpiScale, g, S, E); }
        { pg8::Gemm g{(const pg8::bf16_t*)(ws + WS_WKV + l * SZ_WKV) + 1024 * 1024, (const pg8::bf16_t*)(ws + WS_MEMB), 1024, TMEM, 1024}; pg8::StaticOrder S; S.init(1024, TMEM, G, (bid + G - (128 * l + 64) % G) % G);
          pg8::EpiColScale E{(pg8::bf16_t*)(ws + WS_KV + l * SZ_KV + OFF_VT), TMEM, (const float*)(ws + WS_RMEM)};
          RUN_GEMM(pg8::EpiColScale, g, S, E); }
    }

#pragma unroll 1
    for (int l = 0; l < 2; ++l) {
        unsigned char* ws = OPQ_WS();
        float* SSQ = (float*)(ws + WS_SSQ);
        pg8::bf16_t* XB = (pg8::bf16_t*)(ws + WS_XB);
        pg8::bf16_t* P0 = (pg8::bf16_t*)(ws + WS_P), *P1 = (pg8::bf16_t*)(ws + WS_P + SZ_P), *P2 = (pg8::bf16_t*)(ws + WS_P + 2 * SZ_P), *P3 = (pg8::bf16_t*)(ws + WS_P + 3 * SZ_P);
        pg8::bf16_t* HB = P0;
        if (l == 0) {
            { pg8::Gemm g{XB, (const pg8::bf16_t*)(ws + WS_WCIN), TT, 3072, 1024, 64, (size_t)TT * 128, 64, (size_t)3072 * 128}; pg8::StaticOrder S; S.init(TT, 3072, G, bid);
              pg8::EpiPair<0> E{P0, 1024, P1, SSQ};
              RUN_GEMM(pg8::EpiPair<0>, g, S, E); }
            GRID_BAR();
            conv_pass(P0, P1, p.in[4], P2, wave_s);
#if MK_DUP_CONV
            conv_pass(P0, P1, p.in[4], P2, wave_s);
#endif
            GRID_BAR();
            { pg8::Gemm g{P2, (const pg8::bf16_t*)(ws + WS_WCOUT), TT, 1024, 1024, 64, (size_t)TT * 128, 64, (size_t)1024 * 128}; pg8::StaticOrder S; S.init(TT, 1024, G, bid);
              pg8::EpiResid E{XB, SSQ, 1.0f};
              RUN_GEMM(pg8::EpiResid, g, S, E);
#if MK_DUP_G2
              RUN_GEMM(pg8::EpiResid, g, S, E);
#endif
            }
            GRID_BAR();
        } else {
            { pg8::Gemm g{XB, (const pg8::bf16_t*)(ws + WS_WHIN), TT, 4096, 1024, 64, (size_t)TT * 128, 64, (size_t)4096 * 128}; pg8::StaticOrder S; S.init(TT, 4096, G, bid);
              pg8::EpiHgrn E{P0, (size_t)TT * DM, SSQ, (const float*)(ws + WS_LB)};
              RUN_GEMM(pg8::EpiHgrn, g, S, E); }
            GRID_BAR();
#if MK_SCAN_MFMA
            late_weights(p, lds, wave_s);
            hg::scan_phase(lds, P0, P1, P2, P3, p.in[8], (bf16*)(ws + WS_Y), wave_s);
#if MK_DUP_SCAN
            hg::scan_phase(lds, P0, P1, P2, P3, p.in[8], (bf16*)(ws + WS_Y), wave_s);
#endif
            GRID_BAR();
            { pg8::Gemm g{(const pg8::bf16_t*)(ws + WS_Y), (const pg8::bf16_t*)(ws + WS_WHOUT), TT, 1024, 1024, 64, (size_t)TT * 128, 64, (size_t)1024 * 128};
#else
            scan_naive(P0, P1, P2, P3, p.in[8], lds_raw, G);
            GRID_BAR();
            { pg8::Gemm g{P0, (const pg8::bf16_t*)(ws + WS_WHOUT), TT, 1024, 1024};
#endif
              pg8::StaticOrder S; S.init(TT, 1024, G, bid);
              pg8::EpiResid E{XB, SSQ, 1.0f};
              RUN_GEMM(pg8::EpiResid, g, S, E); }
            GRID_BAR();
        }
        { pg8::Gemm g{XB, (const pg8::bf16_t*)(ws + WS_WQ + l * SZ_WQ), TT, 1024, 1024, 64, (size_t)TT * 128, 64, (size_t)1024 * 128}; pg8::StaticOrder S; S.init(TT, 1024, G, bid);
          pg8::EpiScale E{P0, 1024, SSQ, nullptr, QSCALE};
          RUN_GEMM(pg8::EpiScale, g, S, E);
#if MK_DUP_GQ
          if (l == 0) { RUN_GEMM(pg8::EpiScale, g, S, E); }
#endif
        }
#if MK_ATTN_MFMA
        asm volatile("s_waitcnt vmcnt(0) lgkmcnt(0)" ::: "memory"); __syncthreads();
#else
        GRID_BAR();
#endif
#if MK_ATTN_MFMA
        xat::attn_phase(lds, P0, (const bf16*)(ws + WS_KV + l * SZ_KV), (const bf16*)(ws + WS_KV + l * SZ_KV + OFF_VT), P1, wave_s);
#if MK_DUP_ATTN
        xat::attn_phase(lds, P0, (const bf16*)(ws + WS_KV + l * SZ_KV), (const bf16*)(ws + WS_KV + l * SZ_KV + OFF_VT), P1, wave_s);
#endif
#else
        attn_naive(P0, (const bf16*)(ws + WS_KV + l * SZ_KV), (const bf16*)(ws + WS_KV + l * SZ_KV + OFF_VT), P1, wave_s);
#endif
        GRID_BAR();
        { pg8::Gemm g{P1, (const pg8::bf16_t*)(ws + WS_WO + l * SZ_WO), TT, 1024, 1024, 64, (size_t)TT * 128, 64, (size_t)1024 * 128}; pg8::StaticOrder S; S.init(TT, 1024, G, bid);
          pg8::EpiResid E{XB, SSQ, 1.0f};
          RUN_GEMM(pg8::EpiResid, g, S, E); }
        GRID_BAR();
        { pg8::Gemm g{XB, (const pg8::bf16_t*)(ws + WS_WFIN + l * SZ_WFIN), TT, 2 * DFF, 1024, 64, (size_t)TT * 128, 64, (size_t)(2 * DFF) * 128}; pg8::StaticOrder S; S.init(TT, 2 * DFF, G, bid);
          pg8::EpiPair<1> E{HB, DFF, nullptr, SSQ};
          RUN_GEMM(pg8::EpiPair<1>, g, S, E);
#if MK_DUP_FFN
          if (l == 0) { RUN_GEMM(pg8::EpiPair<1>, g, S, E); }
#endif
        }
        GRID_BAR();
        { pg8::Gemm g{HB, (const pg8::bf16_t*)(ws + WS_WFOUT + l * SZ_WFOUT), TT, 1024, DFF, 64, (size_t)TT * 128, 64, (size_t)1024 * 128};     pg8::StaticOrder S; S.init(TT, 1024, G, bid, MK_G6_REV);
          pg8::EpiResid E{XB, SSQ, 1.0f};
          RUN_GEMM(pg8::EpiResid, g, S, E);
#if MK_DUP_G6
          if (l == 0) { pg8::EpiResid E0{XB, SSQ, 0.0f}; RUN_GEMM(pg8::EpiResid, g, S, E0); }
#endif
        }
        GRID_BAR();
    }
#if MK_EXTRA_BAR
#pragma unroll 1
    for (int eb = 0; eb < MK_EXTRA_BAR; ++eb) GRID_BAR();
#endif
    final_norm((const bf16*)(OPQ_WS() + WS_XB), p.in[18], p.out, wave_s);
}

extern "C" void kernel_launch(void* const* d_in, const int* in_sizes, int n_in, void* d_out, int out_size, void* d_ws, size_t ws_size, hipStream_t stream) {
    static int grid = 0;
    if (grid == 0) {
        if (n_in != 19 || out_size != TT * DM || ws_size < WS_END) { fprintf(stderr, "kernel_launch: unexpected shapes (n_in %d, out %d, ws %zu); nothing launched\n", n_in, out_size, ws_size); grid = -1; return; }
        int dev = 0, cus = 0, per_cu = 0;
        if (hipGetDevice(&dev) != hipSuccess || hipDeviceGetAttribute(&cus, hipDeviceAttributeMultiprocessorCount, dev) != hipSuccess) { fprintf(stderr, "kernel_launch: device query failed\n"); grid = -1; return; }
        if (hipFuncSetAttribute((const void*)mk_fwd, hipFuncAttributeMaxDynamicSharedMemorySize, LDS_BYTES) != hipSuccess) { fprintf(stderr, "kernel_launch: hipFuncSetAttribute failed\n"); grid = -1; return; }
        if (hipOccupancyMaxActiveBlocksPerMultiprocessor(&per_cu, (const void*)mk_fwd, NWAVES * 64, LDS_BYTES) != hipSuccess || per_cu < 1) { fprintf(stderr, "kernel_launch: occupancy query says %d blocks per CU\n", per_cu); per_cu = 1; }
        (void)hipGetLastError();
        grid = cus;
    }
    if (grid < 0) return;
    if (hipMemsetAsync((char*)d_ws + WS_CTL, 0, CTL_ZERO_BYTES, stream) != hipSuccess) { fprintf(stderr, "kernel_launch: memset failed\n"); return; }
    Params a{};
    for (int i = 0; i < 19; ++i) a.in[i] = (const float*)d_in[i];
    a.out = (float*)d_out; a.ws = (unsigned char*)d_ws;
    hipLaunchKernelGGL(mk_fwd, dim3(grid), dim3(NWAVES * 64), LDS_BYTES, stream, a);
    const hipError_t le = hipPeekAtLastError();
    if (le != hipSuccess) fprintf(stderr, "kernel_launch: launch failed: %s\n", hipGetErrorName(le));
}
```

```cpp
#define MK_NAIVE_GEMM 0
#include <hip/hip_runtime.h>
#include <cstdio>
#include <cstdint>
namespace pg8 {
#define PG8_LAS __attribute__((address_space(3)))
typedef unsigned short bf16_t;
typedef short bf16x8 __attribute__((ext_vector_type(8)));
typedef float f32x4 __attribute__((ext_vector_type(4)));
typedef unsigned u32x4 __attribute__((ext_vector_type(4)));
constexpr int BM = 256, BK = 64, HALF = 128, HTB = HALF * BK * 2  , STAGE_BYTES = 8 * HTB, NXCD = 8, WGM = 8;

__host__ __device__ __forceinline__ int lds_byte(int r, int c) { const int st = (r >> 4) * 2 + (c >> 5), rr = r & 15, cc = c & 31, ob = rr * 64 + cc * 2; return st * 1024 + (ob ^ (((ob >> 9) & 1) << 5)); }
__host__ __device__ __forceinline__ void stage_rc(int b, int& R, int& C) { const int st = b / 1024, sb = b % 1024, swz = sb ^ (((sb >> 9) & 1) << 5); R = (st >> 1) * 16 + swz / 64; C = (st & 1) * 32 + (swz % 64) / 2; }
__host__ __device__ __forceinline__ int perm32(int rho) { const int n = rho >> 4, i = rho & 15; return 8 * (i >> 2) + 4 * n + (i & 3); }

struct Unit { int pm, pn, idx; };
struct Gemm { const bf16_t* A; const bf16_t* Bt; int M, N, K; int lda; size_t kstepA; int ldb; size_t kstepB; };

struct StaticOrder {
    int nM, nN, nwg, G, c, rev;
    __host__ __device__ void init(int M, int N, int G_, int c_, int rev_ = 0) { nM = M / BM; nN = N / BM; nwg = nM * nN; G = G_; c = c_; rev = rev_; }
    __host__ __device__ bool next(int i, Unit& u) const {
        const long L = (long)i * G + c; if (L >= nwg) return false;
        int wgid = (int)L; { const int q = nwg / NXCD, r = nwg % NXCD, xcd = wgid % NXCD, off = wgid / NXCD; wgid = (xcd < r ? xcd * (q + 1) : r * (q + 1) + (xcd - r) * q) + off; }
        const int nig = WGM * nN, gid = wgid / nig, fm = gid * WGM, gsz = (nM - fm) < WGM ? (nM - fm) : WGM;
        u.pm = fm + ((wgid % nig) % gsz); u.pn = (wgid % nig) / gsz; if (rev) u.pm = nM - 1 - u.pm; return true;
    }
    __device__ __forceinline__ void a_ready(const Unit&) const {}
    __device__ __forceinline__ void done(const Unit&) const {}
};

typedef float f32x2_cv __attribute__((ext_vector_type(2))); typedef __bf16 bf16x2_cv __attribute__((ext_vector_type(2)));
__device__ __forceinline__ unsigned cvt_pk_bf16(float lo, float hi) { f32x2_cv v = {lo, hi}; bf16x2_cv b = __builtin_convertvector(v, bf16x2_cv); return __builtin_bit_cast(unsigned, b); }
__device__ __forceinline__ float xor16_get(float x) { return __int_as_float(__builtin_amdgcn_ds_swizzle(__float_as_int(x), 0x401F)); }
__device__ __forceinline__ float xor32_sum(float x) { const auto rr = __builtin_amdgcn_permlane32_swap(__float_as_uint(x), __float_as_uint(x), false, false); return __uint_as_float(rr[0]) + __uint_as_float(rr[1]); }
__device__ __forceinline__ float xor32_max(float x) { const auto rr = __builtin_amdgcn_permlane32_swap(__float_as_uint(x), __float_as_uint(x), false, false); return fmaxf(__uint_as_float(rr[0]), __uint_as_float(rr[1])); }
__device__ __forceinline__ float lane_get(float x, int srclane) { return __int_as_float(__builtin_amdgcn_ds_bpermute(srclane << 2, __float_as_int(x))); }
typedef unsigned u32x2 __attribute__((ext_vector_type(2)));
constexpr int TT_ROWS = 32768;
__device__ __forceinline__ void rs_rows(const float* ssq, const float* rdirect, int rowbase, int lane, float (&v)[2]) {
#pragma unroll
    for (int ai = 0; ai < 2; ++ai) {
        const int row = rowbase + ai * HALF + lane;
        if (rdirect) v[ai] = rdirect[row];
        else { const f32x4* sp = (const f32x4*)(ssq + (size_t)row * 16);
            const f32x4 s0 = sp[0], s1 = sp[1], s2 = sp[2], s3 = sp[3];
            const float s = (((s0[0] + s0[1]) + (s0[2] + s0[3])) + ((s1[0] + s1[1]) + (s1[2] + s1[3]))) + (((s2[0] + s2[1]) + (s2[2] + s2[3])) + ((s3[0] + s3[1]) + (s3[2] + s3[3])));
            v[ai] = rsqrtf(s * (1.0f / 1024.0f) + 1e-6f); }
    }
}
__device__ __forceinline__ float sigm_f(float x) { return __builtin_amdgcn_rcpf(1.0f + __builtin_amdgcn_exp2f(x * -1.4426950408889634f)); }
constexpr int RS_TABLE_OFF = 131072 + 2048, RS_MAX_UNITS = 14;
template <class Sched> __device__ __forceinline__ void fill_rs_table(const Sched& S, const float* ssq, const float* rdirect, PG8_LAS float* RS, int tid) {
    Unit u;
#pragma unroll 1
    for (int i0 = 0; i0 < RS_MAX_UNITS; i0 += 2) { const int i = i0 + (tid >> 8);
        if (S.next(i, u)) { const int row = u.pm * BM + (tid & 255);
          if (rdirect) RS[i * 256 + (tid & 255)] = rdirect[row];
          else { const f32x4* sp = (const f32x4*)(ssq + (size_t)row * 16);
            const f32x4 s0 = sp[0], s1 = sp[1], s2 = sp[2], s3 = sp[3];
            const float s = (((s0[0] + s0[1]) + (s0[2] + s0[3])) + ((s1[0] + s1[1]) + (s1[2] + s1[3]))) + (((s2[0] + s2[1]) + (s2[2] + s2[3])) + ((s3[0] + s3[1]) + (s3[2] + s3[3])));
            RS[i * 256 + (tid & 255)] = rsqrtf(s * (1.0f / 1024.0f) + 1e-6f); } }
        if (!S.next(i0 + 2, u)) break; }
    asm volatile("s_waitcnt vmcnt(0) lgkmcnt(0)\n\ts_barrier" ::: "memory");
}
__device__ __forceinline__ float silu_f(float x) { return x * sigm_f(x); }
__device__ __forceinline__ u32x4 pack8(const f32x4 v0, const f32x4 v1) { u32x4 w; w.x = cvt_pk_bf16(v0[0], v0[1]); w.y = cvt_pk_bf16(v0[2], v0[3]); w.z = cvt_pk_bf16(v1[0], v1[1]); w.w = cvt_pk_bf16(v1[2], v1[3]); return w; }

template <int MODE> struct EpiPair {
    static constexpr bool PERM = true, AFTER_DRAIN = false, IDEMP = true;
    bf16_t* OUT; int ldo; bf16_t* GB; const float* ssq; PG8_LAS float* rst;
    template <class Sched> __device__ __forceinline__ void prepare(const Sched& S, int tid) const { fill_rs_table(S, ssq, nullptr, rst, tid); }
    __device__ __forceinline__ void operator()(const f32x4 (&acc)[2][2][4][2], const Unit& u, int wr, int wc, int fr, int fq) const {
        const int row0 = u.pm * BM + wr * 64 + fr;
        const PG8_LAS float* rsp = rst + u.idx * 256 + wr * 64 + fr;
        if (MODE == 0 && u.pn >= 8) {
            const int col0 = (u.pn - 8) * 256 + wc * 32 + 8 * fq;
#pragma unroll
            for (int ai = 0; ai < 2; ++ai)
#pragma unroll
                for (int m = 0; m < 4; ++m) { const int row = row0 + ai * HALF + m * 16; const float rs = rsp[ai * HALF + m * 16]; bf16_t* rowp = GB + (size_t)row * 1024 + col0;
#pragma unroll
                    for (int bj = 0; bj < 2; ++bj) *(u32x4*)(rowp + bj * HALF) = pack8(acc[ai][bj][m][0] * rs, acc[ai][bj][m][1] * rs); }
        } else {
            const int col0 = u.pn * 128 + wc * 32 + 8 * fq;
#if MK_EPI_REP
#pragma unroll 1
            for (int rep_ = 0; rep_ < (MODE == 1 ? 2 : 1); ++rep_)
#endif
#pragma unroll
            for (int ai = 0; ai < 2; ++ai)
#pragma unroll
                for (int m = 0; m < 4; ++m) { const int row = row0 + ai * HALF + m * 16; const float rs = rsp[ai * HALF + m * 16];
                    const f32x4 a0 = acc[ai][0][m][0] * rs, a1 = acc[ai][0][m][1] * rs, b0 = acc[ai][1][m][0] * rs, b1 = acc[ai][1][m][1] * rs; f32x4 v0, v1;
                    if (MODE == 0) { v0 = a0 * b0; v1 = a1 * b1; }
                    else {
#pragma unroll
                        for (int j = 0; j < 4; ++j) { v0[j] = silu_f(a0[j]) * b0[j]; v1[j] = silu_f(a1[j]) * b1[j]; } }
                    if (MODE == 1) {
                        const int kt = 2 * u.pn + (wc >> 1), within = (wc & 1) * 32 + 8 * fq;
                        *(u32x4*)(OUT + ((size_t)kt * TT_ROWS + row) * 64 + within) = pack8(v0, v1);
                    } else *(u32x4*)(OUT + (size_t)row * ldo + col0) = pack8(v0, v1); }
        }
    }
};
struct EpiResid {
    static constexpr bool PERM = true, AFTER_DRAIN = false, IDEMP = false;
    bf16_t* xb; float* ssq; float sc;
    template <class Sched> __device__ __forceinline__ void prepare(const Sched&, int) const {}
    __device__ __forceinline__ void operator()(const f32x4 (&acc)[2][2][4][2], const Unit& u, int wr, int wc, int fr, int fq) const {
        const int row0 = u.pm * BM + wr * 64 + fr;
        bf16_t* rp[2]; u32x4 bres[2][4][2];
#pragma unroll
        for (int bj = 0; bj < 2; ++bj) rp[bj] = xb + ((size_t)(4 * u.pn + 2 * bj + (wc >> 1)) * TT_ROWS + row0) * 64 + (wc & 1) * 32 + 8 * fq;
#pragma unroll
        for (int ai = 0; ai < 2; ++ai)
#pragma unroll
            for (int m = 0; m < 4; ++m)
#pragma unroll
                for (int bj = 0; bj < 2; ++bj) bres[ai][m][bj] = *(const u32x4*)(rp[bj] + (size_t)(ai * HALF + m * 16) * 64);
#pragma unroll
        for (int ai = 0; ai < 2; ++ai)
#pragma unroll
            for (int m = 0; m < 4; ++m) { const int row = row0 + ai * HALF + m * 16; float sq = 0.f;
#pragma unroll
                for (int bj = 0; bj < 2; ++bj) { const u32x4 b = bres[ai][m][bj];
                    f32x4 o0 = acc[ai][bj][m][0] * sc, o1 = acc[ai][bj][m][1] * sc;
                    o0[0] += __uint_as_float(b.x << 16); o0[1] += __uint_as_float(b.x & 0xffff0000u); o0[2] += __uint_as_float(b.y << 16); o0[3] += __uint_as_float(b.y & 0xffff0000u);
                    o1[0] += __uint_as_float(b.z << 16); o1[1] += __uint_as_float(b.z & 0xffff0000u); o1[2] += __uint_as_float(b.w << 16); o1[3] += __uint_as_float(b.w & 0xffff0000u);
                    const u32x4 w = pack8(o0, o1); *(u32x4*)(rp[bj] + (size_t)(ai * HALF + m * 16) * 64) = w;
                    const float r0 = __uint_as_float(w.x << 16), r1 = __uint_as_float(w.x & 0xffff0000u), r2 = __uint_as_float(w.y << 16), r3 = __uint_as_float(w.y & 0xffff0000u);
                    const float r4 = __uint_as_float(w.z << 16), r5 = __uint_as_float(w.z & 0xffff0000u), r6 = __uint_as_float(w.w << 16), r7 = __uint_as_float(w.w & 0xffff0000u);
                    sq += ((r0 * r0 + r1 * r1) + (r2 * r2 + r3 * r3)) + ((r4 * r4 + r5 * r5) + (r6 * r6 + r7 * r7)); }
                sq += xor16_get(sq); sq = xor32_sum(sq);
                if (fq == 0) ssq[(size_t)row * 16 + (u.pn * 4 + wc)] = sq; }
    }
};
struct EpiScale {
    static constexpr bool PERM = true, AFTER_DRAIN = false, IDEMP = true;
    bf16_t* O; int ldc; const float* ssq; const float* rdirect; float scale; PG8_LAS float* rst;
    template <class Sched> __device__ __forceinline__ void prepare(const Sched& S, int tid) const { fill_rs_table(S, ssq, rdirect, rst, tid); }
    __device__ __forceinline__ void operator()(const f32x4 (&acc)[2][2][4][2], const Unit& u, int wr, int wc, int fr, int fq) const {
        const int row0 = u.pm * BM + wr * 64 + fr, col0 = u.pn * BM + wc * 32 + 8 * fq;
        const PG8_LAS float* rsp = rst + u.idx * 256 + wr * 64 + fr;
#pragma unroll
        for (int ai = 0; ai < 2; ++ai)
#pragma unroll
            for (int m = 0; m < 4; ++m) { const int row = row0 + ai * HALF + m * 16; const float rs = rsp[ai * HALF + m * 16] * scale; bf16_t* rowp = O + (size_t)row * ldc + col0;
#pragma unroll
                for (int bj = 0; bj < 2; ++bj) *(u32x4*)(rowp + bj * HALF) = pack8(acc[ai][bj][m][0] * rs, acc[ai][bj][m][1] * rs); }
    }
};
struct EpiHgrn {
    static constexpr bool PERM = true, AFTER_DRAIN = false, IDEMP = true;
    bf16_t* P; size_t pstride; const float* ssq; const float* lb; PG8_LAS float* rst;
    template <class Sched> __device__ __forceinline__ void prepare(const Sched& S, int tid) const { fill_rs_table(S, ssq, nullptr, rst, tid); }
    __device__ __forceinline__ void operator()(const f32x4 (&acc)[2][2][4][2], const Unit& u, int wr, int wc, int fr, int fq) const {
        const int row0 = u.pm * BM + wr * 64 + fr, type = u.pn >> 2, col0 = (u.pn & 3) * BM + wc * 32 + 8 * fq;
        const int bb = u.pm >> 3, t0 = (u.pm & 7) * BM + wr * 64 + fr;
        bf16_t* base = P + (size_t)type * pstride + ((size_t)(bb * 8 + (u.pn & 3) * 2) * 2048 + t0) * 128 + wc * 32 + 8 * fq;
        const PG8_LAS float* rsp = rst + u.idx * 256 + wr * 64 + fr;
        if (type == 1) {
#pragma unroll
            for (int bj = 0; bj < 2; ++bj) {
                const f32x4 l0 = *(const f32x4*)(lb + col0 + bj * HALF), l1 = *(const f32x4*)(lb + col0 + bj * HALF + 4);
#pragma unroll
                for (int ai = 0; ai < 2; ++ai)
#pragma unroll
                    for (int m = 0; m < 4; ++m) { const float rs = rsp[ai * HALF + m * 16]; f32x4 v0, v1;
#pragma unroll
                        for (int j = 0; j < 4; ++j) { const float s0 = sigm_f(acc[ai][bj][m][0][j] * rs), s1 = sigm_f(acc[ai][bj][m][1][j] * rs);
                            v0[j] = __log2f(l0[j] + (1.0f - l0[j]) * s0); v1[j] = __log2f(l1[j] + (1.0f - l1[j]) * s1); }
                        *(u32x4*)(base + (size_t)(ai * HALF + m * 16) * 128 + (size_t)bj * (2048 * 128)) = pack8(v0, v1); }
            }
        } else if (type == 2) {
#pragma unroll
            for (int ai = 0; ai < 2; ++ai)
#pragma unroll
                for (int m = 0; m < 4; ++m) { const float rs = rsp[ai * HALF + m * 16];
#pragma unroll
                    for (int bj = 0; bj < 2; ++bj) *(u32x4*)(base + (size_t)(ai * HALF + m * 16) * 128 + (size_t)bj * (2048 * 128)) = pack8(acc[ai][bj][m][0] * rs, acc[ai][bj][m][1] * rs); }
        } else {
#pragma unroll
            for (int ai = 0; ai < 2; ++ai)
#pragma unroll
                for (int m = 0; m < 4; ++m) { const float rs = rsp[ai * HALF + m * 16];
#pragma unroll
                    for (int bj = 0; bj < 2; ++bj) { f32x4 v0, v1;
#pragma unroll
                        for (int j = 0; j < 4; ++j) { v0[j] = silu_f(acc[ai][bj][m][0][j] * rs); v1[j] = silu_f(acc[ai][bj][m][1][j] * rs); }
                        *(u32x4*)(base + (size_t)(ai * HALF + m * 16) * 128 + (size_t)bj * (2048 * 128)) = pack8(v0, v1); } }
        }
    }
};
struct EpiColScale {
    static constexpr bool PERM = true, AFTER_DRAIN = false, IDEMP = true;
    bf16_t* O; int ldc; const float* cs;
    template <class Sched> __device__ __forceinline__ void prepare(const Sched&, int) const {}
    __device__ __forceinline__ void operator()(const f32x4 (&acc)[2][2][4][2], const Unit& u, int wr, int wc, int fr, int fq) const {
        const int row0 = u.pm * BM + wr * 64 + fr, col0 = u.pn * BM + wc * 32 + 8 * fq;
#pragma unroll
        for (int bj = 0; bj < 2; ++bj) { const f32x4 c0 = *(const f32x4*)(cs + col0 + bj * HALF), c1 = *(const f32x4*)(cs + col0 + bj * HALF + 4);
#pragma unroll
            for (int ai = 0; ai < 2; ++ai)
#pragma unroll
                for (int m = 0; m < 4; ++m) *(u32x4*)(O + (size_t)(row0 + ai * HALF + m * 16) * ldc + col0 + bj * HALF) = pack8(acc[ai][bj][m][0] * c0, acc[ai][bj][m][1] * c1); }
    }
};
template <class Epi, class Sched, bool ALIGN_EPI = false, bool SP2 = false>
__device__ __forceinline__ void gemm_phase(PG8_LAS unsigned char* lds, const Gemm g, const Sched& S, const Epi& E, const int wave_s) {
    unsigned z_ = 0u; asm volatile("" : "+v"(z_));
    int tid_ = (wave_s << 6) | (int)__builtin_amdgcn_mbcnt_hi(~0u, __builtin_amdgcn_mbcnt_lo(~0u, z_)); asm volatile("" : "+v"(tid_));
    const int tid = tid_, wid = __builtin_amdgcn_readfirstlane(tid >> 6), lane = tid & 63, wr = wid >> 2, wc = wid & 3, fr = lane & 15, fq = lane >> 4;
    const int K = g.K, nt = K / BK;
    const int lda = g.lda ? g.lda : K, ldb = g.ldb ? g.ldb : K;
    unsigned voffA[2], voffB[2];
#pragma unroll
    for (int i = 0; i < 2; ++i) { int R, C; stage_rc(tid * 16 + i * 8192, R, C); const int Rb = Epi::PERM ? ((R & ~31) + perm32(R & 31)) : R;
        voffA[i] = (unsigned)(R * lda + C) * 2u; voffB[i] = (unsigned)(Rb * ldb + C) * 2u; }
    const size_t kstep = (size_t)(BK * 2);
    const size_t kstepA = g.kstepA ? g.kstepA : kstep, hstepA = (size_t)HALF * lda * 2, tstepA = 2 * hstepA;
    const size_t hstep = (size_t)HALF * ldb * 2;
    const size_t kstepB = g.kstepB ? g.kstepB : kstep;
    const size_t tstep = 2 * hstep;
    const unsigned ldsw = (unsigned)wid * 1024u;
    const int aoff = lds_byte(wr * 64 + fr, fq * 8), boff = lds_byte(wc * 32 + fr, fq * 8);
#define PG8_SA(b, h) (((b) * 2 + (h)) * HTB)
#define PG8_SB(b, h) ((4 + (b) * 2 + (h)) * HTB)
#define PG8_STAGE(bufoff, gbase, voff) do { _Pragma("unroll") for (int _i = 0; _i < 2; ++_i) \
        __builtin_amdgcn_global_load_lds((const unsigned*)((const char*)(gbase) + (voff)[_i]), (PG8_LAS unsigned*)(lds + (bufoff) + ldsw + _i * 8192), 16, 0, 0); } while (0)
#define PG8_LDA(dst, b, h) do { _Pragma("unroll") for (int m = 0; m < 4; ++m) _Pragma("unroll") for (int k = 0; k < 2; ++k) dst[m][k] = *(const PG8_LAS bf16x8*)(lds + PG8_SA(b, h) + aoff + m * 2048 + k * 1024); } while (0)
#define PG8_LDB(dst, b, h) do { _Pragma("unroll") for (int n = 0; n < 2; ++n) _Pragma("unroll") for (int k = 0; k < 2; ++k) dst[n][k] = *(const PG8_LAS bf16x8*)(lds + PG8_SB(b, h) + boff + n * 2048 + k * 1024); } while (0)
#define PG8_MMA(ai, bj, At, Bt) do { __builtin_amdgcn_s_setprio(1); _Pragma("unroll") for (int m = 0; m < 4; ++m) _Pragma("unroll") for (int n = 0; n < 2; ++n) _Pragma("unroll") for (int k = 0; k < 2; ++k) \
        acc[ai][bj][m][n] = __builtin_amdgcn_mfma_f32_16x16x32_bf16(Bt[n][k], At[m][k], acc[ai][bj][m][n], 0, 0, 0); __builtin_amdgcn_s_setprio(0); } while (0)
#define PG8_WAIT_V(n) asm volatile("s_waitcnt vmcnt(" #n ")" ::: "memory")
#define PG8_WAIT_L(n) asm volatile("s_waitcnt lgkmcnt(" #n ")" ::: "memory")
#define PG8_BAR __builtin_amdgcn_s_barrier()
#define PG8_SCHED __builtin_amdgcn_sched_barrier(0)
    Unit cur, nxt; int ui = 0;
    if (!S.next(0, cur)) return;
    E.prepare(S, tid);
    f32x4 acc[2][2][4][2];
#pragma unroll
    for (int a = 0; a < 2; ++a)
#pragma unroll
        for (int b = 0; b < 2; ++b)
#pragma unroll
            for (int m = 0; m < 4; ++m)
#pragma unroll
                for (int n = 0; n < 2; ++n) acc[a][b][m][n] = (f32x4){0.f, 0.f, 0.f, 0.f};
    bf16x8 At[4][2], B0[2][2], B1[2][2];
    const char* cA = (const char*)g.A + (size_t)cur.pm * tstepA; const char* cB = (const char*)g.Bt + (size_t)cur.pn * tstep;
    S.a_ready(cur);
    if constexpr (SP2) {
        PG8_STAGE(PG8_SB(0, 0), cB, voffB); PG8_STAGE(PG8_SB(0, 1), cB + hstep, voffB); PG8_STAGE(PG8_SA(0, 0), cA, voffA); PG8_STAGE(PG8_SA(0, 1), cA + hstepA, voffA);
        if (wr == 1) PG8_BAR;
        PG8_WAIT_V(2); PG8_BAR;
        PG8_STAGE(PG8_SB(1, 0), cB + kstepB, voffB); PG8_STAGE(PG8_SA(1, 0), cA + kstepA, voffA); PG8_STAGE(PG8_SB(1, 1), cB + hstep + kstepB, voffB);
        PG8_WAIT_V(6); PG8_BAR;
    } else {
        PG8_STAGE(PG8_SB(0, 0), cB, voffB); PG8_STAGE(PG8_SA(0, 0), cA, voffA); PG8_STAGE(PG8_SB(0, 1), cB + hstep, voffB); PG8_STAGE(PG8_SA(0, 1), cA + hstepA, voffA);
        if (wr == 1) PG8_BAR;
        PG8_WAIT_V(4); PG8_BAR;
        PG8_STAGE(PG8_SB(1, 0), cB + kstepB, voffB); PG8_STAGE(PG8_SA(1, 0), cA + kstepA, voffA); PG8_STAGE(PG8_SB(1, 1), cB + hstep + kstepB, voffB);
        PG8_WAIT_V(6); PG8_BAR;
    }
    for (;;) {
        const bool has_next = S.next(ui + 1, nxt);
        const char* nA = has_next ? (const char*)g.A + (size_t)nxt.pm * tstepA : cA; const char* nB = has_next ? (const char*)g.Bt + (size_t)nxt.pn * tstep : cB;
        for (int t = 0; t < nt; t += 2) {
            const bool last = (t == nt - 2);
            const char* a1 = cA + (size_t)(t + 1) * kstepA;
            const char* a2 = last ? nA : cA + (size_t)(t + 2) * kstepA; const char* b2 = last ? nB : cB + (size_t)(t + 2) * kstepB;
            const char* a3 = a2 + kstepA; const char* b3 = b2 + kstepB;
            if (last && has_next) S.a_ready(nxt);
            if constexpr (SP2) {
            PG8_LDB(B0, 0, 0); PG8_LDB(B1, 0, 1); PG8_SCHED; PG8_LDA(At, 0, 0); PG8_STAGE(PG8_SA(1, 1), a1 + hstepA, voffA);
            PG8_WAIT_V(8); PG8_WAIT_L(0); PG8_BAR; PG8_MMA(0, 0, At, B0); PG8_MMA(0, 1, At, B1); PG8_BAR; PG8_SCHED;
            PG8_LDA(At, 0, 1); PG8_STAGE(PG8_SB(0, 0), b2, voffB); PG8_STAGE(PG8_SB(0, 1), b2 + hstep, voffB); PG8_STAGE(PG8_SA(0, 0), a2, voffA);
            PG8_WAIT_V(8); PG8_WAIT_L(0); PG8_BAR; PG8_MMA(1, 0, At, B0); PG8_MMA(1, 1, At, B1); PG8_BAR; PG8_SCHED;
            PG8_LDB(B0, 1, 0); PG8_LDB(B1, 1, 1); PG8_SCHED; PG8_LDA(At, 1, 0); PG8_STAGE(PG8_SA(0, 1), a2 + hstepA, voffA);
            PG8_WAIT_V(8); PG8_WAIT_L(0); PG8_BAR; PG8_MMA(0, 0, At, B0); PG8_MMA(0, 1, At, B1); PG8_BAR; PG8_SCHED;
            PG8_LDA(At, 1, 1); PG8_STAGE(PG8_SB(1, 0), b3, voffB); PG8_STAGE(PG8_SB(1, 1), b3 + hstep, voffB); PG8_STAGE(PG8_SA(1, 0), a3, voffA);
            PG8_WAIT_V(8); PG8_WAIT_L(0); PG8_BAR; PG8_MMA(1, 0, At, B0); PG8_MMA(1, 1, At, B1); PG8_BAR; PG8_SCHED;
            } else {
            PG8_LDB(B0, 0, 0); PG8_SCHED; PG8_LDA(At, 0, 0); PG8_STAGE(PG8_SA(1, 1), a1 + hstepA, voffA);
            PG8_WAIT_L(8); PG8_BAR; PG8_WAIT_L(0); PG8_MMA(0, 0, At, B0); PG8_BAR; PG8_SCHED;
            PG8_LDB(B1, 0, 1); PG8_STAGE(PG8_SB(0, 0), b2, voffB);
            PG8_BAR; PG8_WAIT_L(0); PG8_MMA(0, 1, At, B1); PG8_BAR;
            PG8_LDA(At, 0, 1); PG8_STAGE(PG8_SA(0, 0), a2, voffA);
            PG8_BAR; PG8_WAIT_L(0); PG8_MMA(1, 0, At, B0); PG8_BAR; PG8_SCHED;
            PG8_STAGE(PG8_SB(0, 1), b2 + hstep, voffB);
            PG8_WAIT_V(6); PG8_BAR; PG8_MMA(1, 1, At, B1); PG8_BAR;
            PG8_LDB(B0, 1, 0); PG8_SCHED; PG8_LDA(At, 1, 0); PG8_STAGE(PG8_SA(0, 1), a2 + hstepA, voffA);
            PG8_WAIT_L(8); PG8_BAR; PG8_WAIT_L(0); PG8_MMA(0, 0, At, B0); PG8_BAR; PG8_SCHED;
            PG8_LDB(B1, 1, 1); PG8_STAGE(PG8_SB(1, 0), b3, voffB);
            PG8_BAR; PG8_WAIT_L(0); PG8_MMA(0, 1, At, B1); PG8_BAR;
            PG8_LDA(At, 1, 1); PG8_STAGE(PG8_SA(1, 0), a3, voffA);
            PG8_BAR; PG8_WAIT_L(0); PG8_MMA(1, 0, At, B0); PG8_BAR; PG8_SCHED;
            PG8_STAGE(PG8_SB(1, 1), b3 + hstep, voffB);
            PG8_WAIT_V(6); PG8_BAR; PG8_MMA(1, 1, At, B1); PG8_BAR;
            }
        }
        if constexpr (ALIGN_EPI) { if (wr == 0) PG8_BAR; }
        if constexpr (!Epi::AFTER_DRAIN) { Unit eu = cur; eu.idx = ui; asm volatile("" : "+s"(eu.pm), "+s"(eu.pn));
            E(acc, eu, wr, wc, fr, fq);
#if MK_DUP_EPI_ALL
            if constexpr (Epi::IDEMP) { asm volatile("" ::: "memory"); Unit eu2 = cur; asm volatile("" : "+s"(eu2.pm), "+s"(eu2.pn)); E(acc, eu2, wr, wc, fr, fq); }
#endif
            S.done(cur); }
        if (!has_next) break;
#pragma unroll
        for (int a = 0; a < 2; ++a)
#pragma unroll
            for (int b = 0; b < 2; ++b)
#pragma unroll
                for (int m = 0; m < 4; ++m)
#pragma unroll
                    for (int n = 0; n < 2; ++n) acc[a][b][m][n] = (f32x4){0.f, 0.f, 0.f, 0.f};
        cur = nxt; cA = nA; cB = nB; ++ui;
        if constexpr (ALIGN_EPI) { if (wr == 1) PG8_BAR; }
    }
    PG8_WAIT_V(0);
    if constexpr (!ALIGN_EPI) { if (wr == 0) PG8_BAR; }
    PG8_BAR;
    if constexpr (Epi::AFTER_DRAIN) { E.fused(acc, cur, wr, wc, fr, fq, lds, wid, lane); S.done(cur); }
#undef PG8_SA
#undef PG8_SB
#undef PG8_STAGE
#undef PG8_LDA
#undef PG8_LDB
#undef PG8_MMA
#undef PG8_WAIT_V
#undef PG8_WAIT_L
#undef PG8_BAR
#undef PG8_SCHED
}
__device__ __forceinline__ float bf2f(short s) { return __uint_as_float(((unsigned)(unsigned short)s) << 16); }
template <class Epi, class Sched>
__device__ __forceinline__ void gemm_phase_naive(const Gemm g, const Sched& S, const Epi& E) {
    int tid_ = threadIdx.x; asm volatile("" : "+v"(tid_));
    const int tid = tid_, wid = tid >> 6, lane = tid & 63, wr = wid >> 2, wc = wid & 3, fr = lane & 15, fq = lane >> 4;
    const int K = g.K; Unit u;
    for (int i = 0; S.next(i, u); ++i) {
        f32x4 acc[2][2][4][2];
#pragma unroll
        for (int a = 0; a < 2; ++a)
#pragma unroll
            for (int b = 0; b < 2; ++b)
#pragma unroll
                for (int m = 0; m < 4; ++m)
#pragma unroll
                    for (int n = 0; n < 2; ++n) acc[a][b][m][n] = (f32x4){0.f, 0.f, 0.f, 0.f};
        const bf16_t* Arow = g.A + (size_t)(u.pm * BM + wr * 64 + fr) * K;
#pragma unroll
        for (int bj = 0; bj < 2; ++bj) {
            const int cb = u.pn * BM + bj * HALF + wc * 32;
            const bf16_t* B0 = g.Bt + (size_t)(cb + (Epi::PERM ? 8 * fq : 4 * fq)) * K;
            const bf16_t* B1 = g.Bt + (size_t)(cb + (Epi::PERM ? 8 * fq + 4 : 16 + 4 * fq)) * K;
#pragma unroll 1
            for (int k0 = 0; k0 < K; k0 += 4) {
                float bf[2][4][4];
#pragma unroll
                for (int j = 0; j < 4; ++j) { const uint2 b0 = *(const uint2*)(B0 + (size_t)j * K + k0), b1 = *(const uint2*)(B1 + (size_t)j * K + k0);
                    bf[0][j][0] = __uint_as_float(b0.x << 16); bf[0][j][1] = __uint_as_float(b0.x & 0xffff0000u); bf[0][j][2] = __uint_as_float(b0.y << 16); bf[0][j][3] = __uint_as_float(b0.y & 0xffff0000u);
                    bf[1][j][0] = __uint_as_float(b1.x << 16); bf[1][j][1] = __uint_as_float(b1.x & 0xffff0000u); bf[1][j][2] = __uint_as_float(b1.y << 16); bf[1][j][3] = __uint_as_float(b1.y & 0xffff0000u); }
#pragma unroll
                for (int ai = 0; ai < 2; ++ai)
#pragma unroll
                    for (int m = 0; m < 4; ++m) { const uint2 a2 = *(const uint2*)(Arow + (size_t)(ai * HALF + m * 16) * K + k0);
                        const float a0 = __uint_as_float(a2.x << 16), a1 = __uint_as_float(a2.x & 0xffff0000u), a2f = __uint_as_float(a2.y << 16), a3 = __uint_as_float(a2.y & 0xffff0000u);
#pragma unroll
                        for (int n = 0; n < 2; ++n)
#pragma unroll
                            for (int j = 0; j < 4; ++j) acc[ai][bj][m][n][j] += a0 * bf[n][j][0] + a1 * bf[n][j][1] + a2f * bf[n][j][2] + a3 * bf[n][j][3]; }
            }
        }
        E(acc, u, wr, wc, fr, fq);
    }
}
}
#define GAS __attribute__((address_space(1)))
#define LAS __attribute__((address_space(3)))
typedef unsigned short bf16;
typedef unsigned v4u __attribute__((ext_vector_type(4)));
typedef float f32x4 __attribute__((ext_vector_type(4)));
typedef short bf16x8 __attribute__((ext_vector_type(8)));
typedef GAS unsigned gu32;
typedef GAS unsigned long long gu64;
#define RLX_AGENT __ATOMIC_RELAXED, __HIP_MEMORY_SCOPE_AGENT
#define LDS_WAIT() asm volatile("s_waitcnt lgkmcnt(0)" ::: "memory")
#define VM_WAIT() asm volatile("s_waitcnt vmcnt(0)" ::: "memory")
__device__ __forceinline__ unsigned long long rt() { return __builtin_amdgcn_s_memrealtime(); }
__device__ __forceinline__ unsigned pk2(float lo, float hi) { return pg8::cvt_pk_bf16(lo, hi); }
__device__ __forceinline__ unsigned f2bf(float f) { return pg8::cvt_pk_bf16(f, f) & 0xffffu; }
#define XB_TMO      128
#define XB_XCNT(j)  (256  + 64 * (j))
#define XB_XSUB(j)  (1280 + 64 * (j))
#define XB_XGEN(j)  (2304 + 64 * (j))
#define XB_TOP      3328
#define XB_TOPGEN   3392
#define XCD_BAR_WORDS 3456
#define XB_SPIN_CAP (1u << 22)

__device__ __forceinline__ unsigned xb_ld(unsigned* p)              { return __hip_atomic_load(p, __ATOMIC_RELAXED, __HIP_MEMORY_SCOPE_AGENT); }
__device__ __forceinline__ unsigned xb_add(unsigned* p, unsigned v) { return __hip_atomic_fetch_add(p, v, __ATOMIC_RELAXED, __HIP_MEMORY_SCOPE_AGENT); }
__device__ __forceinline__ unsigned xb_xcc_id() { return (unsigned)__builtin_amdgcn_s_getreg((3 << 11) | 20) & 0xFu; }
#define XB_SPIN(cond, bar) do { unsigned _sp = 0; while (cond) { __builtin_amdgcn_s_sleep(1); \
    if ((++_sp & 255u) == 0u) { if (xb_ld(&(bar)[XB_TMO])) break; if (_sp > XB_SPIN_CAP) { atomicAdd(&(bar)[XB_TMO], 1u); break; } } } } while (0)

struct XcdBarrier {
    unsigned* bar; unsigned x;
    volatile LAS unsigned* st;
};

__device__ __forceinline__ XcdBarrier xcd_barrier_post(unsigned* bar, volatile LAS unsigned* st) {
    XcdBarrier b; b.bar = bar; b.x = xb_xcc_id(); b.st = st;
    if (threadIdx.x == 0) (void)xb_add(&bar[XB_XCNT(b.x)], 1u);
    return b;
}
__device__ __forceinline__ void xcd_barrier_complete(unsigned* bar, unsigned x, unsigned& nloc, unsigned& nx) {
    const unsigned G = gridDim.x * gridDim.y * gridDim.z;
    unsigned sum, cnt, mine, sp = 0u;
    for (;;) {
        sum = 0u; cnt = 0u; mine = 0u;
#pragma unroll
        for (unsigned j = 0; j < 16; ++j) { const unsigned c = xb_ld(&bar[XB_XCNT(j)]); sum += c; cnt += (c > 0u) ? 1u : 0u; mine = (j == x) ? c : mine; }
        if (sum == G) break;
        __builtin_amdgcn_s_sleep(1);
        if ((++sp & 255u) == 0u) { if (xb_ld(&bar[XB_TMO])) break; if (sp > XB_SPIN_CAP) { atomicAdd(&bar[XB_TMO], 1u); break; } }
    }
    nloc = mine > 0u ? mine : 1u; nx = cnt > 0u ? cnt : 1u;
}

__device__ __forceinline__ void xcd_barrier(const XcdBarrier& b) {
    asm volatile("s_waitcnt vmcnt(0)" ::: "memory");
    __syncthreads();
    if (threadIdx.x == 0) {
        unsigned* bar = b.bar;
        __builtin_amdgcn_s_waitcnt(0);
        unsigned nloc = b.st[0], nx = b.st[1];
        if (nloc == 0u) { xcd_barrier_complete(bar, b.x, nloc, nx); b.st[0] = nloc; b.st[1] = nx; }
        const unsigned old = xb_add(&bar[XB_XSUB(b.x)], 1u);
        const unsigned gen = old / nloc;
        if (old + 1u == (gen + 1u) * nloc) {
            __builtin_amdgcn_fence(__ATOMIC_RELEASE, "agent");
            asm volatile("s_waitcnt vmcnt(0)" ::: "memory");
            const unsigned og = xb_add(&bar[XB_TOP], 1u);
            const unsigned tg = og / nx;
            if (og + 1u == (tg + 1u) * nx) xb_add(&bar[XB_TOPGEN], 1u);
            else XB_SPIN(xb_ld(&bar[XB_TOPGEN]) == tg, bar);
            __builtin_amdgcn_fence(__ATOMIC_ACQUIRE, "agent");
            xb_add(&bar[XB_XGEN(b.x)], 1u);
            asm volatile("s_waitcnt vmcnt(0)" ::: "memory");
        } else {
            XB_SPIN(xb_ld(&bar[XB_XGEN(b.x)]) == gen, bar);
            __builtin_amdgcn_fence(__ATOMIC_ACQUIRE, "agent");
            asm volatile("s_waitcnt vmcnt(0)" ::: "memory");
        }
    }
    __syncthreads();
}

constexpr int NWAVES = 8;
constexpr int DM = 1024, NBATCH = 16, SEQ = 2048, TT = NBATCH * SEQ, MEML = 256, TMEM = NBATCH * MEML, DFF = 2816, XH = 4, XHD = 256, HGH = 8, HGD = 128;
constexpr float EPS = 1e-6f;
constexpr float QSCALE = 0.0625f * 1.4426950408889634f;
static_assert(TT == pg8::TT_ROWS, "row count");
constexpr size_t MiB = 1u << 20;
constexpr size_t WS_CTL = 0, CTL_ZERO_BYTES = 1 * MiB;
constexpr size_t WS_SSQ = 1 * MiB;
constexpr size_t WS_RMEM = 3 * MiB;
constexpr size_t WS_LB = 3 * MiB + 65536;
constexpr size_t WS_WCIN = 4 * MiB, WS_WCOUT = 10 * MiB, WS_WHIN = 12 * MiB, WS_WHOUT = 20 * MiB, WS_WQ = 22 * MiB, WS_WKV = 26 * MiB, WS_WO = 34 * MiB, WS_WFIN = 38 * MiB, WS_WFOUT = 60 * MiB;
constexpr size_t SZ_WQ = 2 * MiB, SZ_WKV = 4 * MiB, SZ_WO = 2 * MiB, SZ_WFIN = 11 * MiB, SZ_WFOUT = 5 * MiB + 512 * 1024;
constexpr size_t WS_MEMB = 72 * MiB;
constexpr size_t WS_KV = 80 * MiB, SZ_KV = 16 * MiB, OFF_VT = 8 * MiB;
constexpr size_t WS_XB = 112 * MiB;
constexpr size_t WS_P = 176 * MiB, SZ_P = 64 * MiB;
constexpr size_t WS_Y = 432 * MiB;
constexpr size_t WS_END = 496 * MiB;
constexpr int CW_BAR = 4096;
constexpr int RING_OFF = 0, RING_BYTES = 131072;
constexpr int LDSCTL_OFF = RING_BYTES, MISC_OFF = LDSCTL_OFF + 320;
constexpr int LDS_BYTES = 147456;

struct Params { const float* in[19]; float* out; unsigned char* ws; };

__device__ __forceinline__ int opaque_tid(int wave_s) { unsigned z = 0u; asm volatile("" : "+v"(z));
    int t = (wave_s << 6) | (int)__builtin_amdgcn_mbcnt_hi(~0u, __builtin_amdgcn_mbcnt_lo(~0u, z)); asm volatile("" : "+v"(t)); return t; }
#define SWZ_XOR(x, m) __int_as_float(__builtin_amdgcn_ds_swizzle(__float_as_int(x), ((m) << 10) | 0x1f))
__device__ __forceinline__ float wave_sum(float v) {
    v += SWZ_XOR(v, 1); v += SWZ_XOR(v, 2); v += SWZ_XOR(v, 4); v += SWZ_XOR(v, 8); v += SWZ_XOR(v, 16);
    return pg8::xor32_sum(v);
}
__device__ __forceinline__ float wave_max(float v) {
    v = fmaxf(v, SWZ_XOR(v, 1)); v = fmaxf(v, SWZ_XOR(v, 2)); v = fmaxf(v, SWZ_XOR(v, 4)); v = fmaxf(v, SWZ_XOR(v, 8)); v = fmaxf(v, SWZ_XOR(v, 16));
    return pg8::xor32_max(v);
}
__device__ __forceinline__ float bfu2f(unsigned short s) { return __uint_as_float(((unsigned)s) << 16); }
__device__ __forceinline__ float bflo(unsigned w) { return __uint_as_float(w << 16); }
__device__ __forceinline__ float bfhi(unsigned w) { return __uint_as_float(w & 0xffff0000u); }

__device__ __forceinline__ int map_row(int mode, int n0) {
    if (mode == 1) { if (n0 < 1024) return 2048 + n0; if (n0 < 2048) { const int c = n0 - 1024; return 256 * (c >> 7) + (c & 127); } const int c = n0 - 2048; return 256 * (c >> 7) + 128 + (c & 127); }
    if (mode == 2) { if (n0 < DFF) return 256 * (n0 >> 7) + (n0 & 127); const int c = n0 - DFF; return 256 * (c >> 7) + 128 + (c & 127); }
    return n0;
}
struct TrItem { const float* W; const float* gain; bf16* WT; int K, N, mode, r, tm; };
__device__ __forceinline__ void tr_load(const TrItem& d, int lane, f32x4 (&v)[8]) {
    const int nblk = d.N / 32, kb = d.r / nblk, nb = d.r % nblk, k0 = 64 * kb, n0 = 32 * nb;
    const float* src = d.W + (size_t)(k0 + (lane >> 3)) * d.N + n0 + 4 * (lane & 7);
#pragma unroll
    for (int i = 0; i < 8; ++i) v[i] = *(const GAS f32x4*)(src + (size_t)(8 * i) * d.N);
}
__device__ __forceinline__ void tr_store(const TrItem& d, int lane, const f32x4 (&v)[8], LAS float* scr) {
    const int nblk = d.N / 32, kb = d.r / nblk, nb = d.r % nblk, k0 = 64 * kb, n0 = 32 * nb;
#pragma unroll
    for (int i = 0; i < 8; ++i) { LAS float* t = scr + (8 * i + (lane >> 3)) * 33 + 4 * (lane & 7); t[0] = v[i].x; t[1] = v[i].y; t[2] = v[i].z; t[3] = v[i].w; }
    LDS_WAIT(); asm volatile("" ::: "memory");
    const int c = lane & 7, r0 = map_row(d.mode, n0);
    f32x4 g0 = {1.f, 1.f, 1.f, 1.f}, g1 = {1.f, 1.f, 1.f, 1.f};
    if (d.gain) { g0 = *(const f32x4*)(d.gain + k0 + 8 * c); g1 = *(const f32x4*)(d.gain + k0 + 8 * c + 4); }
#pragma unroll
    for (int j = 0; j < 4; ++j) { const int n = (lane >> 3) + 8 * j; const LAS float* t = scr + (8 * c) * 33 + n;
        v4u o; o.x = pk2(t[0 * 33] * g0.x, t[1 * 33] * g0.y); o.y = pk2(t[2 * 33] * g0.z, t[3 * 33] * g0.w); o.z = pk2(t[4 * 33] * g1.x, t[5 * 33] * g1.y); o.w = pk2(t[6 * 33] * g1.z, t[7 * 33] * g1.w);
        *(GAS v4u*)(d.WT + (size_t)(r0 + n) * d.K + k0 + 8 * c) = o; }
    LDS_WAIT(); asm volatile("" ::: "memory");
}
constexpr int TR_ITEMS_EARLY = (1024 / 64) * ((3072 + 1024 + 4096 + 1024 + 2048 + 2048 + 1024 + 5632) / 32) + (DFF / 64) * (1024 / 32);
constexpr int TR_ITEMS_LATE = (1024 / 64) * ((1024 + 1024 + 1024 + 5632) / 32) + (DFF / 64) * (1024 / 32);
__device__ __forceinline__ TrItem tr_decode(const Params& p, unsigned char* ws, int it, int list) {
    int r = it; TrItem d;
#define TR_ITEM(Wp, K_, N_, Gp, WTp, MODE_, TM_) { constexpr int cnt_ = ((K_) / 64) * ((N_) / 32); if (r < cnt_) { d.W = (Wp); d.gain = (Gp); d.WT = (bf16*)(WTp); d.K = (K_); d.N = (N_); d.mode = (MODE_); d.tm = (TM_); d.r = r; return d; } r -= cnt_; }
    if (list == 0) {
        TR_ITEM(p.in[3], 1024, 3072, p.in[2], ws + WS_WCIN, 1, 1)
        TR_ITEM(p.in[5], 1024, 1024, (const float*)nullptr, ws + WS_WCOUT, 0, 1)
        TR_ITEM(p.in[6], 1024, 4096, p.in[2] + 1024, ws + WS_WHIN, 0, 1)
        TR_ITEM(p.in[12], 1024, 1024, p.in[10], ws + WS_WQ, 0, 1)
        TR_ITEM(p.in[13], 1024, 2048, p.in[11], ws + WS_WKV, 0, 0)
        TR_ITEM(p.in[13] + 1024 * 2048, 1024, 2048, p.in[11] + 1024, ws + WS_WKV + SZ_WKV, 0, 0)
        TR_ITEM(p.in[14], 1024, 1024, (const float*)nullptr, ws + WS_WO, 0, 1)
        TR_ITEM(p.in[16], 1024, 5632, p.in[15], ws + WS_WFIN, 2, 1)
        d.W = p.in[17]; d.gain = nullptr; d.WT = (bf16*)(ws + WS_WFOUT); d.K = DFF; d.N = 1024; d.mode = 0; d.tm = 1; d.r = r; return d;
    }
    TR_ITEM(p.in[7], 1024, 1024, (const float*)nullptr, ws + WS_WHOUT, 0, 1)
    TR_ITEM(p.in[12] + 1024 * 1024, 1024, 1024, p.in[10] + 1024, ws + WS_WQ + SZ_WQ, 0, 1)
    TR_ITEM(p.in[14] + 1024 * 1024, 1024, 1024, (const float*)nullptr, ws + WS_WO + SZ_WO, 0, 1)
    TR_ITEM(p.in[16] + 1024 * 5632, 1024, 5632, p.in[15] + 1024, ws + WS_WFIN + SZ_WFIN, 2, 1)
#undef TR_ITEM
    d.W = p.in[17] + DFF * 1024; d.gain = nullptr; d.WT = (bf16*)(ws + WS_WFOUT + SZ_WFOUT); d.K = DFF; d.N = 1024; d.mode = 0; d.tm = 1; d.r = r; return d;
}
__device__ __forceinline__ void tr_run(const Params& p, unsigned char* ws, LAS float* scr, int list, int nitems, int it0, int stride, int lane) {
    int it = it0; f32x4 v[8];
    if (it < nitems) { TrItem d = tr_decode(p, ws, it, list); tr_load(d, lane, v); }
    while (it < nitems) {
        const TrItem d = tr_decode(p, ws, it, list);
#pragma unroll
        for (int i = 0; i < 8; ++i) { LAS float* t = scr + (8 * i + (lane >> 3)) * 33 + 4 * (lane & 7); t[0] = v[i].x; t[1] = v[i].y; t[2] = v[i].z; t[3] = v[i].w; }
        const int nx = it + stride;
        if (nx < nitems) { const TrItem dn = tr_decode(p, ws, nx, list); tr_load(dn, lane, v); }
        LDS_WAIT(); asm volatile("" ::: "memory");
        { const int nblk = d.N / 32, kb = d.r / nblk, nb = d.r % nblk, k0 = 64 * kb, n0 = 32 * nb; const int c = lane & 7, r0 = map_row(d.mode, n0);
          f32x4 g0 = {1.f, 1.f, 1.f, 1.f}, g1 = {1.f, 1.f, 1.f, 1.f};
          if (d.gain) { g0 = *(const f32x4*)(d.gain + k0 + 8 * c); g1 = *(const f32x4*)(d.gain + k0 + 8 * c + 4); }
#pragma unroll
          for (int j = 0; j < 4; ++j) { const int n = (lane >> 3) + 8 * j; const LAS float* t = scr + (8 * c) * 33 + n;
              v4u o; o.x = pk2(t[0 * 33] * g0.x, t[1 * 33] * g0.y); o.y = pk2(t[2 * 33] * g0.z, t[3 * 33] * g0.w); o.z = pk2(t[4 * 33] * g1.x, t[5 * 33] * g1.y); o.w = pk2(t[6 * 33] * g1.z, t[7 * 33] * g1.w);
              if (d.tm) *(GAS v4u*)(d.WT + ((size_t)(k0 >> 6) * d.N + r0 + n) * 64 + 8 * c) = o;
              else *(GAS v4u*)(d.WT + (size_t)(r0 + n) * d.K + k0 + 8 * c) = o; } }
        LDS_WAIT(); asm volatile("" ::: "memory");
        it = nx;
    }
}
template <bool TILE_MAJOR, int NR> __device__ __forceinline__ void row_group(const float* src, bf16* dst, int m0, int lane, float (&ss)[NR]) {
    f32x4 v[NR][4];
#pragma unroll
    for (int i = 0; i < NR; ++i) { const GAS f32x4* xa = (const GAS f32x4*)(src + (size_t)(m0 + i) * DM) + lane;
#pragma unroll
        for (int j = 0; j < 4; ++j) v[i][j] = xa[64 * j]; }
#pragma unroll
    for (int i = 0; i < NR; ++i) { float s = 0.f;
#pragma unroll
        for (int j = 0; j < 4; ++j) s += (v[i][j].x * v[i][j].x + v[i][j].y * v[i][j].y) + (v[i][j].z * v[i][j].z + v[i][j].w * v[i][j].w);
        ss[i] = wave_sum(s);
#pragma unroll
        for (int j = 0; j < 4; ++j) { const unsigned long long w = (unsigned long long)pk2(v[i][j].x, v[i][j].y) | ((unsigned long long)pk2(v[i][j].z, v[i][j].w) << 32);
            if (TILE_MAJOR) *((GAS unsigned long long*)(dst + ((size_t)(4 * j + (lane >> 4)) * TT + m0 + i) * 64 + 4 * (lane & 15))) = w;
            else *((GAS unsigned long long*)(dst + (size_t)(m0 + i) * DM) + lane + 64 * j) = w; } }
}
__device__ __forceinline__ void p0_prologue(const Params& p, LAS unsigned char* lds, int wave_s) {
    const int tid = opaque_tid(wave_s), lane = tid & 63, wave = __builtin_amdgcn_readfirstlane(tid >> 6), gw = blockIdx.x * NWAVES + wave, NGW = gridDim.x * NWAVES;
    unsigned char* ws = p.ws;
    LAS float* scr = (LAS float*)(lds + RING_OFF + wave * 16384);
    { const float* x = p.in[0]; bf16* XB = (bf16*)(ws + WS_XB); float* SSQ = (float*)(ws + WS_SSQ);
      for (int m = 4 * gw; m < TT; m += 4 * NGW) { float ss[4]; row_group<true, 4>(x, XB, m, lane, ss);
          SSQ[(size_t)(m + (lane >> 4)) * 16 + (lane & 15)] = ((lane & 15) == 0) ? (((lane >> 4) == 0) ? ss[0] : ((lane >> 4) == 1) ? ss[1] : ((lane >> 4) == 2) ? ss[2] : ss[3]) : 0.f; }
      const float* mem = p.in[1]; bf16* MEMB = (bf16*)(ws + WS_MEMB); float* RMEM = (float*)(ws + WS_RMEM);
      for (int m = 2 * gw; m < TMEM; m += 2 * NGW) { float ss[2]; row_group<false, 2>(mem, MEMB, m, lane, ss);
          if (lane < 2) RMEM[m + lane] = rsqrtf((lane ? ss[1] : ss[0]) * (1.0f / DM) + EPS); } }
    tr_run(p, ws, scr, 0, TR_ITEMS_EARLY, gw, NGW, lane);
    if ((int)gridDim.x <= NBATCH * HGH) tr_run(p, ws, scr, 1, TR_ITEMS_LATE, gw, NGW, lane);
    { float* LB = (float*)(ws + WS_LB); const int gt = gw * 64 + lane; if (gt < DM) LB[gt] = 1.0f / (1.0f + __expf(p.in[9][gt] - p.in[9][DM + gt])); }
}

__device__ __forceinline__ void conv_pass(const bf16* U2, const bf16* GBp, const float* cw, bf16* V, int wave_s) {
    const int gtid = blockIdx.x * (NWAVES * 64) + opaque_tid(wave_s), NT = gridDim.x * NWAVES * 64;
    constexpr int RUN = 8;
    for (int idx = gtid; idx < (TT / RUN) * 128; idx += NT) {
        const int c8 = (idx & 127) * 8, row0 = (idx >> 7) * RUN, t0 = row0 & (SEQ - 1);
        const f32x4 w0a = *(const f32x4*)(cw + c8), w0b = *(const f32x4*)(cw + c8 + 4);
        const f32x4 w1a = *(const f32x4*)(cw + DM + c8), w1b = *(const f32x4*)(cw + DM + c8 + 4);
        const f32x4 w2a = *(const f32x4*)(cw + 2 * DM + c8), w2b = *(const f32x4*)(cw + 2 * DM + c8 + 4);
        const v4u z4 = {0u, 0u, 0u, 0u};
        v4u uc = (t0 >= 2) ? *(const v4u*)(U2 + (size_t)(row0 - 2) * DM + c8) : z4;
        v4u ub = (t0 >= 1) ? *(const v4u*)(U2 + (size_t)(row0 - 1) * DM + c8) : z4;
        v4u ur[RUN], gr[RUN];
#pragma unroll
        for (int i = 0; i < RUN; ++i) { ur[i] = *(const v4u*)(U2 + (size_t)(row0 + i) * DM + c8); gr[i] = *(const v4u*)(GBp + (size_t)(row0 + i) * DM + c8); }
#pragma unroll
        for (int i = 0; i < RUN; ++i) { const v4u ua = ur[i], g = gr[i]; v4u o;
#define CV(W, e0, e1, wA, wB, wC) { const float z0 = wA[e0] * bflo(uc.W) + wB[e0] * bflo(ub.W) + wC[e0] * bflo(ua.W); const float z1 = wA[e1] * bfhi(uc.W) + wB[e1] * bfhi(ub.W) + wC[e1] * bfhi(ua.W); \
            o.W = pk2(bflo(g.W) * z0, bfhi(g.W) * z1); }
            CV(x, 0, 1, w0a, w1a, w2a) CV(y, 2, 3, w0a, w1a, w2a) CV(z, 0, 1, w0b, w1b, w2b) CV(w, 2, 3, w0b, w1b, w2b)
#undef CV
            *(v4u*)(V + ((size_t)(c8 >> 6) * TT + row0 + i) * 64 + (c8 & 63)) = o; uc = ub; ub = ua; }
    }
}

__device__ __forceinline__ void attn_naive(const bf16* Q, const bf16* Kb, const bf16* VT, bf16* O, int wave_s) {
    const int tid = opaque_tid(wave_s), lane = tid & 63, gw = blockIdx.x * NWAVES + __builtin_amdgcn_readfirstlane(tid >> 6), NGW = gridDim.x * NWAVES;
    for (int item = gw; item < TT * XH; item += NGW) {
        const int row = item >> 2, h = item & 3, b = row >> 11;
        const bf16* q = Q + (size_t)row * DM + h * XHD;
        const bf16* Kh = Kb + (size_t)(b * MEML) * DM + h * XHD;
        float sc[4] = {0.f, 0.f, 0.f, 0.f};
        for (int c = 0; c < 32; ++c) {
            const v4u qv = *(const v4u*)(q + 8 * c);
#pragma unroll
            for (int j = 0; j < 4; ++j) { const v4u kv = *(const v4u*)(Kh + (size_t)(lane + 64 * j) * DM + 8 * c);
                sc[j] += bflo(qv.x) * bflo(kv.x) + bfhi(qv.x) * bfhi(kv.x) + bflo(qv.y) * bflo(kv.y) + bfhi(qv.y) * bfhi(kv.y)
                       + bflo(qv.z) * bflo(kv.z) + bfhi(qv.z) * bfhi(kv.z) + bflo(qv.w) * bflo(kv.w) + bfhi(qv.w) * bfhi(kv.w); }
        }
        const float mx = wave_max(fmaxf(fmaxf(sc[0], sc[1]), fmaxf(sc[2], sc[3])));
        float pr[4]; float sum = 0.f;
#pragma unroll
        for (int j = 0; j < 4; ++j) { pr[j] = exp2f(sc[j] - mx); sum += pr[j]; }
        sum = wave_sum(sum); const float inv = 1.0f / sum;
        const bf16* Vh = VT + (size_t)(h * XHD) * TMEM + b * MEML;
        float keep = 0.f;
        for (int d = 0; d < XHD; ++d) {
            float part = 0.f;
#pragma unroll
            for (int j = 0; j < 4; ++j) part += pr[j] * bfu2f(Vh[(size_t)d * TMEM + lane + 64 * j]);
            part = wave_sum(part);
            if ((d & 63) == lane) keep = part * inv;
            if ((d & 63) == 63) O[(size_t)row * DM + h * XHD + (d - 63) + lane] = (bf16)f2bf(keep);
        }
    }
}


namespace xat {
typedef short bf16x8 __attribute__((ext_vector_type(8)));
typedef float f32x16 __attribute__((ext_vector_type(16)));
#define XAT_WAITBAR() asm volatile("s_waitcnt vmcnt(0) lgkmcnt(0)\n\ts_barrier" ::: "memory")
__device__ __forceinline__ void dma_k_half(LAS unsigned char* buf, const bf16* Kbh, int kh, int wid, int lane) {
    const int rho = 2 * wid + (lane >> 5), c = (lane & 31) ^ rho, key0 = 128 * kh + ((rho & ~12) | ((rho & 4) << 1) | ((rho & 8) >> 1));
    const bf16* src = Kbh + (size_t)key0 * 1024 + 8 * c;
#pragma unroll
    for (int i = 0; i < 8; ++i) __builtin_amdgcn_global_load_lds((const unsigned*)(src + (size_t)i * 16 * 1024), (LAS unsigned*)(buf + (wid + 8 * i) * 1024), 16, 0, 0);
}
__device__ __forceinline__ void dma_v_half(LAS unsigned char* buf, const bf16* VTbh, int kh, int wid, int lane) {
    const int rho = 4 * wid + (lane >> 4), c = (lane & 15) ^ (rho & 15);
    const bf16* src = VTbh + (size_t)rho * TMEM + 128 * kh + 8 * c;
#pragma unroll
    for (int i = 0; i < 8; ++i) __builtin_amdgcn_global_load_lds((const unsigned*)(src + (size_t)i * 32 * TMEM), (LAS unsigned*)(buf + (wid + 8 * i) * 1024), 16, 0, 0);
}
__device__ __forceinline__ void attn_phase(LAS unsigned char* lds, const bf16* Q, const bf16* Kb, const bf16* VT, bf16* O, int wave_s) {
    const int tid0 = opaque_tid(wave_s), wid = __builtin_amdgcn_readfirstlane(tid0 >> 6);
    const int G = gridDim.x, bx = blockIdx.x;
    LAS unsigned char* buf0 = lds; LAS unsigned char* buf1 = lds + 65536;
    LAS float* lsw = (LAS float*)(lds + 131072 + 1024) + wid * 32;
    pg8::StaticOrder SO; SO.init(TT, DM, G, bx); pg8::Unit qu;
    for (int ui = 0; SO.next(ui, qu); ++ui) {
        int tid = tid0; asm volatile("" : "+v"(tid));
        const int lane = tid & 63, r = lane & 31, h = lane >> 5, xk = h ^ (r & 15);
        const int qb = qu.pm & 7, hd = qu.pn, b = qu.pm >> 3;
        const size_t row0 = (size_t)b * SEQ + qb * 256 + wid * 32;
        const bf16* Kbh = Kb + (size_t)(b * MEML) * DM + hd * XHD;
        const bf16* VTbh = VT + (size_t)(hd * XHD) * TMEM + b * MEML;
        XAT_WAITBAR();
        dma_k_half(buf0, Kbh, 0, wid, lane); dma_k_half(buf1, Kbh, 1, wid, lane);
        bf16x8 qf[16];
#pragma unroll
        for (int ks = 0; ks < 16; ++ks) qf[ks] = *(const bf16x8*)(Q + (row0 + r) * DM + hd * XHD + 16 * ks + 8 * h);
        XAT_WAITBAR();
        f32x16 sacc[8];
#pragma unroll
        for (int kb = 0; kb < 8; ++kb)
#pragma unroll
            for (int i = 0; i < 16; ++i) sacc[kb][i] = 0.f;
        {
            bf16x8 kc[4], kn[4];
#pragma unroll
            for (int kbl = 0; kbl < 4; ++kbl) kc[kbl] = *(const LAS bf16x8*)(buf0 + r * 512 + kbl * 16384 + (((0) ^ xk) << 4));
#pragma unroll
            for (int st = 0; st < 32; ++st) { const int hf = st >> 4, ks = st & 15;
                if (st + 1 < 32) { const int hn = (st + 1) >> 4, kx = (st + 1) & 15; LAS unsigned char* nb = (hn ? buf1 : buf0) + r * 512 + (((2 * kx) ^ xk) << 4);
#pragma unroll
                    for (int kbl = 0; kbl < 4; ++kbl) kn[kbl] = *(const LAS bf16x8*)(nb + kbl * 16384); }
#pragma unroll
                for (int kbl = 0; kbl < 4; ++kbl) sacc[hf * 4 + kbl] = __builtin_amdgcn_mfma_f32_32x32x16_bf16(kc[kbl], qf[ks], sacc[hf * 4 + kbl], 0, 0, 0);
#pragma unroll
                for (int kbl = 0; kbl < 4; ++kbl) kc[kbl] = kn[kbl];
            }
        }
        XAT_WAITBAR();
        dma_v_half(buf0, VTbh, 0, wid, lane); dma_v_half(buf1, VTbh, 1, wid, lane);
        float mx = sacc[0][0];
#pragma unroll
        for (int kb = 0; kb < 8; ++kb)
#pragma unroll
            for (int i = 0; i < 16; ++i) mx = fmaxf(mx, sacc[kb][i]);
        mx = pg8::xor32_max(mx);
        float lsum = 0.f; bf16x8 pf[8][2];
#pragma unroll
        for (int kb = 0; kb < 8; ++kb) {
#pragma unroll
            for (int i = 0; i < 16; ++i) { const float pv = __builtin_amdgcn_exp2f(sacc[kb][i] - mx); sacc[kb][i] = pv; lsum += pv; }
#pragma unroll
            for (int s = 0; s < 2; ++s) { v4u w; w.x = pg8::cvt_pk_bf16(sacc[kb][8 * s + 0], sacc[kb][8 * s + 1]); w.y = pg8::cvt_pk_bf16(sacc[kb][8 * s + 2], sacc[kb][8 * s + 3]);
                w.z = pg8::cvt_pk_bf16(sacc[kb][8 * s + 4], sacc[kb][8 * s + 5]); w.w = pg8::cvt_pk_bf16(sacc[kb][8 * s + 6], sacc[kb][8 * s + 7]); pf[kb][s] = __builtin_bit_cast(bf16x8, w); }
        }
        lsum = pg8::xor32_sum(lsum);
        if (h == 0) lsw[r] = lsum;
        XAT_WAITBAR();
        f32x16 oacc[8];
#pragma unroll
        for (int db = 0; db < 8; ++db)
#pragma unroll
            for (int i = 0; i < 16; ++i) oacc[db][i] = 0.f;
        {
            bf16x8 vc[4], vn[4];
#pragma unroll
            for (int d4 = 0; d4 < 4; ++d4) vc[d4] = *(const LAS bf16x8*)(buf0 + r * 256 + d4 * 8192 + ((((h)) ^ (r & 15)) << 4));
#pragma unroll
            for (int st = 0; st < 32; ++st) { const int hf = st >> 4, kbl = (st >> 2) & 3, sx = (st >> 1) & 1, dh = st & 1;
                if (st + 1 < 32) { const int s1 = st + 1, hn = s1 >> 4, kn_ = (s1 >> 2) & 3, sn = (s1 >> 1) & 1, dn = s1 & 1;
                    LAS unsigned char* nb = (hn ? buf1 : buf0) + r * 256 + dn * 32768 + ((((4 * kn_ + 2 * sn + h)) ^ (r & 15)) << 4);
#pragma unroll
                    for (int d4 = 0; d4 < 4; ++d4) vn[d4] = *(const LAS bf16x8*)(nb + d4 * 8192); }
#pragma unroll
                for (int d4 = 0; d4 < 4; ++d4) oacc[dh * 4 + d4] = __builtin_amdgcn_mfma_f32_32x32x16_bf16(pf[hf * 4 + kbl][sx], vc[d4], oacc[dh * 4 + d4], 0, 0, 0);
#pragma unroll
                for (int d4 = 0; d4 < 4; ++d4) vc[d4] = vn[d4];
            }
        }
        float inv[16];
#pragma unroll
        for (int i = 0; i < 16; ++i) inv[i] = __builtin_amdgcn_rcpf(lsw[(i & 3) + 8 * (i >> 2) + 4 * h]);
        bf16* Ow = O + ((size_t)(4 * hd) * TT + row0) * 64 + r;
#pragma unroll
        for (int db = 0; db < 8; ++db)
#pragma unroll
            for (int i = 0; i < 16; ++i) { const float ov = oacc[db][i] * inv[i]; Ow[((size_t)(db >> 1) * TT + ((i & 3) + 8 * (i >> 2) + 4 * h)) * 64 + (db & 1) * 32] = (bf16)(pg8::cvt_pk_bf16(ov, ov) & 0xffffu); }
    }
    XAT_WAITBAR();
}
}


namespace hg {
typedef short bf16x8 __attribute__((ext_vector_type(8)));
typedef float f32x16 __attribute__((ext_vector_type(16)));
typedef unsigned u32x2v __attribute__((ext_vector_type(2)));
typedef float f32x2v __attribute__((ext_vector_type(2)));
#define HG_BAR() asm volatile("s_waitcnt lgkmcnt(0)\n\ts_barrier" ::: "memory")
#define HG_WAITBAR() asm volatile("s_waitcnt vmcnt(0) lgkmcnt(0)\n\ts_barrier" ::: "memory")
constexpr int QT = 0, QB = 16384, KT = 32768, KTT = 49152, VTI = 65536, ST = 81920, TAB = 131072 + 2048;
__device__ __forceinline__ int sig(int x) { return (x & ~12) | ((x & 4) << 1) | ((x & 8) >> 1); }
__device__ __forceinline__ float ex2(float x) { return __builtin_amdgcn_exp2f(x); }
struct RawL { unsigned lg[8]; };
struct RawQV { unsigned q[8]; v4u v[2]; };
__device__ __forceinline__ void load_lg(RawL& R, const bf16* P1h, int c, int tid, int wid) {
    const unsigned* pl = (const unsigned*)(P1h + (size_t)(c * 64 + 8 * wid) * HGD + 2 * (tid & 63));
#pragma unroll
    for (int j = 0; j < 8; ++j) R.lg[j] = pl[j * (HGD / 2)];
}
__device__ __forceinline__ void load_qv(RawQV& R, const bf16* P0h, const bf16* P2h, int c, int tid, int wid) {
    const unsigned* pq = (const unsigned*)(P0h + (size_t)(c * 64 + 8 * wid) * HGD + 2 * (tid & 63));
#pragma unroll
    for (int j = 0; j < 8; ++j) R.q[j] = pq[j * (HGD / 2)];
    const v4u* pv = (const v4u*)(P2h + (size_t)(c * 64 + 2 * (tid & 31)) * HGD + 8 * (tid >> 5));
    R.v[0] = pv[0]; R.v[1] = pv[HGD / 8];
}
__device__ __forceinline__ void load_og(u32x2v (&og)[4], const bf16* P3h, int c, int tid, int tb, int vb) {
    const int lane = tid & 63, r = lane & 31, h = lane >> 5;
    const u32x2v* po = (const u32x2v*)(P3h + (size_t)(c * 64 + 32 * tb + r) * HGD + 32 * vb + 4 * h);
#pragma unroll
    for (int q = 0; q < 4; ++q) og[q] = po[2 * q];
}
__device__ __forceinline__ void chunk_body(LAS unsigned char* lds, RawL& RL, RawQV& QV, f32x16 (&Sst)[2], const int c, const int tid0, const int wid,
                                           const bf16* P0h, const bf16* P1h, const bf16* P2h, const bf16* P3h, const float* gnh, bf16* Yb) {
    LAS float* TOT = (LAS float*)(lds + TAB); LAS float* DL = TOT + 1024; LAS float* DMT = DL + 128; LAS float* SSQX = DMT + 128;
    const int tb = wid >> 2, vb = wid & 3, kb0 = 2 * (wid >> 2);
    int tid = tid0; asm volatile("" : "+v"(tid));
    if (c >= 0) {
    const int lane = tid & 63, r = lane & 31, h = lane >> 5, kp = lane, k0 = 2 * lane, sw256 = r & 15, sw128 = (r >> 1) & 7;
    u32x2v ogr[4]; load_og(ogr, P3h, c, tid, tb, vb);
    { float r0 = 0.f, r1 = 0.f;
#pragma unroll
      for (int j = 0; j < 8; ++j) { r0 += bflo(RL.lg[j]); r1 += bfhi(RL.lg[j]); }
      *(LAS f32x2v*)(TOT + wid * 128 + k0) = (f32x2v){r0, r1}; }
    HG_BAR();
    { const int sp = tid & 31, vg = tid >> 5, s = 2 * sp;
      const unsigned a4[4] = {QV.v[0].x, QV.v[0].y, QV.v[0].z, QV.v[0].w}, b4[4] = {QV.v[1].x, QV.v[1].y, QV.v[1].z, QV.v[1].w};
#pragma unroll
      for (int e = 0; e < 8; ++e) { const int v = 8 * vg + e;
          const unsigned lo = (e & 1) ? (a4[e >> 1] >> 16) : (a4[e >> 1] & 0xffffu), hi = (e & 1) ? (b4[e >> 1] & 0xffff0000u) : (b4[e >> 1] << 16);
          *(LAS unsigned*)(lds + VTI + v * 128 + ((((s >> 3) ^ ((v >> 1) & 7))) << 4) + (s & 7) * 2) = lo | hi; } }
    { float off0 = 0.f, off1 = 0.f, bm0 = 0.f, bm1 = 0.f, bl0 = 0.f, bl1 = 0.f;
#pragma unroll
      for (int sgi = 0; sgi < 8; ++sgi) { const f32x2v tt = *(const LAS f32x2v*)(TOT + sgi * 128 + k0);
          if (sgi < wid) { off0 += tt[0]; off1 += tt[1]; } if (sgi < 4) { bm0 += tt[0]; bm1 += tt[1]; } bl0 += tt[0]; bl1 += tt[1]; }
      const float em0 = ex2(bm0), em1 = ex2(bm1);
      unsigned ktA[4], ktB[4];
      float pk0 = 0.f, pk1 = 0.f, run0 = off0 - bm0, run1 = off1 - bm1;
#pragma unroll
      for (int j = 0; j < 8; ++j) { const int t = 8 * wid + j, rho = sig(t);
          const float l0 = bflo(RL.lg[j]), l1 = bfhi(RL.lg[j]); run0 += l0; run1 += l1;
          const float d0 = run0, d1 = run1;
          const float E0 = ex2(fminf(d0, 115.f)), E1 = ex2(fminf(d1, 115.f)), I0 = ex2(fminf(-d0, 115.f)), I1 = ex2(fminf(-d1, 115.f));
          const float q0 = bflo(QV.q[j]) * E0, q1 = bfhi(QV.q[j]) * E1, kt0 = (1.0f - ex2(l0)) * I0, kt1 = (1.0f - ex2(l1)) * I1;
          const int co = (k0 & 7) * 2;
          *(LAS unsigned*)(lds + QT + t * 256 + ((((k0 >> 3) ^ (t & 15))) << 4) + co) = pg8::cvt_pk_bf16(q0, q1);
          *(LAS unsigned*)(lds + QB + t * 256 + ((((k0 >> 3) ^ (t & 15))) << 4) + co) = pg8::cvt_pk_bf16(q0 * em0, q1 * em1);
          *(LAS unsigned*)(lds + KT + rho * 256 + ((((k0 >> 3) ^ (rho & 15))) << 4) + co) = pg8::cvt_pk_bf16(kt0, kt1);
          if (j & 1) { ktA[j >> 1] = pg8::cvt_pk_bf16(pk0, kt0); ktB[j >> 1] = pg8::cvt_pk_bf16(pk1, kt1); } else { pk0 = kt0; pk1 = kt1; } }
      *(LAS v4u*)(lds + KTT + k0 * 128 + ((((wid) ^ (kp & 7))) << 4)) = (v4u){ktA[0], ktA[1], ktA[2], ktA[3]};
      *(LAS v4u*)(lds + KTT + (k0 + 1) * 128 + ((((wid) ^ (kp & 7))) << 4)) = (v4u){ktB[0], ktB[1], ktB[2], ktB[3]};
      if (wid == 0) *(LAS f32x2v*)(DL + k0) = (f32x2v){ex2(bl0), ex2(bl1)};
      if (wid == 1) *(LAS f32x2v*)(DMT + k0) = (f32x2v){ex2(bl0 - bm0), ex2(bl1 - bm1)}; }
    if (c + 2 < SEQ / 64) load_lg(RL, P1h, c + 2, tid, wid);
    if (c + 1 < SEQ / 64) load_qv(QV, P0h, P2h, c + 1, tid, wid);
    HG_BAR();
    f32x16 oT;
#pragma unroll
    for (int i = 0; i < 16; ++i) oT[i] = 0.f;
    { bf16x8 qfr[8];
#pragma unroll
      for (int ks = 0; ks < 8; ++ks) qfr[ks] = *(const LAS bf16x8*)(lds + QT + (32 * tb + r) * 256 + ((((2 * ks + h) ^ sw256)) << 4));
#pragma unroll
      for (int sb = 0; sb < 2; ++sb) {
        if (sb <= tb) {
            f32x16 x;
#pragma unroll
            for (int i = 0; i < 16; ++i) x[i] = 0.f;
#pragma unroll
            for (int ks = 0; ks < 8; ++ks) { const bf16x8 a = *(const LAS bf16x8*)(lds + KT + (32 * sb + r) * 256 + ((((2 * ks + h) ^ sw256)) << 4));
                x = __builtin_amdgcn_mfma_f32_32x32x16_bf16(a, qfr[ks], x, 0, 0, 0); }
            if (sb == tb) {
#pragma unroll
                for (int i = 0; i < 16; ++i) { const int sl = (i & 3) + 4 * ((i >> 2) & 1) + 8 * h + 16 * (i >> 3); if (sl > r) x[i] = 0.f; } }
#pragma unroll
            for (int ss = 0; ss < 2; ++ss) { v4u w; w.x = pg8::cvt_pk_bf16(x[8 * ss + 0], x[8 * ss + 1]); w.y = pg8::cvt_pk_bf16(x[8 * ss + 2], x[8 * ss + 3]);
                w.z = pg8::cvt_pk_bf16(x[8 * ss + 4], x[8 * ss + 5]); w.w = pg8::cvt_pk_bf16(x[8 * ss + 6], x[8 * ss + 7]);
                const bf16x8 a = *(const LAS bf16x8*)(lds + VTI + (32 * vb + r) * 128 + ((((4 * sb + 2 * ss + h) ^ sw128)) << 4));
                oT = __builtin_amdgcn_mfma_f32_32x32x16_bf16(a, __builtin_bit_cast(bf16x8, w), oT, 0, 0, 0); }
        }
      } }
#pragma unroll
    for (int ks = 0; ks < 8; ++ks) { const bf16x8 a = *(const LAS bf16x8*)(lds + ST + (32 * vb + r) * 256 + ((((2 * ks + h) ^ sw256)) << 4));
        const bf16x8 qb = *(const LAS bf16x8*)(lds + QB + (32 * tb + r) * 256 + ((((2 * ks + h) ^ sw256)) << 4));
        oT = __builtin_amdgcn_mfma_f32_32x32x16_bf16(a, qb, oT, 0, 0, 0); }
#pragma unroll
    for (int blk = 0; blk < 2; ++blk) { f32x16 U[2];
#pragma unroll
        for (int i = 0; i < 16; ++i) U[blk][i] = 0.f;
#pragma unroll
        for (int st = 0; st < 4; ++st) { const bf16x8 a = *(const LAS bf16x8*)(lds + KTT + (32 * (kb0 + blk) + r) * 128 + ((((2 * st + h) ^ sw128)) << 4));
            const bf16x8 bv = *(const LAS bf16x8*)(lds + VTI + (32 * vb + r) * 128 + ((((2 * st + h) ^ sw128)) << 4));
            U[blk] = __builtin_amdgcn_mfma_f32_32x32x16_bf16(a, bv, U[blk], 0, 0, 0); }
#pragma unroll
        for (int q = 0; q < 4; ++q) { const int kbase = 32 * (kb0 + blk) + 8 * q + 4 * h; const f32x4 dl = *(const LAS f32x4*)(DL + kbase), dm = *(const LAS f32x4*)(DMT + kbase);
#pragma unroll
            for (int e = 0; e < 4; ++e) Sst[blk][4 * q + e] = dl[e] * Sst[blk][4 * q + e] + dm[e] * U[blk][4 * q + e]; }
    }
    { float part = 0.f;
#pragma unroll
      for (int i = 0; i < 16; ++i) part += oT[i] * oT[i];
      part = pg8::xor32_sum(part);
      if (h == 0) SSQX[(32 * tb + r) * 4 + vb] = part; }
    HG_BAR();
    { const f32x4 sx = *(const LAS f32x4*)(SSQX + (32 * tb + r) * 4); const float rs = rsqrtf(((sx[0] + sx[1]) + (sx[2] + sx[3])) * (1.0f / HGD) + EPS);
#pragma unroll
      for (int q = 0; q < 4; ++q) { const f32x4 gn4 = *(const LAS f32x4*)(SSQX + 256 + 32 * vb + 8 * q + 4 * h);
          const float y0 = oT[4 * q + 0] * rs * gn4[0] * bflo(ogr[q].x), y1 = oT[4 * q + 1] * rs * gn4[1] * bfhi(ogr[q].x);
          const float y2 = oT[4 * q + 2] * rs * gn4[2] * bflo(ogr[q].y), y3 = oT[4 * q + 3] * rs * gn4[3] * bfhi(ogr[q].y);
          *(u32x2v*)(Yb + ((size_t)(vb >> 1) * TT + (64 * c + 32 * tb + r)) * 64 + (vb & 1) * 32 + 8 * q + 4 * h) = (u32x2v){pg8::cvt_pk_bf16(y0, y1), pg8::cvt_pk_bf16(y2, y3)}; } }
#pragma unroll
    for (int blk = 0; blk < 2; ++blk)
#pragma unroll
        for (int q = 0; q < 4; ++q) { const int kbase = 32 * (kb0 + blk) + 8 * q + 4 * h;
            *(LAS u32x2v*)(lds + ST + (32 * vb + r) * 256 + ((((kbase >> 3) ^ sw256)) << 4) + (kbase & 7) * 2) =
                (u32x2v){pg8::cvt_pk_bf16(Sst[blk][4 * q + 0], Sst[blk][4 * q + 1]), pg8::cvt_pk_bf16(Sst[blk][4 * q + 2], Sst[blk][4 * q + 3])}; }
    } else {
        load_lg(RL, P1h, c + 2, tid, wid);
        if (c == -1) load_qv(QV, P0h, P2h, 0, tid, wid);
    }
}
__device__ __forceinline__ void scan_phase(LAS unsigned char* lds, const bf16* P0  , const bf16* P1  , const bf16* P2  , const bf16* P3  , const float* gnorm, bf16* Y, int wave_s) {
    const int tid0 = opaque_tid(wave_s), wid = __builtin_amdgcn_readfirstlane(tid0 >> 6);
    const int tb = wid >> 2, vb = wid & 3, G = gridDim.x;
    for (int item = blockIdx.x; item < NBATCH * HGH; item += G) {
        const int b = item >> 3, hh = item & 7;
        const size_t hoff = (size_t)item * SEQ * HGD;
        const bf16* P0h = P0 + hoff; const bf16* P1h = P1 + hoff; const bf16* P2h = P2 + hoff; const bf16* P3h = P3 + hoff;
        bf16* Yb = Y + ((size_t)(2 * hh) * TT + (size_t)b * SEQ) * 64; const float* gnh = gnorm + hh * HGD;
        f32x16 Sst[2];
#pragma unroll
        for (int i = 0; i < 16; ++i) { Sst[0][i] = 0.f; Sst[1][i] = 0.f; }
        HG_WAITBAR();
        RawL LA, LB; RawQV QV;
#pragma unroll
        for (int i = 0; i < 16; ++i) *(LAS unsigned*)(lds + ST + (tid0 * 16 + i) * 4) = 0u;
        if (tid0 < HGD) ((LAS float*)(lds + TAB))[1024 + 128 + 128 + 256 + tid0] = gnh[tid0];
#pragma unroll 1
        for (int c = -2; c < SEQ / 64; c += 2) {
            chunk_body(lds, LA, QV, Sst, c, tid0, wid, P0h, P1h, P2h, P3h, gnh, Yb);
            chunk_body(lds, LB, QV, Sst, c + 1, tid0, wid, P0h, P1h, P2h, P3h, gnh, Yb);
        }
    }
    HG_WAITBAR();
}
}
__device__ __forceinline__ void late_weights(const Params& p, LAS unsigned char* lds, int wave_s) {
    const int G = gridDim.x, nside = G - NBATCH * HGH, my = (int)blockIdx.x - NBATCH * HGH;
    if (nside <= 0 || my < 0) return;
    const int tid = opaque_tid(wave_s), lane = tid & 63, wave = __builtin_amdgcn_readfirstlane(tid >> 6);
    tr_run(p, p.ws, (LAS float*)(lds + RING_OFF + wave * 16384), 1, TR_ITEMS_LATE, my * NWAVES + wave, nside * NWAVES, lane);
}

__device__ __forceinline__ void scan_naive(bf16* P0  , const bf16* P1  , const bf16* P2  , const bf16* P3  , const float* gnorm, unsigned char* lds_generic, int G) {
    float* q_s = (float*)lds_generic;
    float* g_s = q_s + 16 * 128;
    float* v_s = g_s + 16 * 128;
    float* part = v_s + 16 * 128;
    const int tid = threadIdx.x, lane = tid & 63, wave = tid >> 6, vv = tid & 127, kq = tid >> 7;
    for (int item = blockIdx.x; item < NBATCH * HGH; item += G) {
        const int b = item >> 3, h = item & 7;
        const size_t base = (size_t)b * SEQ * DM + h * HGD;
        float S[32];
#pragma unroll
        for (int i = 0; i < 32; ++i) S[i] = 0.f;
        for (int t0 = 0; t0 < SEQ; t0 += 16) {
            __syncthreads();
            { const int r = tid >> 5, c4 = (tid & 31) * 4; const size_t off = base + (size_t)(t0 + r) * DM + c4;
              const uint2 a = *(const uint2*)(P0 + off), l = *(const uint2*)(P1 + off), i2 = *(const uint2*)(P2 + off);
              float* qd = q_s + r * 128 + c4; float* gd = g_s + r * 128 + c4; float* vd = v_s + r * 128 + c4;
              qd[0] = bflo(a.x); qd[1] = bfhi(a.x); qd[2] = bflo(a.y); qd[3] = bfhi(a.y);
              gd[0] = exp2f(bflo(l.x)); gd[1] = exp2f(bfhi(l.x)); gd[2] = exp2f(bflo(l.y)); gd[3] = exp2f(bfhi(l.y));
              vd[0] = bflo(i2.x); vd[1] = bfhi(i2.x); vd[2] = bflo(i2.y); vd[3] = bfhi(i2.y); }
            __syncthreads();
            for (int s = 0; s < 16; ++s) {
                const float vval = v_s[s * 128 + vv]; float acc = 0.f;
#pragma unroll
                for (int i = 0; i < 32; ++i) { const float gk = g_s[s * 128 + kq * 32 + i]; S[i] = gk * S[i] + (1.0f - gk) * vval; acc += q_s[s * 128 + kq * 32 + i] * S[i]; }
                part[(s * 4 + kq) * 128 + vv] = acc;
            }
            __syncthreads();
#pragma unroll
            for (int ss = 0; ss < 2; ++ss) { const int s = wave * 2 + ss; const int t = t0 + s;
                float o0 = 0.f, o1 = 0.f;
#pragma unroll
                for (int k = 0; k < 4; ++k) { o0 += part[(s * 4 + k) * 128 + lane]; o1 += part[(s * 4 + k) * 128 + 64 + lane]; }
                const float ssq = wave_sum(o0 * o0 + o1 * o1); const float rs = rsqrtf(ssq * (1.0f / HGD) + EPS);
                const size_t off = base + (size_t)t * DM;
                const float y0 = o0 * rs * gnorm[h * HGD + lane] * bfu2f(P3[off + lane]), y1 = o1 * rs * gnorm[h * HGD + 64 + lane] * bfu2f(P3[off + 64 + lane]);
                P0[off + lane] = (bf16)f2bf(y0); P0[off + 64 + lane] = (bf16)f2bf(y1); }
        }
    }
}

__device__ __forceinline__ void final_norm(const bf16* XBp, const float* gfin, float* out, int wave_s) {
    const int tid = opaque_tid(wave_s), lane = tid & 63, gw = blockIdx.x * NWAVES + __builtin_amdgcn_readfirstlane(tid >> 6), NGW = gridDim.x * NWAVES;
    constexpr int RB = 4;
    f32x4 g[2][2];
#pragma unroll
    for (int j = 0; j < 2; ++j)
#pragma unroll
        for (int q = 0; q < 2; ++q) g[j][q] = *(const f32x4*)(gfin + 512 * j + 8 * lane + 4 * q);
    for (int m0 = RB * gw; m0 < TT; m0 += RB * NGW) {
        v4u a[RB], b[RB];
#pragma unroll
        for (int i = 0; i < RB; ++i) { const bf16* xr = XBp + ((size_t)(lane >> 3) * TT + m0 + i) * 64 + 8 * (lane & 7);
            a[i] = *(const v4u*)xr; b[i] = *(const v4u*)(xr + (size_t)8 * TT * 64); }
#pragma unroll
        for (int i = 0; i < RB; ++i) {
            float v[16] = {bflo(a[i].x), bfhi(a[i].x), bflo(a[i].y), bfhi(a[i].y), bflo(a[i].z), bfhi(a[i].z), bflo(a[i].w), bfhi(a[i].w),
                           bflo(b[i].x), bfhi(b[i].x), bflo(b[i].y), bfhi(b[i].y), bflo(b[i].z), bfhi(b[i].z), bflo(b[i].w), bfhi(b[i].w)};
            float s = 0.f;
#pragma unroll
            for (int k = 0; k < 16; ++k) s += v[k] * v[k];
            s = wave_sum(s); const float rs = rsqrtf(s * (1.0f / DM) + EPS);
#pragma unroll
            for (int j = 0; j < 2; ++j)
#pragma unroll
                for (int q = 0; q < 2; ++q) { const int col = 512 * j + 8 * lane + 4 * q;
                    f32x4 o; o[0] = v[8 * j + 4 * q + 0] * rs * g[j][q][0]; o[1] = v[8 * j + 4 * q + 1] * rs * g[j][q][1]; o[2] = v[8 * j + 4 * q + 2] * rs * g[j][q][2]; o[3] = v[8 * j + 4 * q + 3] * rs * g[j][q][3];
                    *(f32x4*)(out + (size_t)(m0 + i) * DM + col) = o; }
        }
    }
}

#ifndef MK_DUP_G2
#define MK_DUP_G2 0
#endif
#ifndef MK_DUP_GQ
#define MK_DUP_GQ 0
#endif
#ifndef MK_DUP_SCAN
#define MK_DUP_SCAN 0
#endif
#ifndef MK_DUP_ATTN
#define MK_DUP_ATTN 0
#endif
#ifndef MK_DUP_FFN
#define MK_DUP_FFN 0
#endif
#ifndef MK_DUP_PRO
#define MK_DUP_PRO 0
#endif
#ifndef MK_DUP_CONV
#define MK_DUP_CONV 0
#endif
#ifndef MK_EXTRA_BAR
#define MK_EXTRA_BAR 0
#endif
#ifndef MK_SCAN_MFMA
#define MK_SCAN_MFMA 1
#endif
#ifndef MK_ATTN_MFMA
#define MK_ATTN_MFMA 1
#endif
#ifndef MK_G6_REV
#define MK_G6_REV 0
#endif
#ifndef MK_ALIGN_EPI
#define MK_ALIGN_EPI true
#endif
#ifndef MK_SP2
#define MK_SP2 true
#endif
#ifndef MK_NAIVE_GEMM
#define MK_NAIVE_GEMM 1
#endif
#if MK_NAIVE_GEMM
#define RUN_GEMM(EPI_T, g_, S_, E_) pg8::gemm_phase_naive<EPI_T, pg8::StaticOrder>(g_, S_, E_)
#else
#define RUN_GEMM(EPI_T, g_, S_, E_) pg8::gemm_phase<EPI_T, pg8::StaticOrder, MK_ALIGN_EPI, MK_SP2>(lds + RING_OFF, g_, S_, E_, wave_s)
#endif

__global__ void __launch_bounds__(NWAVES * 64, 2) mk_fwd(Params p) {
    extern __shared__ __attribute__((aligned(16))) unsigned char lds_raw[];
    LAS unsigned char* lds = (LAS unsigned char*)lds_raw;
    volatile LAS unsigned* MISC = (volatile LAS unsigned*)(lds + MISC_OFF);
    const int tid = threadIdx.x;
    const int wave_s = __builtin_amdgcn_readfirstlane(tid >> 6);
    const int G = gridDim.x, bid = blockIdx.x;
    unsigned char* const ws0 = p.ws;
    gu32* ctl = (gu32*)(ws0 + WS_CTL);
    for (int u = tid; u < (LDS_BYTES - LDSCTL_OFF) / 4; u += NWAVES * 64) ((LAS unsigned*)(lds + LDSCTL_OFF))[u] = 0u;
    __syncthreads();
    XcdBarrier bar = xcd_barrier_post((unsigned*)(ctl + CW_BAR), MISC + 8);
#define GRID_BAR() xcd_barrier(bar)
    LAS float* const RST = (LAS float*)(lds + pg8::RS_TABLE_OFF);

#define OPQ_WS() (ws0)

    p0_prologue(p, lds, wave_s);
#if MK_DUP_PRO
    p0_prologue(p, lds, wave_s);
#endif
    GRID_BAR();

#pragma unroll 1
    for (int l = 0; l < 2; ++l) {
        unsigned char* ws = OPQ_WS();
        { pg8::Gemm g{(const pg8::bf16_t*)(ws + WS_MEMB), (const pg8::bf16_t*)(ws + WS_WKV + l * SZ_WKV), TMEM, 1024, 1024}; pg8::StaticOrder S; S.init(TMEM, 1024, G, (bid + G - (128 * l) % G) % G);
          pg8::EpiScale E{(pg8::bf16_t*)(ws + WS_KV + l * SZ_KV), 1024, nullptr, (const float*)(ws + WS_RMEM), 1.0f, RST};
          RUN_GEMM(pg8::EpiScale, g, S, E); }
        { pg8::Gemm g{(const pg8::bf16_t*)(ws + WS_WKV + l * SZ_WKV) + 1024 * 1024, (const pg8::bf16_t*)(ws + WS_MEMB), 1024, TMEM, 1024}; pg8::StaticOrder S; S.init(1024, TMEM, G, (bid + G - (128 * l + 64) % G) % G);
          pg8::EpiColScale E{(pg8::bf16_t*)(ws + WS_KV + l * SZ_KV + OFF_VT), TMEM, (const float*)(ws + WS_RMEM)};
          RUN_GEMM(pg8::EpiColScale, g, S, E); }
    }

#pragma unroll 1
    for (int l = 0; l < 2; ++l) {
        unsigned char* ws = OPQ_WS();
        float* SSQ = (float*)(ws + WS_SSQ);
        pg8::bf16_t* XB = (pg8::bf16_t*)(ws + WS_XB);
        pg8::bf16_t* P0 = (pg8::bf16_t*)(ws + WS_P), *P1 = (pg8::bf16_t*)(ws + WS_P + SZ_P), *P2 = (pg8::bf16_t*)(ws + WS_P + 2 * SZ_P), *P3 = (pg8::bf16_t*)(ws + WS_P + 3 * SZ_P);
        pg8::bf16_t* HB = P0;
        if (l == 0) {
            { pg8::Gemm g{XB, (const pg8::bf16_t*)(ws + WS_WCIN), TT, 3072, 1024, 64, (size_t)TT * 128, 64, (size_t)3072 * 128}; pg8::StaticOrder S; S.init(TT, 3072, G, bid);
              pg8::EpiPair<0> E{P0, 1024, P1, SSQ, RST};
              RUN_GEMM(pg8::EpiPair<0>, g, S, E); }
            GRID_BAR();
            conv_pass(P0, P1, p.in[4], P2, wave_s);
#if MK_DUP_CONV
            conv_pass(P0, P1, p.in[4], P2, wave_s);
#endif
            GRID_BAR();
            { pg8::Gemm g{P2, (const pg8::bf16_t*)(ws + WS_WCOUT), TT, 1024, 1024, 64, (size_t)TT * 128, 64, (size_t)1024 * 128}; pg8::StaticOrder S; S.init(TT, 1024, G, bid);
              pg8::EpiResid E{XB, SSQ, 1.0f};
              RUN_GEMM(pg8::EpiResid, g, S, E);
#if MK_DUP_G2
              RUN_GEMM(pg8::EpiResid, g, S, E);
#endif
            }
            GRID_BAR();
        } else {
            { pg8::Gemm g{XB, (const pg8::bf16_t*)(ws + WS_WHIN), TT, 4096, 1024, 64, (size_t)TT * 128, 64, (size_t)4096 * 128}; pg8::StaticOrder S; S.init(TT, 4096, G, bid);
              pg8::EpiHgrn E{P0, (size_t)TT * DM, SSQ, (const float*)(ws + WS_LB), RST};
              RUN_GEMM(pg8::EpiHgrn, g, S, E); }
            GRID_BAR();
#if MK_SCAN_MFMA
            late_weights(p, lds, wave_s);
            hg::scan_phase(lds, P0, P1, P2, P3, p.in[8], (bf16*)(ws + WS_Y), wave_s);
#if MK_DUP_SCAN
            hg::scan_phase(lds, P0, P1, P2, P3, p.in[8], (bf16*)(ws + WS_Y), wave_s);
#endif
            GRID_BAR();
            { pg8::Gemm g{(const pg8::bf16_t*)(ws + WS_Y), (const pg8::bf16_t*)(ws + WS_WHOUT), TT, 1024, 1024, 64, (size_t)TT * 128, 64, (size_t)1024 * 128};
#else
            scan_naive(P0, P1, P2, P3, p.in[8], lds_raw, G);
            GRID_BAR();
            { pg8::Gemm g{P0, (const pg8::bf16_t*)(ws + WS_WHOUT), TT, 1024, 1024};
#endif
              pg8::StaticOrder S; S.init(TT, 1024, G, bid);
              pg8::EpiResid E{XB, SSQ, 1.0f};
              RUN_GEMM(pg8::EpiResid, g, S, E); }
            GRID_BAR();
        }
        { pg8::Gemm g{XB, (const pg8::bf16_t*)(ws + WS_WQ + l * SZ_WQ), TT, 1024, 1024, 64, (size_t)TT * 128, 64, (size_t)1024 * 128}; pg8::StaticOrder S; S.init(TT, 1024, G, bid);
          pg8::EpiScale E{P0, 1024, SSQ, nullptr, QSCALE, RST};
          RUN_GEMM(pg8::EpiScale, g, S, E);
#if MK_DUP_GQ
          if (l == 0) { RUN_GEMM(pg8::EpiScale, g, S, E); }
#endif
        }
#if MK_ATTN_MFMA
        asm volatile("s_waitcnt vmcnt(0) lgkmcnt(0)" ::: "memory"); __syncthreads();
#else
        GRID_BAR();
#endif
#if MK_ATTN_MFMA
        xat::attn_phase(lds, P0, (const bf16*)(ws + WS_KV + l * SZ_KV), (const bf16*)(ws + WS_KV + l * SZ_KV + OFF_VT), P1, wave_s);
#if MK_DUP_ATTN
        xat::attn_phase(lds, P0, (const bf16*)(ws + WS_KV + l * SZ_KV), (const bf16*)(ws + WS_KV + l * SZ_KV + OFF_VT), P1, wave_s);
#endif
#else
        attn_naive(P0, (const bf16*)(ws + WS_KV + l * SZ_KV), (const bf16*)(ws + WS_KV + l * SZ_KV + OFF_VT), P1, wave_s);
#endif
        GRID_BAR();
        { pg8::Gemm g{P1, (const pg8::bf16_t*)(ws + WS_WO + l * SZ_WO), TT, 1024, 1024, 64, (size_t)TT * 128, 64, (size_t)1024 * 128}; pg8::StaticOrder S; S.init(TT, 1024, G, bid);
          pg8::EpiResid E{XB, SSQ, 1.0f};
          RUN_GEMM(pg8::EpiResid, g, S, E); }
        GRID_BAR();
        { pg8::Gemm g{XB, (const pg8::bf16_t*)(ws + WS_WFIN + l * SZ_WFIN), TT, 2 * DFF, 1024, 64, (size_t)TT * 128, 64, (size_t)(2 * DFF) * 128}; pg8::StaticOrder S; S.init(TT, 2 * DFF, G, bid);
          pg8::EpiPair<1> E{HB, DFF, nullptr, SSQ, RST};
          RUN_GEMM(pg8::EpiPair<1>, g, S, E);
#if MK_DUP_FFN
          if (l == 0) { RUN_GEMM(pg8::EpiPair<1>, g, S, E); }
#endif
        }
        GRID_BAR();
        { pg8::Gemm g{HB, (const pg8::bf16_t*)(ws + WS_WFOUT + l * SZ_WFOUT), TT, 1024, DFF, 64, (size_t)TT * 128, 64, (size_t)1024 * 128};     pg8::StaticOrder S; S.init(TT, 1024, G, bid, MK_G6_REV);
          pg8::EpiResid E{XB, SSQ, 1.0f};
          RUN_GEMM(pg8::EpiResid, g, S, E);
#if MK_DUP_G6
          if (l == 0) { pg8::EpiResid E0{XB, SSQ, 0.0f}; RUN_GEMM(pg8::EpiResid, g, S, E0); }
#endif
        }
        GRID_BAR();
    }
#if MK_EXTRA_BAR
#pragma unroll 1
    for (int eb = 0; eb < MK_EXTRA_BAR; ++eb) GRID_BAR();
#endif
    final_norm((const bf16*)(OPQ_WS() + WS_XB), p.in[18], p.out, wave_s);
}

extern "C" void kernel_launch(void* const* d_in, const int* in_sizes, int n_in, void* d_out, int out_size, void* d_ws, size_t ws_size, hipStream_t stream) {
    static int grid = 0;
    if (grid == 0) {
        if (n_in != 19 || out_size != TT * DM || ws_size < WS_END) { fprintf(stderr, "kernel_launch: unexpected shapes (n_in %d, out %d, ws %zu); nothing launched\n", n_in, out_size, ws_size); grid = -1; return; }
        int dev = 0, cus = 0, per_cu = 0;
        if (hipGetDevice(&dev) != hipSuccess || hipDeviceGetAttribute(&cus, hipDeviceAttributeMultiprocessorCount, dev) != hipSuccess) { fprintf(stderr, "kernel_launch: device query failed\n"); grid = -1; return; }
        if (hipFuncSetAttribute((const void*)mk_fwd, hipFuncAttributeMaxDynamicSharedMemorySize, LDS_BYTES) != hipSuccess) { fprintf(stderr, "kernel_launch: hipFuncSetAttribute failed\n"); grid = -1; return; }
        if (hipOccupancyMaxActiveBlocksPerMultiprocessor(&per_cu, (const void*)mk_fwd, NWAVES * 64, LDS_BYTES) != hipSuccess || per_cu < 1) { fprintf(stderr, "kernel_launch: occupancy query says %d blocks per CU\n", per_cu); per_cu = 1; }
        (void)hipGetLastError();
        grid = cus;
    }
    if (grid < 0) return;
    if (hipMemsetAsync((char*)d_ws + WS_CTL, 0, CTL_ZERO_BYTES, stream) != hipSuccess) { fprintf(stderr, "kernel_launch: memset failed\n"); return; }
    Params a{};
    for (int i = 0; i < 19; ++i) a.in[i] = (const float*)d_in[i];
    a.out = (float*)d_out; a.ws = (unsigned char*)d_ws;
    hipLaunchKernelGGL(mk_fwd, dim3(grid), dim3(NWAVES * 64), LDS_BYTES, stream, a);
    const hipError_t le = hipPeekAtLastError();
    if (le != hipSuccess) fprintf(stderr, "kernel_launch: launch failed: %s\n", hipGetErrorName(le));
}
```

```cpp
#define MK_NAIVE_GEMM 0
#include <hip/hip_runtime.h>
#include <cstdio>
#include <cstdint>
namespace pg8 {
#define PG8_LAS __attribute__((address_space(3)))
typedef unsigned short bf16_t;
typedef short bf16x8 __attribute__((ext_vector_type(8)));
typedef float f32x4 __attribute__((ext_vector_type(4)));
typedef unsigned u32x4 __attribute__((ext_vector_type(4)));
constexpr int BM = 256, BK = 64, HALF = 128, HTB = HALF * BK * 2  , STAGE_BYTES = 8 * HTB, NXCD = 8, WGM = 8;

__host__ __device__ __forceinline__ int lds_byte(int r, int c) { const int st = (r >> 4) * 2 + (c >> 5), rr = r & 15, cc = c & 31, ob = rr * 64 + cc * 2; return st * 1024 + (ob ^ (((ob >> 9) & 1) << 5)); }
__host__ __device__ __forceinline__ void stage_rc(int b, int& R, int& C) { const int st = b / 1024, sb = b % 1024, swz = sb ^ (((sb >> 9) & 1) << 5); R = (st >> 1) * 16 + swz / 64; C = (st & 1) * 32 + (swz % 64) / 2; }
__host__ __device__ __forceinline__ int perm32(int rho) { const int n = rho >> 4, i = rho & 15; return 8 * (i >> 2) + 4 * n + (i & 3); }

struct Unit { int pm, pn, idx; };
struct Gemm { const bf16_t* A; const bf16_t* Bt; int M, N, K; int lda; size_t kstepA; int ldb; size_t kstepB; };

struct StaticOrder {
    int nM, nN, nwg, G, c, rev;
    __host__ __device__ void init(int M, int N, int G_, int c_, int rev_ = 0) { nM = M / BM; nN = N / BM; nwg = nM * nN; G = G_; c = c_; rev = rev_; }
    __host__ __device__ bool next(int i, Unit& u) const {
        const long L = (long)i * G + c; if (L >= nwg) return false;
        int wgid = (int)L; { const int q = nwg / NXCD, r = nwg % NXCD, xcd = wgid % NXCD, off = wgid / NXCD; wgid = (xcd < r ? xcd * (q + 1) : r * (q + 1) + (xcd - r) * q) + off; }
        const int nig = WGM * nN, gid = wgid / nig, fm = gid * WGM, gsz = (nM - fm) < WGM ? (nM - fm) : WGM;
        u.pm = fm + ((wgid % nig) % gsz); u.pn = (wgid % nig) / gsz; if (rev) u.pm = nM - 1 - u.pm; return true;
    }
    __device__ __forceinline__ void a_ready(const Unit&) const {}
    __device__ __forceinline__ void done(const Unit&) const {}
};

typedef float f32x2_cv __attribute__((ext_vector_type(2))); typedef __bf16 bf16x2_cv __attribute__((ext_vector_type(2)));
__device__ __forceinline__ unsigned cvt_pk_bf16(float lo, float hi) { f32x2_cv v = {lo, hi}; bf16x2_cv b = __builtin_convertvector(v, bf16x2_cv); return __builtin_bit_cast(unsigned, b); }
__device__ __forceinline__ float xor16_get(float x) { return __int_as_float(__builtin_amdgcn_ds_swizzle(__float_as_int(x), 0x401F)); }
__device__ __forceinline__ float xor32_sum(float x) { const auto rr = __builtin_amdgcn_permlane32_swap(__float_as_uint(x), __float_as_uint(x), false, false); return __uint_as_float(rr[0]) + __uint_as_float(rr[1]); }
__device__ __forceinline__ float xor32_max(float x) { const auto rr = __builtin_amdgcn_permlane32_swap(__float_as_uint(x), __float_as_uint(x), false, false); return fmaxf(__uint_as_float(rr[0]), __uint_as_float(rr[1])); }
__device__ __forceinline__ float lane_get(float x, int srclane) { return __int_as_float(__builtin_amdgcn_ds_bpermute(srclane << 2, __float_as_int(x))); }
typedef unsigned u32x2 __attribute__((ext_vector_type(2)));
constexpr int TT_ROWS = 32768;
__device__ __forceinline__ void rs_rows(const float* ssq, const float* rdirect, int rowbase, int lane, float (&v)[2]) {
#pragma unroll
    for (int ai = 0; ai < 2; ++ai) {
        const int row = rowbase + ai * HALF + lane;
        if (rdirect) v[ai] = rdirect[row];
        else { const f32x4* sp = (const f32x4*)(ssq + (size_t)row * 16);
            const f32x4 s0 = sp[0], s1 = sp[1], s2 = sp[2], s3 = sp[3];
            const float s = (((s0[0] + s0[1]) + (s0[2] + s0[3])) + ((s1[0] + s1[1]) + (s1[2] + s1[3]))) + (((s2[0] + s2[1]) + (s2[2] + s2[3])) + ((s3[0] + s3[1]) + (s3[2] + s3[3])));
            v[ai] = rsqrtf(s * (1.0f / 1024.0f) + 1e-6f); }
    }
}
__device__ __forceinline__ float sigm_f(float x) { return __builtin_amdgcn_rcpf(1.0f + __builtin_amdgcn_exp2f(x * -1.4426950408889634f)); }
constexpr int RS_TABLE_OFF = 131072 + 2048, RS_MAX_UNITS = 14;
template <class Sched> __device__ __forceinline__ void fill_rs_table(const Sched& S, const float* ssq, const float* rdirect, PG8_LAS float* RS, int tid) {
    Unit u;
#pragma unroll 1
    for (int i0 = 0; i0 < RS_MAX_UNITS; i0 += 2) { const int i = i0 + (tid >> 8);
        if (S.next(i, u)) { const int row = u.pm * BM + (tid & 255);
          if (rdirect) RS[i * 256 + (tid & 255)] = rdirect[row];
          else { const f32x4* sp = (const f32x4*)(ssq + (size_t)row * 16);
            const f32x4 s0 = sp[0], s1 = sp[1], s2 = sp[2], s3 = sp[3];
            const float s = (((s0[0] + s0[1]) + (s0[2] + s0[3])) + ((s1[0] + s1[1]) + (s1[2] + s1[3]))) + (((s2[0] + s2[1]) + (s2[2] + s2[3])) + ((s3[0] + s3[1]) + (s3[2] + s3[3])));
            RS[i * 256 + (tid & 255)] = rsqrtf(s * (1.0f / 1024.0f) + 1e-6f); } }
        if (!S.next(i0 + 2, u)) break; }
    asm volatile("s_waitcnt vmcnt(0) lgkmcnt(0)\n\ts_barrier" ::: "memory");
}
__device__ __forceinline__ float silu_f(float x) { return x * sigm_f(x); }
__device__ __forceinline__ u32x4 pack8(const f32x4 v0, const f32x4 v1) { u32x4 w; w.x = cvt_pk_bf16(v0[0], v0[1]); w.y = cvt_pk_bf16(v0[2], v0[3]); w.z = cvt_pk_bf16(v1[0], v1[1]); w.w = cvt_pk_bf16(v1[2], v1[3]); return w; }

template <int MODE> struct EpiPair {
    static constexpr bool PERM = true, AFTER_DRAIN = false, IDEMP = true;
    bf16_t* OUT; int ldo; bf16_t* GB; const float* ssq; PG8_LAS float* rst;
    template <class Sched> __device__ __forceinline__ void prepare(const Sched& S, int tid) const { fill_rs_table(S, ssq, nullptr, rst, tid); }
    __device__ __forceinline__ void operator()(const f32x4 (&acc)[2][2][4][2], const Unit& u, int wr, int wc, int fr, int fq) const {
        const int row0 = u.pm * BM + wr * 64 + fr;
        const PG8_LAS float* rsp = rst + u.idx * 256 + wr * 64 + fr;
        if (MODE == 0 && u.pn >= 8) {
            const int col0 = (u.pn - 8) * 256 + wc * 32 + 8 * fq;
#pragma unroll
            for (int ai = 0; ai < 2; ++ai)
#pragma unroll
                for (int m = 0; m < 4; ++m) { const int row = row0 + ai * HALF + m * 16; const float rs = rsp[ai * HALF + m * 16]; bf16_t* rowp = GB + (size_t)row * 1024 + col0;
#pragma unroll
                    for (int bj = 0; bj < 2; ++bj) *(u32x4*)(rowp + bj * HALF) = pack8(acc[ai][bj][m][0] * rs, acc[ai][bj][m][1] * rs); }
        } else {
            const int col0 = u.pn * 128 + wc * 32 + 8 * fq;
#if MK_EPI_REP
#pragma unroll 1
            for (int rep_ = 0; rep_ < (MODE == 1 ? 2 : 1); ++rep_)
#endif
#pragma unroll
            for (int ai = 0; ai < 2; ++ai)
#pragma unroll
                for (int m = 0; m < 4; ++m) { const int row = row0 + ai * HALF + m * 16; const float rs = rsp[ai * HALF + m * 16];
                    const f32x4 a0 = acc[ai][0][m][0] * rs, a1 = acc[ai][0][m][1] * rs, b0 = acc[ai][1][m][0] * rs, b1 = acc[ai][1][m][1] * rs; f32x4 v0, v1;
                    if (MODE == 0) { v0 = a0 * b0; v1 = a1 * b1; }
                    else {
#pragma unroll
                        for (int j = 0; j < 4; ++j) { v0[j] = silu_f(a0[j]) * b0[j]; v1[j] = silu_f(a1[j]) * b1[j]; } }
                    if (MODE == 1) {
                        const int kt = 2 * u.pn + (wc >> 1), within = (wc & 1) * 32 + 8 * fq;
                        *(u32x4*)(OUT + ((size_t)kt * TT_ROWS + row) * 64 + within) = pack8(v0, v1);
                    } else *(u32x4*)(OUT + (size_t)row * ldo + col0) = pack8(v0, v1); }
        }
    }
};
struct EpiResid {
    static constexpr bool PERM = true, AFTER_DRAIN = false, IDEMP = false;
    bf16_t* xb; float* ssq; float sc;
    template <class Sched> __device__ __forceinline__ void prepare(const Sched&, int) const {}
    __device__ __forceinline__ void operator()(const f32x4 (&acc)[2][2][4][2], const Unit& u, int wr, int wc, int fr, int fq) const {
        const int row0 = u.pm * BM + wr * 64 + fr;
        bf16_t* rp[2]; u32x4 bres[2][4][2];
#pragma unroll
        for (int bj = 0; bj < 2; ++bj) rp[bj] = xb + ((size_t)(4 * u.pn + 2 * bj + (wc >> 1)) * TT_ROWS + row0) * 64 + (wc & 1) * 32 + 8 * fq;
#pragma unroll
        for (int ai = 0; ai < 2; ++ai)
#pragma unroll
            for (int m = 0; m < 4; ++m)
#pragma unroll
                for (int bj = 0; bj < 2; ++bj) bres[ai][m][bj] = *(const u32x4*)(rp[bj] + (size_t)(ai * HALF + m * 16) * 64);
#pragma unroll
        for (int ai = 0; ai < 2; ++ai)
#pragma unroll
            for (int m = 0; m < 4; ++m) { const int row = row0 + ai * HALF + m * 16; float sq = 0.f;
#pragma unroll
                for (int bj = 0; bj < 2; ++bj) { const u32x4 b = bres[ai][m][bj];
                    f32x4 o0 = acc[ai][bj][m][0] * sc, o1 = acc[ai][bj][m][1] * sc;
                    o0[0] += __uint_as_float(b.x << 16); o0[1] += __uint_as_float(b.x & 0xffff0000u); o0[2] += __uint_as_float(b.y << 16); o0[3] += __uint_as_float(b.y & 0xffff0000u);
                    o1[0] += __uint_as_float(b.z << 16); o1[1] += __uint_as_float(b.z & 0xffff0000u); o1[2] += __uint_as_float(b.w << 16); o1[3] += __uint_as_float(b.w & 0xffff0000u);
                    const u32x4 w = pack8(o0, o1); *(u32x4*)(rp[bj] + (size_t)(ai * HALF + m * 16) * 64) = w;
                    const float r0 = __uint_as_float(w.x << 16), r1 = __uint_as_float(w.x & 0xffff0000u), r2 = __uint_as_float(w.y << 16), r3 = __uint_as_float(w.y & 0xffff0000u);
                    const float r4 = __uint_as_float(w.z << 16), r5 = __uint_as_float(w.z & 0xffff0000u), r6 = __uint_as_float(w.w << 16), r7 = __uint_as_float(w.w & 0xffff0000u);
                    sq += ((r0 * r0 + r1 * r1) + (r2 * r2 + r3 * r3)) + ((r4 * r4 + r5 * r5) + (r6 * r6 + r7 * r7)); }
                sq += xor16_get(sq); sq = xor32_sum(sq);
                if (fq == 0) ssq[(size_t)row * 16 + (u.pn * 4 + wc)] = sq; }
    }
};
struct EpiScale {
    static constexpr bool PERM = true, AFTER_DRAIN = false, IDEMP = true;
    bf16_t* O; int ldc; const float* ssq; const float* rdirect; float scale; PG8_LAS float* rst;
    template <class Sched> __device__ __forceinline__ void prepare(const Sched& S, int tid) const { fill_rs_table(S, ssq, rdirect, rst, tid); }
    __device__ __forceinline__ void operator()(const f32x4 (&acc)[2][2][4][2], const Unit& u, int wr, int wc, int fr, int fq) const {
        const int row0 = u.pm * BM + wr * 64 + fr, col0 = u.pn * BM + wc * 32 + 8 * fq;
        const PG8_LAS float* rsp = rst + u.idx * 256 + wr * 64 + fr;
#pragma unroll
        for (int ai = 0; ai < 2; ++ai)
#pragma unroll
            for (int m = 0; m < 4; ++m) { const int row = row0 + ai * HALF + m * 16; const float rs = rsp[ai * HALF + m * 16] * scale; bf16_t* rowp = O + (size_t)row * ldc + col0;
#pragma unroll
                for (int bj = 0; bj < 2; ++bj) *(u32x4*)(rowp + bj * HALF) = pack8(acc[ai][bj][m][0] * rs, acc[ai][bj][m][1] * rs); }
    }
};
struct EpiHgrn {
    static constexpr bool PERM = true, AFTER_DRAIN = false, IDEMP = true;
    bf16_t* P; size_t pstride; const float* ssq; const float* lb; PG8_LAS float* rst;
    template <class Sched> __device__ __forceinline__ void prepare(const Sched& S, int tid) const { fill_rs_table(S, ssq, nullptr, rst, tid); }
    __device__ __forceinline__ void operator()(const f32x4 (&acc)[2][2][4][2], const Unit& u, int wr, int wc, int fr, int fq) const {
        const int row0 = u.pm * BM + wr * 64 + fr, type = u.pn >> 2, col0 = (u.pn & 3) * BM + wc * 32 + 8 * fq;
        const int bb = u.pm >> 3, t0 = (u.pm & 7) * BM + wr * 64 + fr;
        bf16_t* base = P + (size_t)type * pstride + ((size_t)(bb * 8 + (u.pn & 3) * 2) * 2048 + t0) * 128 + wc * 32 + 8 * fq;
        const PG8_LAS float* rsp = rst + u.idx * 256 + wr * 64 + fr;
        if (type == 1) {
#pragma unroll
            for (int bj = 0; bj < 2; ++bj) {
                const f32x4 l0 = *(const f32x4*)(lb + col0 + bj * HALF), l1 = *(const f32x4*)(lb + col0 + bj * HALF + 4);
#pragma unroll
                for (int ai = 0; ai < 2; ++ai)
#pragma unroll
                    for (int m = 0; m < 4; ++m) { const float rs = rsp[ai * HALF + m * 16]; f32x4 v0, v1;
#pragma unroll
                        for (int j = 0; j < 4; ++j) { const float s0 = sigm_f(acc[ai][bj][m][0][j] * rs), s1 = sigm_f(acc[ai][bj][m][1][j] * rs);
                            v0[j] = __log2f(l0[j] + (1.0f - l0[j]) * s0); v1[j] = __log2f(l1[j] + (1.0f - l1[j]) * s1); }
                        *(u32x4*)(base + (size_t)(ai * HALF + m * 16) * 128 + (size_t)bj * (2048 * 128)) = pack8(v0, v1); }
            }
        } else if (type == 2) {
#pragma unroll
            for (int ai = 0; ai < 2; ++ai)
#pragma unroll
                for (int m = 0; m < 4; ++m) { const float rs = rsp[ai * HALF + m * 16];
#pragma unroll
                    for (int bj = 0; bj < 2; ++bj) *(u32x4*)(base + (size_t)(ai * HALF + m * 16) * 128 + (size_t)bj * (2048 * 128)) = pack8(acc[ai][bj][m][0] * rs, acc[ai][bj][m][1] * rs); }
        } else {
#pragma unroll
            for (int ai = 0; ai < 2; ++ai)
#pragma unroll
                for (int m = 0; m < 4; ++m) { const float rs = rsp[ai * HALF + m * 16];
#pragma unroll
                    for (int bj = 0; bj < 2; ++bj) { f32x4 v0, v1;
#pragma unroll
                        for (int j = 0; j < 4; ++j) { v0[j] = silu_f(acc[ai][bj][m][0][j] * rs); v1[j] = silu_f(acc[ai][bj][m][1][j] * rs); }
                        *(u32x4*)(base + (size_t)(ai * HALF + m * 16) * 128 + (size_t)bj * (2048 * 128)) = pack8(v0, v1); } }
        }
    }
};
struct EpiColScale {
    static constexpr bool PERM = true, AFTER_DRAIN = false, IDEMP = true;
    bf16_t* O; int ldc; const float* cs;
    template <class Sched> __device__ __forceinline__ void prepare(const Sched&, int) const {}
    __device__ __forceinline__ void operator()(const f32x4 (&acc)[2][2][4][2], const Unit& u, int wr, int wc, int fr, int fq) const {
        const int row0 = u.pm * BM + wr * 64 + fr, col0 = u.pn * BM + wc * 32 + 8 * fq;
#pragma unroll
        for (int bj = 0; bj < 2; ++bj) { const f32x4 c0 = *(const f32x4*)(cs + col0 + bj * HALF), c1 = *(const f32x4*)(cs + col0 + bj * HALF + 4);
#pragma unroll
            for (int ai = 0; ai < 2; ++ai)
#pragma unroll
                for (int m = 0; m < 4; ++m) *(u32x4*)(O + (size_t)(row0 + ai * HALF + m * 16) * ldc + col0 + bj * HALF) = pack8(acc[ai][bj][m][0] * c0, acc[ai][bj][m][1] * c1); }
    }
};
template <class Epi, class Sched, bool ALIGN_EPI = false, bool SP2 = false>
__device__ __forceinline__ void gemm_phase(PG8_LAS unsigned char* lds, const Gemm g, const Sched& S, const Epi& E, const int wave_s) {
    unsigned z_ = 0u; asm volatile("" : "+v"(z_));
    int tid_ = (wave_s << 6) | (int)__builtin_amdgcn_mbcnt_hi(~0u, __builtin_amdgcn_mbcnt_lo(~0u, z_)); asm volatile("" : "+v"(tid_));
    const int tid = tid_, wid = __builtin_amdgcn_readfirstlane(tid >> 6), lane = tid & 63, wr = wid >> 2, wc = wid & 3, fr = lane & 15, fq = lane >> 4;
    const int K = g.K, nt = K / BK;
    const int lda = g.lda ? g.lda : K, ldb = g.ldb ? g.ldb : K;
    unsigned voffA[2], voffB[2];
#pragma unroll
    for (int i = 0; i < 2; ++i) { int R, C; stage_rc(tid * 16 + i * 8192, R, C); const int Rb = Epi::PERM ? ((R & ~31) + perm32(R & 31)) : R;
        voffA[i] = (unsigned)(R * lda + C) * 2u; voffB[i] = (unsigned)(Rb * ldb + C) * 2u; }
    const size_t kstep = (size_t)(BK * 2);
    const size_t kstepA = g.kstepA ? g.kstepA : kstep, hstepA = (size_t)HALF * lda * 2, tstepA = 2 * hstepA;
    const size_t hstep = (size_t)HALF * ldb * 2;
    const size_t kstepB = g.kstepB ? g.kstepB : kstep;
    const size_t tstep = 2 * hstep;
    const unsigned ldsw = (unsigned)wid * 1024u;
    const int aoff = lds_byte(wr * 64 + fr, fq * 8), boff = lds_byte(wc * 32 + fr, fq * 8);
#define PG8_SA(b, h) (((b) * 2 + (h)) * HTB)
#define PG8_SB(b, h) ((4 + (b) * 2 + (h)) * HTB)
#define PG8_STAGE(bufoff, gbase, voff) do { _Pragma("unroll") for (int _i = 0; _i < 2; ++_i) \
        __builtin_amdgcn_global_load_lds((const unsigned*)((const char*)(gbase) + (voff)[_i]), (PG8_LAS unsigned*)(lds + (bufoff) + ldsw + _i * 8192), 16, 0, 0); } while (0)
#define PG8_LDA(dst, b, h) do { _Pragma("unroll") for (int m = 0; m < 4; ++m) _Pragma("unroll") for (int k = 0; k < 2; ++k) dst[m][k] = *(const PG8_LAS bf16x8*)(lds + PG8_SA(b, h) + aoff + m * 2048 + k * 1024); } while (0)
#define PG8_LDB(dst, b, h) do { _Pragma("unroll") for (int n = 0; n < 2; ++n) _Pragma("unroll") for (int k = 0; k < 2; ++k) dst[n][k] = *(const PG8_LAS bf16x8*)(lds + PG8_SB(b, h) + boff + n * 2048 + k * 1024); } while (0)
#define PG8_MMA(ai, bj, At, Bt) do { __builtin_amdgcn_s_setprio(1); _Pragma("unroll") for (int m = 0; m < 4; ++m) _Pragma("unroll") for (int n = 0; n < 2; ++n) _Pragma("unroll") for (int k = 0; k < 2; ++k) \
        acc[ai][bj][m][n] = __builtin_amdgcn_mfma_f32_16x16x32_bf16(Bt[n][k], At[m][k], acc[ai][bj][m][n], 0, 0, 0); __builtin_amdgcn_s_setprio(0); } while (0)
#define PG8_WAIT_V(n) asm volatile("s_waitcnt vmcnt(" #n ")" ::: "memory")
#define PG8_WAIT_L(n) asm volatile("s_waitcnt lgkmcnt(" #n ")" ::: "memory")
#define PG8_BAR __builtin_amdgcn_s_barrier()
#define PG8_SCHED __builtin_amdgcn_sched_barrier(0)
    Unit cur, nxt; int ui = 0;
    if (!S.next(0, cur)) return;
    E.prepare(S, tid);
    f32x4 acc[2][2][4][2];
#pragma unroll
    for (int a = 0; a < 2; ++a)
#pragma unroll
        for (int b = 0; b < 2; ++b)
#pragma unroll
            for (int m = 0; m < 4; ++m)
#pragma unroll
                for (int n = 0; n < 2; ++n) acc[a][b][m][n] = (f32x4){0.f, 0.f, 0.f, 0.f};
    bf16x8 At[4][2], B0[2][2], B1[2][2];
    const char* cA = (const char*)g.A + (size_t)cur.pm * tstepA; const char* cB = (const char*)g.Bt + (size_t)cur.pn * tstep;
    S.a_ready(cur);
    if constexpr (SP2) {
        PG8_STAGE(PG8_SB(0, 0), cB, voffB); PG8_STAGE(PG8_SB(0, 1), cB + hstep, voffB); PG8_STAGE(PG8_SA(0, 0), cA, voffA); PG8_STAGE(PG8_SA(0, 1), cA + hstepA, voffA);
        if (wr == 1) PG8_BAR;
        PG8_WAIT_V(2); PG8_BAR;
        PG8_STAGE(PG8_SB(1, 0), cB + kstepB, voffB); PG8_STAGE(PG8_SA(1, 0), cA + kstepA, voffA); PG8_STAGE(PG8_SB(1, 1), cB + hstep + kstepB, voffB);
        PG8_WAIT_V(6); PG8_BAR;
    } else {
        PG8_STAGE(PG8_SB(0, 0), cB, voffB); PG8_STAGE(PG8_SA(0, 0), cA, voffA); PG8_STAGE(PG8_SB(0, 1), cB + hstep, voffB); PG8_STAGE(PG8_SA(0, 1), cA + hstepA, voffA);
        if (wr == 1) PG8_BAR;
        PG8_WAIT_V(4); PG8_BAR;
        PG8_STAGE(PG8_SB(1, 0), cB + kstepB, voffB); PG8_STAGE(PG8_SA(1, 0), cA + kstepA, voffA); PG8_STAGE(PG8_SB(1, 1), cB + hstep + kstepB, voffB);
        PG8_WAIT_V(6); PG8_BAR;
    }
    for (;;) {
        const bool has_next = S.next(ui + 1, nxt);
        const char* nA = has_next ? (const char*)g.A + (size_t)nxt.pm * tstepA : cA; const char* nB = has_next ? (const char*)g.Bt + (size_t)nxt.pn * tstep : cB;
        for (int t = 0; t < nt; t += 2) {
            const bool last = (t == nt - 2);
            const char* a1 = cA + (size_t)(t + 1) * kstepA;
            const char* a2 = last ? nA : cA + (size_t)(t + 2) * kstepA; const char* b2 = last ? nB : cB + (size_t)(t + 2) * kstepB;
            const char* a3 = a2 + kstepA; const char* b3 = b2 + kstepB;
            if (last && has_next) S.a_ready(nxt);
            if constexpr (SP2) {
            PG8_LDB(B0, 0, 0); PG8_LDB(B1, 0, 1); PG8_SCHED; PG8_LDA(At, 0, 0); PG8_STAGE(PG8_SA(1, 1), a1 + hstepA, voffA);
            PG8_WAIT_V(8); PG8_WAIT_L(0); PG8_BAR; PG8_MMA(0, 0, At, B0); PG8_MMA(0, 1, At, B1); PG8_BAR; PG8_SCHED;
            PG8_LDA(At, 0, 1); PG8_STAGE(PG8_SB(0, 0), b2, voffB); PG8_STAGE(PG8_SB(0, 1), b2 + hstep, voffB); PG8_STAGE(PG8_SA(0, 0), a2, voffA);
            PG8_WAIT_V(8); PG8_WAIT_L(0); PG8_BAR; PG8_MMA(1, 0, At, B0); PG8_MMA(1, 1, At, B1); PG8_BAR; PG8_SCHED;
            PG8_LDB(B0, 1, 0); PG8_LDB(B1, 1, 1); PG8_SCHED; PG8_LDA(At, 1, 0); PG8_STAGE(PG8_SA(0, 1), a2 + hstepA, voffA);
            PG8_WAIT_V(8); PG8_WAIT_L(0); PG8_BAR; PG8_MMA(0, 0, At, B0); PG8_MMA(0, 1, At, B1); PG8_BAR; PG8_SCHED;
            PG8_LDA(At, 1, 1); PG8_STAGE(PG8_SB(1, 0), b3, voffB); PG8_STAGE(PG8_SB(1, 1), b3 + hstep, voffB); PG8_STAGE(PG8_SA(1, 0), a3, voffA);
            PG8_WAIT_V(8); PG8_WAIT_L(0); PG8_BAR; PG8_MMA(1, 0, At, B0); PG8_MMA(1, 1, At, B1); PG8_BAR; PG8_SCHED;
            } else {
            PG8_LDB(B0, 0, 0); PG8_SCHED; PG8_LDA(At, 0, 0); PG8_STAGE(PG8_SA(1, 1), a1 + hstepA, voffA);
            PG8_WAIT_L(8); PG8_BAR; PG8_WAIT_L(0); PG8_MMA(0, 0, At, B0); PG8_BAR; PG8_SCHED;
            PG8_LDB(B1, 0, 1); PG8_STAGE(PG8_SB(0, 0), b2, voffB);
            PG8_BAR; PG8_WAIT_L(0); PG8_MMA(0, 1, At, B1); PG8_BAR;
            PG8_LDA(At, 0, 1); PG8_STAGE(PG8_SA(0, 0), a2, voffA);
            PG8_BAR; PG8_WAIT_L(0); PG8_MMA(1, 0, At, B0); PG8_BAR; PG8_SCHED;
            PG8_STAGE(PG8_SB(0, 1), b2 + hstep, voffB);
            PG8_WAIT_V(6); PG8_BAR; PG8_MMA(1, 1, At, B1); PG8_BAR;
            PG8_LDB(B0, 1, 0); PG8_SCHED; PG8_LDA(At, 1, 0); PG8_STAGE(PG8_SA(0, 1), a2 + hstepA, voffA);
            PG8_WAIT_L(8); PG8_BAR; PG8_WAIT_L(0); PG8_MMA(0, 0, At, B0); PG8_BAR; PG8_SCHED;
            PG8_LDB(B1, 1, 1); PG8_STAGE(PG8_SB(1, 0), b3, voffB);
            PG8_BAR; PG8_WAIT_L(0); PG8_MMA(0, 1, At, B1); PG8_BAR;
            PG8_LDA(At, 1, 1); PG8_STAGE(PG8_SA(1, 0), a3, voffA);
            PG8_BAR; PG8_WAIT_L(0); PG8_MMA(1, 0, At, B0); PG8_BAR; PG8_SCHED;
            PG8_STAGE(PG8_SB(1, 1), b3 + hstep, voffB);
            PG8_WAIT_V(6); PG8_BAR; PG8_MMA(1, 1, At, B1); PG8_BAR;
            }
        }
        if constexpr (ALIGN_EPI) { if (wr == 0) PG8_BAR; }
        if constexpr (!Epi::AFTER_DRAIN) { Unit eu = cur; eu.idx = ui; asm volatile("" : "+s"(eu.pm), "+s"(eu.pn));
            E(acc, eu, wr, wc, fr, fq);
#if MK_DUP_EPI_ALL
            if constexpr (Epi::IDEMP) { asm volatile("" ::: "memory"); Unit eu2 = cur; asm volatile("" : "+s"(eu2.pm), "+s"(eu2.pn)); E(acc, eu2, wr, wc, fr, fq); }
#endif
            S.done(cur); }
        if (!has_next) break;
#pragma unroll
        for (int a = 0; a < 2; ++a)
#pragma unroll
            for (int b = 0; b < 2; ++b)
#pragma unroll
                for (int m = 0; m < 4; ++m)
#pragma unroll
                    for (int n = 0; n < 2; ++n) acc[a][b][m][n] = (f32x4){0.f, 0.f, 0.f, 0.f};
        cur = nxt; cA = nA; cB = nB; ++ui;
        if constexpr (ALIGN_EPI) { if (wr == 1) PG8_BAR; }
    }
    PG8_WAIT_V(0);
    if constexpr (!ALIGN_EPI) { if (wr == 0) PG8_BAR; }
    PG8_BAR;
    if constexpr (Epi::AFTER_DRAIN) { E.fused(acc, cur, wr, wc, fr, fq, lds, wid, lane); S.done(cur); }
#undef PG8_SA
#undef PG8_SB
#undef PG8_STAGE
#undef PG8_LDA
#undef PG8_LDB
#undef PG8_MMA
#undef PG8_WAIT_V
#undef PG8_WAIT_L
#undef PG8_BAR
#undef PG8_SCHED
}
__device__ __forceinline__ float bf2f(short s) { return __uint_as_float(((unsigned)(unsigned short)s) << 16); }
template <class Epi, class Sched>
__device__ __forceinline__ void gemm_phase_naive(const Gemm g, const Sched& S, const Epi& E) {
    int tid_ = threadIdx.x; asm volatile("" : "+v"(tid_));
    const int tid = tid_, wid = tid >> 6, lane = tid & 63, wr = wid >> 2, wc = wid & 3, fr = lane & 15, fq = lane >> 4;
    const int K = g.K; Unit u;
    for (int i = 0; S.next(i, u); ++i) {
        f32x4 acc[2][2][4][2];
#pragma unroll
        for (int a = 0; a < 2; ++a)
#pragma unroll
            for (int b = 0; b < 2; ++b)
#pragma unroll
                for (int m = 0; m < 4; ++m)
#pragma unroll
                    for (int n = 0; n < 2; ++n) acc[a][b][m][n] = (f32x4){0.f, 0.f, 0.f, 0.f};
        const bf16_t* Arow = g.A + (size_t)(u.pm * BM + wr * 64 + fr) * K;
#pragma unroll
        for (int bj = 0; bj < 2; ++bj) {
            const int cb = u.pn * BM + bj * HALF + wc * 32;
            const bf16_t* B0 = g.Bt + (size_t)(cb + (Epi::PERM ? 8 * fq : 4 * fq)) * K;
            const bf16_t* B1 = g.Bt + (size_t)(cb + (Epi::PERM ? 8 * fq + 4 : 16 + 4 * fq)) * K;
#pragma unroll 1
            for (int k0 = 0; k0 < K; k0 += 4) {
                float bf[2][4][4];
#pragma unroll
                for (int j = 0; j < 4; ++j) { const uint2 b0 = *(const uint2*)(B0 + (size_t)j * K + k0), b1 = *(const uint2*)(B1 + (size_t)j * K + k0);
                    bf[0][j][0] = __uint_as_float(b0.x << 16); bf[0][j][1] = __uint_as_float(b0.x & 0xffff0000u); bf[0][j][2] = __uint_as_float(b0.y << 16); bf[0][j][3] = __uint_as_float(b0.y & 0xffff0000u);
                    bf[1][j][0] = __uint_as_float(b1.x << 16); bf[1][j][1] = __uint_as_float(b1.x & 0xffff0000u); bf[1][j][2] = __uint_as_float(b1.y << 16); bf[1][j][3] = __uint_as_float(b1.y & 0xffff0000u); }
#pragma unroll
                for (int ai = 0; ai < 2; ++ai)
#pragma unroll
                    for (int m = 0; m < 4; ++m) { const uint2 a2 = *(const uint2*)(Arow + (size_t)(ai * HALF + m * 16) * K + k0);
                        const float a0 = __uint_as_float(a2.x << 16), a1 = __uint_as_float(a2.x & 0xffff0000u), a2f = __uint_as_float(a2.y << 16), a3 = __uint_as_float(a2.y & 0xffff0000u);
#pragma unroll
                        for (int n = 0; n < 2; ++n)
#pragma unroll
                            for (int j = 0; j < 4; ++j) acc[ai][bj][m][n][j] += a0 * bf[n][j][0] + a1 * bf[n][j][1] + a2f * bf[n][j][2] + a3 * bf[n][j][3]; }
            }
        }
        E(acc, u, wr, wc, fr, fq);
    }
}
}
#define GAS __attribute__((address_space(1)))
#define LAS __attribute__((address_space(3)))
typedef unsigned short bf16;
typedef unsigned v4u __attribute__((ext_vector_type(4)));
typedef float f32x4 __attribute__((ext_vector_type(4)));
typedef short bf16x8 __attribute__((ext_vector_type(8)));
typedef GAS unsigned gu32;
typedef GAS unsigned long long gu64;
#define RLX_AGENT __ATOMIC_RELAXED, __HIP_MEMORY_SCOPE_AGENT
#define LDS_WAIT() asm volatile("s_waitcnt lgkmcnt(0)" ::: "memory")
#define VM_WAIT() asm volatile("s_waitcnt vmcnt(0)" ::: "memory")
__device__ __forceinline__ unsigned long long rt() { return __builtin_amdgcn_s_memrealtime(); }
__device__ __forceinline__ unsigned pk2(float lo, float hi) { return pg8::cvt_pk_bf16(lo, hi); }
__device__ __forceinline__ unsigned f2bf(float f) { return pg8::cvt_pk_bf16(f, f) & 0xffffu; }
#define XB_TMO      128
#define XB_XCNT(j)  (256  + 64 * (j))
#define XB_XSUB(j)  (1280 + 64 * (j))
#define XB_XGEN(j)  (2304 + 64 * (j))
#define XB_TOP      3328
#define XB_TOPGEN   3392
#define XCD_BAR_WORDS 3456
#define XB_SPIN_CAP (1u << 22)

__device__ __forceinline__ unsigned xb_ld(unsigned* p)              { return __hip_atomic_load(p, __ATOMIC_RELAXED, __HIP_MEMORY_SCOPE_AGENT); }
__device__ __forceinline__ unsigned xb_add(unsigned* p, unsigned v) { return __hip_atomic_fetch_add(p, v, __ATOMIC_RELAXED, __HIP_MEMORY_SCOPE_AGENT); }
__device__ __forceinline__ unsigned xb_xcc_id() { return (unsigned)__builtin_amdgcn_s_getreg((3 << 11) | 20) & 0xFu; }
#define XB_SPIN(cond, bar) do { unsigned _sp = 0; while (cond) { __builtin_amdgcn_s_sleep(1); \
    if ((++_sp & 255u) == 0u) { if (xb_ld(&(bar)[XB_TMO])) break; if (_sp > XB_SPIN_CAP) { atomicAdd(&(bar)[XB_TMO], 1u); break; } } } } while (0)

struct XcdBarrier {
    unsigned* bar; unsigned x;
    volatile LAS unsigned* st;
};

__device__ __forceinline__ XcdBarrier xcd_barrier_post(unsigned* bar, volatile LAS unsigned* st) {
    XcdBarrier b; b.bar = bar; b.x = xb_xcc_id(); b.st = st;
    if (threadIdx.x == 0) (void)xb_add(&bar[XB_XCNT(b.x)], 1u);
    return b;
}
__device__ __forceinline__ void xcd_barrier_complete(unsigned* bar, unsigned x, unsigned& nloc, unsigned& nx) {
    const unsigned G = gridDim.x * gridDim.y * gridDim.z;
    unsigned sum, cnt, mine, sp = 0u;
    for (;;) {
        sum = 0u; cnt = 0u; mine = 0u;
#pragma unroll
        for (unsigned j = 0; j < 16; ++j) { const unsigned c = xb_ld(&bar[XB_XCNT(j)]); sum += c; cnt += (c > 0u) ? 1u : 0u; mine = (j == x) ? c : mine; }
        if (sum == G) break;
        __builtin_amdgcn_s_sleep(1);
        if ((++sp & 255u) == 0u) { if (xb_ld(&bar[XB_TMO])) break; if (sp > XB_SPIN_CAP) { atomicAdd(&bar[XB_TMO], 1u); break; } }
    }
    nloc = mine > 0u ? mine : 1u; nx = cnt > 0u ? cnt : 1u;
}

__device__ __forceinline__ void xcd_barrier(const XcdBarrier& b) {
    asm volatile("s_waitcnt vmcnt(0)" ::: "memory");
    __syncthreads();
    if (threadIdx.x == 0) {
        unsigned* bar = b.bar;
        __builtin_amdgcn_s_waitcnt(0);
        unsigned nloc = b.st[0], nx = b.st[1];
        if (nloc == 0u) { xcd_barrier_complete(bar, b.x, nloc, nx); b.st[0] = nloc; b.st[1] = nx; }
        const unsigned old = xb_add(&bar[XB_XSUB(b.x)], 1u);
        const unsigned gen = old / nloc;
        if (old + 1u == (gen + 1u) * nloc) {
            __builtin_amdgcn_fence(__ATOMIC_RELEASE, "agent");
            asm volatile("s_waitcnt vmcnt(0)" ::: "memory");
            const unsigned og = xb_add(&bar[XB_TOP], 1u);
            const unsigned tg = og / nx;
            if (og + 1u == (tg + 1u) * nx) xb_add(&bar[XB_TOPGEN], 1u);
            else XB_SPIN(xb_ld(&bar[XB_TOPGEN]) == tg, bar);
            __builtin_amdgcn_fence(__ATOMIC_ACQUIRE, "agent");
            xb_add(&bar[XB_XGEN(b.x)], 1u);
            asm volatile("s_waitcnt vmcnt(0)" ::: "memory");
        } else {
            XB_SPIN(xb_ld(&bar[XB_XGEN(b.x)]) == gen, bar);
            __builtin_amdgcn_fence(__ATOMIC_ACQUIRE, "agent");
            asm volatile("s_waitcnt vmcnt(0)" ::: "memory");
        }
    }
    __syncthreads();
}

constexpr int NWAVES = 8;
constexpr int DM = 1024, NBATCH = 16, SEQ = 2048, TT = NBATCH * SEQ, MEML = 256, TMEM = NBATCH * MEML, DFF = 2816, XH = 4, XHD = 256, HGH = 8, HGD = 128;
constexpr float EPS = 1e-6f;
constexpr float QSCALE = 0.0625f * 1.4426950408889634f;
static_assert(TT == pg8::TT_ROWS, "row count");
constexpr size_t MiB = 1u << 20;
constexpr size_t WS_CTL = 0, CTL_ZERO_BYTES = 1 * MiB;
constexpr size_t WS_SSQ = 1 * MiB;
constexpr size_t WS_RMEM = 3 * MiB;
constexpr size_t WS_LB = 3 * MiB + 65536;
constexpr size_t WS_WCIN = 4 * MiB, WS_WCOUT = 10 * MiB, WS_WHIN = 12 * MiB, WS_WHOUT = 20 * MiB, WS_WQ = 22 * MiB, WS_WKV = 26 * MiB, WS_WO = 34 * MiB, WS_WFIN = 38 * MiB, WS_WFOUT = 60 * MiB;
constexpr size_t SZ_WQ = 2 * MiB, SZ_WKV = 4 * MiB, SZ_WO = 2 * MiB, SZ_WFIN = 11 * MiB, SZ_WFOUT = 5 * MiB + 512 * 1024;
constexpr size_t WS_MEMB = 72 * MiB;
constexpr size_t WS_KV = 80 * MiB, SZ_KV = 16 * MiB, OFF_VT = 8 * MiB;
constexpr size_t WS_XB = 112 * MiB;
constexpr size_t WS_P = 176 * MiB, SZ_P = 64 * MiB;
constexpr size_t WS_Y = 432 * MiB;
constexpr size_t WS_END = 496 * MiB;
constexpr int CW_BAR = 4096;
constexpr int RING_OFF = 0, RING_BYTES = 131072;
constexpr int LDSCTL_OFF = RING_BYTES, MISC_OFF = LDSCTL_OFF + 320;
constexpr int LDS_BYTES = 147456;

struct Params { const float* in[19]; float* out; unsigned char* ws; };

__device__ __forceinline__ int opaque_tid(int wave_s) { unsigned z = 0u; asm volatile("" : "+v"(z));
    int t = (wave_s << 6) | (int)__builtin_amdgcn_mbcnt_hi(~0u, __builtin_amdgcn_mbcnt_lo(~0u, z)); asm volatile("" : "+v"(t)); return t; }
#define SWZ_XOR(x, m) __int_as_float(__builtin_amdgcn_ds_swizzle(__float_as_int(x), ((m) << 10) | 0x1f))
__device__ __forceinline__ float wave_sum(float v) {
    v += SWZ_XOR(v, 1); v += SWZ_XOR(v, 2); v += SWZ_XOR(v, 4); v += SWZ_XOR(v, 8); v += SWZ_XOR(v, 16);
    return pg8::xor32_sum(v);
}
__device__ __forceinline__ float wave_max(float v) {
    v = fmaxf(v, SWZ_XOR(v, 1)); v = fmaxf(v, SWZ_XOR(v, 2)); v = fmaxf(v, SWZ_XOR(v, 4)); v = fmaxf(v, SWZ_XOR(v, 8)); v = fmaxf(v, SWZ_XOR(v, 16));
    return pg8::xor32_max(v);
}
__device__ __forceinline__ float bfu2f(unsigned short s) { return __uint_as_float(((unsigned)s) << 16); }
__device__ __forceinline__ float bflo(unsigned w) { return __uint_as_float(w << 16); }
__device__ __forceinline__ float bfhi(unsigned w) { return __uint_as_float(w & 0xffff0000u); }

__device__ __forceinline__ int map_row(int mode, int n0) {
    if (mode == 1) { if (n0 < 1024) return 2048 + n0; if (n0 < 2048) { const int c = n0 - 1024; return 256 * (c >> 7) + (c & 127); } const int c = n0 - 2048; return 256 * (c >> 7) + 128 + (c & 127); }
    if (mode == 2) { if (n0 < DFF) return 256 * (n0 >> 7) + (n0 & 127); const int c = n0 - DFF; return 256 * (c >> 7) + 128 + (c & 127); }
    return n0;
}
struct TrItem { const float* W; const float* gain; bf16* WT; int K, N, mode, r, tm; };
__device__ __forceinline__ void tr_load(const TrItem& d, int lane, f32x4 (&v)[8]) {
    const int nblk = d.N / 32, kb = d.r / nblk, nb = d.r % nblk, k0 = 64 * kb, n0 = 32 * nb;
    const float* src = d.W + (size_t)(k0 + (lane >> 3)) * d.N + n0 + 4 * (lane & 7);
#pragma unroll
    for (int i = 0; i < 8; ++i) v[i] = *(const GAS f32x4*)(src + (size_t)(8 * i) * d.N);
}
__device__ __forceinline__ void tr_store(const TrItem& d, int lane, const f32x4 (&v)[8], LAS float* scr) {
    const int nblk = d.N / 32, kb = d.r / nblk, nb = d.r % nblk, k0 = 64 * kb, n0 = 32 * nb;
#pragma unroll
    for (int i = 0; i < 8; ++i) { LAS float* t = scr + (8 * i + (lane >> 3)) * 33 + 4 * (lane & 7); t[0] = v[i].x; t[1] = v[i].y; t[2] = v[i].z; t[3] = v[i].w; }
    LDS_WAIT(); asm volatile("" ::: "memory");
    const int c = lane & 7, r0 = map_row(d.mode, n0);
    f32x4 g0 = {1.f, 1.f, 1.f, 1.f}, g1 = {1.f, 1.f, 1.f, 1.f};
    if (d.gain) { g0 = *(const f32x4*)(d.gain + k0 + 8 * c); g1 = *(const f32x4*)(d.gain + k0 + 8 * c + 4); }
#pragma unroll
    for (int j = 0; j < 4; ++j) { const int n = (lane >> 3) + 8 * j; const LAS float* t = scr + (8 * c) * 33 + n;
        v4u o; o.x = pk2(t[0 * 33] * g0.x, t[1 * 33] * g0.y); o.y = pk2(t[2 * 33] * g0.z, t[3 * 33] * g0.w); o.z = pk2(t[4 * 33] * g1.x, t[5 * 33] * g1.y); o.w = pk2(t[6 * 33] * g1.z, t[7 * 33] * g1.w);
        *(GAS v4u*)(d.WT + (size_t)(r0 + n) * d.K + k0 + 8 * c) = o; }
    LDS_WAIT(); asm volatile("" ::: "memory");
}
constexpr int TR_ITEMS_EARLY = (1024 / 64) * ((3072 + 1024 + 4096 + 1024 + 2048 + 2048 + 1024 + 5632) / 32) + (DFF / 64) * (1024 / 32);
constexpr int TR_ITEMS_LATE = (1024 / 64) * ((1024 + 1024 + 1024 + 5632) / 32) + (DFF / 64) * (1024 / 32);
__device__ __forceinline__ TrItem tr_decode(const Params& p, unsigned char* ws, int it, int list) {
    int r = it; TrItem d;
#define TR_ITEM(Wp, K_, N_, Gp, WTp, MODE_, TM_) { constexpr int cnt_ = ((K_) / 64) * ((N_) / 32); if (r < cnt_) { d.W = (Wp); d.gain = (Gp); d.WT = (bf16*)(WTp); d.K = (K_); d.N = (N_); d.mode = (MODE_); d.tm = (TM_); d.r = r; return d; } r -= cnt_; }
    if (list == 0) {
        TR_ITEM(p.in[3], 1024, 3072, p.in[2], ws + WS_WCIN, 1, 1)
        TR_ITEM(p.in[5], 1024, 1024, (const float*)nullptr, ws + WS_WCOUT, 0, 1)
        TR_ITEM(p.in[6], 1024, 4096, p.in[2] + 1024, ws + WS_WHIN, 0, 1)
        TR_ITEM(p.in[12], 1024, 1024, p.in[10], ws + WS_WQ, 0, 1)
        TR_ITEM(p.in[13], 1024, 2048, p.in[11], ws + WS_WKV, 0, 0)
        TR_ITEM(p.in[13] + 1024 * 2048, 1024, 2048, p.in[11] + 1024, ws + WS_WKV + SZ_WKV, 0, 0)
        TR_ITEM(p.in[14], 1024, 1024, (const float*)nullptr, ws + WS_WO, 0, 1)
        TR_ITEM(p.in[16], 1024, 5632, p.in[15], ws + WS_WFIN, 2, 1)
        d.W = p.in[17]; d.gain = nullptr; d.WT = (bf16*)(ws + WS_WFOUT); d.K = DFF; d.N = 1024; d.mode = 0; d.tm = 1; d.r = r; return d;
    }
    TR_ITEM(p.in[7], 1024, 1024, (const float*)nullptr, ws + WS_WHOUT, 0, 1)
    TR_ITEM(p.in[12] + 1024 * 1024, 1024, 1024, p.in[10] + 1024, ws + WS_WQ + SZ_WQ, 0, 1)
    TR_ITEM(p.in[14] + 1024 * 1024, 1024, 1024, (const float*)nullptr, ws + WS_WO + SZ_WO, 0, 1)
    TR_ITEM(p.in[16] + 1024 * 5632, 1024, 5632, p.in[15] + 1024, ws + WS_WFIN + SZ_WFIN, 2, 1)
#undef TR_ITEM
    d.W = p.in[17] + DFF * 1024; d.gain = nullptr; d.WT = (bf16*)(ws + WS_WFOUT + SZ_WFOUT); d.K = DFF; d.N = 1024; d.mode = 0; d.tm = 1; d.r = r; return d;
}
__device__ __forceinline__ void tr_run(const Params& p, unsigned char* ws, LAS float* scr, int list, int nitems, int it0, int stride, int lane) {
    int it = it0; f32x4 v[8];
    if (it < nitems) { TrItem d = tr_decode(p, ws, it, list); tr_load(d, lane, v); }
    while (it < nitems) {
        const TrItem d = tr_decode(p, ws, it, list);
#pragma unroll
        for (int i = 0; i < 8; ++i) { LAS float* t = scr + (8 * i + (lane >> 3)) * 33 + 4 * (lane & 7); t[0] = v[i].x; t[1] = v[i].y; t[2] = v[i].z; t[3] = v[i].w; }
        const int nx = it + stride;
        if (nx < nitems) { const TrItem dn = tr_decode(p, ws, nx, list); tr_load(dn, lane, v); }
        LDS_WAIT(); asm volatile("" ::: "memory");
        { const int nblk = d.N / 32, kb = d.r / nblk, nb = d.r % nblk, k0 = 64 * kb, n0 = 32 * nb; const int c = lane & 7, r0 = map_row(d.mode, n0);
          f32x4 g0 = {1.f, 1.f, 1.f, 1.f}, g1 = {1.f, 1.f, 1.f, 1.f};
          if (d.gain) { g0 = *(const f32x4*)(d.gain + k0 + 8 * c); g1 = *(const f32x4*)(d.gain + k0 + 8 * c + 4); }
#pragma unroll
          for (int j = 0; j < 4; ++j) { const int n = (lane >> 3) + 8 * j; const LAS float* t = scr + (8 * c) * 33 + n;
              v4u o; o.x = pk2(t[0 * 33] * g0.x, t[1 * 33] * g0.y); o.y = pk2(t[2 * 33] * g0.z, t[3 * 33] * g0.w); o.z = pk2(t[4 * 33] * g1.x, t[5 * 33] * g1.y); o.w = pk2(t[6 * 33] * g1.z, t[7 * 33] * g1.w);
              if (d.tm) *(GAS v4u*)(d.WT + ((size_t)(k0 >> 6) * d.N + r0 + n) * 64 + 8 * c) = o;
              else *(GAS v4u*)(d.WT + (size_t)(r0 + n) * d.K + k0 + 8 * c) = o; } }
        LDS_WAIT(); asm volatile("" ::: "memory");
        it = nx;
    }
}
template <bool TILE_MAJOR, int NR> __device__ __forceinline__ void row_group(const float* src, bf16* dst, int m0, int lane, float (&ss)[NR]) {
    f32x4 v[NR][4];
#pragma unroll
    for (int i = 0; i < NR; ++i) { const GAS f32x4* xa = (const GAS f32x4*)(src + (size_t)(m0 + i) * DM) + lane;
#pragma unroll
        for (int j = 0; j < 4; ++j) v[i][j] = xa[64 * j]; }
#pragma unroll
    for (int i = 0; i < NR; ++i) { float s = 0.f;
#pragma unroll
        for (int j = 0; j < 4; ++j) s += (v[i][j].x * v[i][j].x + v[i][j].y * v[i][j].y) + (v[i][j].z * v[i][j].z + v[i][j].w * v[i][j].w);
        ss[i] = wave_sum(s);
#pragma unroll
        for (int j = 0; j < 4; ++j) { const unsigned long long w = (unsigned long long)pk2(v[i][j].x, v[i][j].y) | ((unsigned long long)pk2(v[i][j].z, v[i][j].w) << 32);
            if (TILE_MAJOR) *((GAS unsigned long long*)(dst + ((size_t)(4 * j + (lane >> 4)) * TT + m0 + i) * 64 + 4 * (lane & 15))) = w;
            else *((GAS unsigned long long*)(dst + (size_t)(m0 + i) * DM) + lane + 64 * j) = w; } }
}
__device__ __forceinline__ void p0_prologue(const Params& p, LAS unsigned char* lds, int wave_s) {
    const int tid = opaque_tid(wave_s), lane = tid & 63, wave = __builtin_amdgcn_readfirstlane(tid >> 6), gw = blockIdx.x * NWAVES + wave, NGW = gridDim.x * NWAVES;
    unsigned char* ws = p.ws;
    LAS float* scr = (LAS float*)(lds + RING_OFF + wave * 16384);
    { const float* x = p.in[0]; bf16* XB = (bf16*)(ws + WS_XB); float* SSQ = (float*)(ws + WS_SSQ);
      for (int m = 4 * gw; m < TT; m += 4 * NGW) { float ss[4]; row_group<true, 4>(x, XB, m, lane, ss);
          SSQ[(size_t)(m + (lane >> 4)) * 16 + (lane & 15)] = ((lane & 15) == 0) ? (((lane >> 4) == 0) ? ss[0] : ((lane >> 4) == 1) ? ss[1] : ((lane >> 4) == 2) ? ss[2] : ss[3]) : 0.f; }
      const float* mem = p.in[1]; bf16* MEMB = (bf16*)(ws + WS_MEMB); float* RMEM = (float*)(ws + WS_RMEM);
      for (int m = 2 * gw; m < TMEM; m += 2 * NGW) { float ss[2]; row_group<false, 2>(mem, MEMB, m, lane, ss);
          if (lane < 2) RMEM[m + lane] = rsqrtf((lane ? ss[1] : ss[0]) * (1.0f / DM) + EPS); } }
    tr_run(p, ws, scr, 0, TR_ITEMS_EARLY, gw, NGW, lane);
    if ((int)gridDim.x <= NBATCH * HGH) tr_run(p, ws, scr, 1, TR_ITEMS_LATE, gw, NGW, lane);
    { float* LB = (float*)(ws + WS_LB); const int gt = gw * 64 + lane; if (gt < DM) LB[gt] = 1.0f / (1.0f + __expf(p.in[9][gt] - p.in[9][DM + gt])); }
}

__device__ __forceinline__ void conv_pass(const bf16* U2, const bf16* GBp, const float* cw, bf16* V, int wave_s) {
    const int gtid = blockIdx.x * (NWAVES * 64) + opaque_tid(wave_s), NT = gridDim.x * NWAVES * 64;
    constexpr int RUN = 8;
    for (int idx = gtid; idx < (TT / RUN) * 128; idx += NT) {
        const int c8 = (idx & 127) * 8, row0 = (idx >> 7) * RUN, t0 = row0 & (SEQ - 1);
        const f32x4 w0a = *(const f32x4*)(cw + c8), w0b = *(const f32x4*)(cw + c8 + 4);
        const f32x4 w1a = *(const f32x4*)(cw + DM + c8), w1b = *(const f32x4*)(cw + DM + c8 + 4);
        const f32x4 w2a = *(const f32x4*)(cw + 2 * DM + c8), w2b = *(const f32x4*)(cw + 2 * DM + c8 + 4);
        const v4u z4 = {0u, 0u, 0u, 0u};
        v4u uc = (t0 >= 2) ? *(const v4u*)(U2 + (size_t)(row0 - 2) * DM + c8) : z4;
        v4u ub = (t0 >= 1) ? *(const v4u*)(U2 + (size_t)(row0 - 1) * DM + c8) : z4;
        v4u ur[RUN], gr[RUN];
#pragma unroll
        for (int i = 0; i < RUN; ++i) { ur[i] = *(const v4u*)(U2 + (size_t)(row0 + i) * DM + c8); gr[i] = *(const v4u*)(GBp + (size_t)(row0 + i) * DM + c8); }
#pragma unroll
        for (int i = 0; i < RUN; ++i) { const v4u ua = ur[i], g = gr[i]; v4u o;
#define CV(W, e0, e1, wA, wB, wC) { const float z0 = wA[e0] * bflo(uc.W) + wB[e0] * bflo(ub.W) + wC[e0] * bflo(ua.W); const float z1 = wA[e1] * bfhi(uc.W) + wB[e1] * bfhi(ub.W) + wC[e1] * bfhi(ua.W); \
            o.W = pk2(bflo(g.W) * z0, bfhi(g.W) * z1); }
            CV(x, 0, 1, w0a, w1a, w2a) CV(y, 2, 3, w0a, w1a, w2a) CV(z, 0, 1, w0b, w1b, w2b) CV(w, 2, 3, w0b, w1b, w2b)
#undef CV
            *(v4u*)(V + ((size_t)(c8 >> 6) * TT + row0 + i) * 64 + (c8 & 63)) = o; uc = ub; ub = ua; }
    }
}

__device__ __forceinline__ void attn_naive(const bf16* Q, const bf16* Kb, const bf16* VT, bf16* O, int wave_s) {
    const int tid = opaque_tid(wave_s), lane = tid & 63, gw = blockIdx.x * NWAVES + __builtin_amdgcn_readfirstlane(tid >> 6), NGW = gridDim.x * NWAVES;
    for (int item = gw; item < TT * XH; item += NGW) {
        const int row = item >> 2, h = item & 3, b = row >> 11;
        const bf16* q = Q + (size_t)row * DM + h * XHD;
        const bf16* Kh = Kb + (size_t)(b * MEML) * DM + h * XHD;
        float sc[4] = {0.f, 0.f, 0.f, 0.f};
        for (int c = 0; c < 32; ++c) {
            const v4u qv = *(const v4u*)(q + 8 * c);
#pragma unroll
            for (int j = 0; j < 4; ++j) { const v4u kv = *(const v4u*)(Kh + (size_t)(lane + 64 * j) * DM + 8 * c);
                sc[j] += bflo(qv.x) * bflo(kv.x) + bfhi(qv.x) * bfhi(kv.x) + bflo(qv.y) * bflo(kv.y) + bfhi(qv.y) * bfhi(kv.y)
                       + bflo(qv.z) * bflo(kv.z) + bfhi(qv.z) * bfhi(kv.z) + bflo(qv.w) * bflo(kv.w) + bfhi(qv.w) * bfhi(kv.w); }
        }
        const float mx = wave_max(fmaxf(fmaxf(sc[0], sc[1]), fmaxf(sc[2], sc[3])));
        float pr[4]; float sum = 0.f;
#pragma unroll
        for (int j = 0; j < 4; ++j) { pr[j] = exp2f(sc[j] - mx); sum += pr[j]; }
        sum = wave_sum(sum); const float inv = 1.0f / sum;
        const bf16* Vh = VT + (size_t)(h * XHD) * TMEM + b * MEML;
        float keep = 0.f;
        for (int d = 0; d < XHD; ++d) {
            float part = 0.f;
#pragma unroll
            for (int j = 0; j < 4; ++j) part += pr[j] * bfu2f(Vh[(size_t)d * TMEM + lane + 64 * j]);
            part = wave_sum(part);
            if ((d & 63) == lane) keep = part * inv;
            if ((d & 63) == 63) O[(size_t)row * DM + h * XHD + (d - 63) + lane] = (bf16)f2bf(keep);
        }
    }
}


namespace xat {
typedef short bf16x8 __attribute__((ext_vector_type(8)));
typedef float f32x16 __attribute__((ext_vector_type(16)));
#define XAT_WAITBAR() asm volatile("s_waitcnt vmcnt(0) lgkmcnt(0)\n\ts_barrier" ::: "memory")
__device__ __forceinline__ void dma_k_half(LAS unsigned char* buf, const bf16* Kbh, int kh, int wid, int lane) {
    const int rho = 2 * wid + (lane >> 5), c = (lane & 31) ^ rho, key0 = 128 * kh + ((rho & ~12) | ((rho & 4) << 1) | ((rho & 8) >> 1));
    const bf16* src = Kbh + (size_t)key0 * 1024 + 8 * c;
#pragma unroll
    for (int i = 0; i < 8; ++i) __builtin_amdgcn_global_load_lds((const unsigned*)(src + (size_t)i * 16 * 1024), (LAS unsigned*)(buf + (wid + 8 * i) * 1024), 16, 0, 0);
}
__device__ __forceinline__ void dma_v_half(LAS unsigned char* buf, const bf16* VTbh, int kh, int wid, int lane) {
    const int rho = 4 * wid + (lane >> 4), c = (lane & 15) ^ (rho & 15);
    const bf16* src = VTbh + (size_t)rho * TMEM + 128 * kh + 8 * c;
#pragma unroll
    for (int i = 0; i < 8; ++i) __builtin_amdgcn_global_load_lds((const unsigned*)(src + (size_t)i * 32 * TMEM), (LAS unsigned*)(buf + (wid + 8 * i) * 1024), 16, 0, 0);
}
__device__ __forceinline__ void attn_phase(LAS unsigned char* lds, const bf16* Q, const bf16* Kb, const bf16* VT, bf16* O, int wave_s) {
    const int tid0 = opaque_tid(wave_s), wid = __builtin_amdgcn_readfirstlane(tid0 >> 6);
    const int G = gridDim.x, bx = blockIdx.x;
    LAS unsigned char* buf0 = lds; LAS unsigned char* buf1 = lds + 65536;
    LAS float* lsw = (LAS float*)(lds + 131072 + 1024) + wid * 32;
    pg8::StaticOrder SO; SO.init(TT, DM, G, bx); pg8::Unit qu;
    for (int ui = 0; SO.next(ui, qu); ++ui) {
        int tid = tid0; asm volatile("" : "+v"(tid));
        const int lane = tid & 63, r = lane & 31, h = lane >> 5, xk = h ^ (r & 15);
        const int qb = qu.pm & 7, hd = qu.pn, b = qu.pm >> 3;
        const size_t row0 = (size_t)b * SEQ + qb * 256 + wid * 32;
        const bf16* Kbh = Kb + (size_t)(b * MEML) * DM + hd * XHD;
        const bf16* VTbh = VT + (size_t)(hd * XHD) * TMEM + b * MEML;
        XAT_WAITBAR();
        dma_k_half(buf0, Kbh, 0, wid, lane); dma_k_half(buf1, Kbh, 1, wid, lane);
        bf16x8 qf[16];
#pragma unroll
        for (int ks = 0; ks < 16; ++ks) qf[ks] = *(const bf16x8*)(Q + (row0 + r) * DM + hd * XHD + 16 * ks + 8 * h);
        XAT_WAITBAR();
        f32x16 sacc[8];
#pragma unroll
        for (int kb = 0; kb < 8; ++kb)
#pragma unroll
            for (int i = 0; i < 16; ++i) sacc[kb][i] = 0.f;
        {
            bf16x8 kc[4], kn[4];
#pragma unroll
            for (int kbl = 0; kbl < 4; ++kbl) kc[kbl] = *(const LAS bf16x8*)(buf0 + r * 512 + kbl * 16384 + (((0) ^ xk) << 4));
#pragma unroll
            for (int st = 0; st < 32; ++st) { const int hf = st >> 4, ks = st & 15;
                if (st + 1 < 32) { const int hn = (st + 1) >> 4, kx = (st + 1) & 15; LAS unsigned char* nb = (hn ? buf1 : buf0) + r * 512 + (((2 * kx) ^ xk) << 4);
#pragma unroll
                    for (int kbl = 0; kbl < 4; ++kbl) kn[kbl] = *(const LAS bf16x8*)(nb + kbl * 16384); }
#pragma unroll
                for (int kbl = 0; kbl < 4; ++kbl) sacc[hf * 4 + kbl] = __builtin_amdgcn_mfma_f32_32x32x16_bf16(kc[kbl], qf[ks], sacc[hf * 4 + kbl], 0, 0, 0);
#pragma unroll
                for (int kbl = 0; kbl < 4; ++kbl) kc[kbl] = kn[kbl];
            }
        }
        XAT_WAITBAR();
        dma_v_half(buf0, VTbh, 0, wid, lane); dma_v_half(buf1, VTbh, 1, wid, lane);
        float mx = sacc[0][0];
#pragma unroll
        for (int kb = 0; kb < 8; ++kb)
#pragma unroll
            for (int i = 0; i < 16; ++i) mx = fmaxf(mx, sacc[kb][i]);
        mx = pg8::xor32_max(mx);
        float lsum = 0.f; bf16x8 pf[8][2];
#pragma unroll
        for (int kb = 0; kb < 8; ++kb) {
#pragma unroll
            for (int i = 0; i < 16; ++i) { const float pv = __builtin_amdgcn_exp2f(sacc[kb][i] - mx); sacc[kb][i] = pv; lsum += pv; }
#pragma unroll
            for (int s = 0; s < 2; ++s) { v4u w; w.x = pg8::cvt_pk_bf16(sacc[kb][8 * s + 0], sacc[kb][8 * s + 1]); w.y = pg8::cvt_pk_bf16(sacc[kb][8 * s + 2], sacc[kb][8 * s + 3]);
                w.z = pg8::cvt_pk_bf16(sacc[kb][8 * s + 4], sacc[kb][8 * s + 5]); w.w = pg8::cvt_pk_bf16(sacc[kb][8 * s + 6], sacc[kb][8 * s + 7]); pf[kb][s] = __builtin_bit_cast(bf16x8, w); }
        }
        lsum = pg8::xor32_sum(lsum);
        if (h == 0) lsw[r] = lsum;
        XAT_WAITBAR();
        f32x16 oacc[8];
#pragma unroll
        for (int db = 0; db < 8; ++db)
#pragma unroll
            for (int i = 0; i < 16; ++i) oacc[db][i] = 0.f;
        {
            bf16x8 vc[4], vn[4];
#pragma unroll
            for (int d4 = 0; d4 < 4; ++d4) vc[d4] = *(const LAS bf16x8*)(buf0 + r * 256 + d4 * 8192 + ((((h)) ^ (r & 15)) << 4));
#pragma unroll
            for (int st = 0; st < 32; ++st) { const int hf = st >> 4, kbl = (st >> 2) & 3, sx = (st >> 1) & 1, dh = st & 1;
                if (st + 1 < 32) { const int s1 = st + 1, hn = s1 >> 4, kn_ = (s1 >> 2) & 3, sn = (s1 >> 1) & 1, dn = s1 & 1;
                    LAS unsigned char* nb = (hn ? buf1 : buf0) + r * 256 + dn * 32768 + ((((4 * kn_ + 2 * sn + h)) ^ (r & 15)) << 4);
#pragma unroll
                    for (int d4 = 0; d4 < 4; ++d4) vn[d4] = *(const LAS bf16x8*)(nb + d4 * 8192); }
#pragma unroll
                for (int d4 = 0; d4 < 4; ++d4) oacc[dh * 4 + d4] = __builtin_amdgcn_mfma_f32_32x32x16_bf16(pf[hf * 4 + kbl][sx], vc[d4], oacc[dh * 4 + d4], 0, 0, 0);
#pragma unroll
                for (int d4 = 0; d4 < 4; ++d4) vc[d4] = vn[d4];
            }
        }
        float inv[16];
#pragma unroll
        for (int i = 0; i < 16; ++i) inv[i] = __builtin_amdgcn_rcpf(lsw[(i & 3) + 8 * (i >> 2) + 4 * h]);
        bf16* Ow = O + ((size_t)(4 * hd) * TT + row0) * 64 + r;
#pragma unroll
        for (int db = 0; db < 8; ++db)
#pragma unroll
            for (int i = 0; i < 16; ++i) { const float ov = oacc[db][i] * inv[i]; Ow[((size_t)(db >> 1) * TT + ((i & 3) + 8 * (i >> 2) + 4 * h)) * 64 + (db & 1) * 32] = (bf16)(pg8::cvt_pk_bf16(ov, ov) & 0xffffu); }
    }
    XAT_WAITBAR();
}
}


namespace hg {
typedef short bf16x8 __attribute__((ext_vector_type(8)));
typedef float f32x16 __attribute__((ext_vector_type(16)));
typedef unsigned u32x2v __attribute__((ext_vector_type(2)));
typedef float f32x2v __attribute__((ext_vector_type(2)));
#define HG_BAR() asm volatile("s_waitcnt lgkmcnt(0)\n\ts_barrier" ::: "memory")
#define HG_WAITBAR() asm volatile("s_waitcnt vmcnt(0) lgkmcnt(0)\n\ts_barrier" ::: "memory")
constexpr int QT = 0, QB = 16384, KT = 32768, KTT = 49152, VTI = 65536, ST = 81920, TAB = 131072 + 2048;
__device__ __forceinline__ int sig(int x) { return (x & ~12) | ((x & 4) << 1) | ((x & 8) >> 1); }
__device__ __forceinline__ float ex2(float x) { return __builtin_amdgcn_exp2f(x); }
struct RawL { unsigned lg[8]; };
struct RawQV { unsigned q[8]; v4u v[2]; };
__device__ __forceinline__ void load_lg(RawL& R, const bf16* P1h, int c, int tid, int wid) {
    const unsigned* pl = (const unsigned*)(P1h + (size_t)(c * 64 + 8 * wid) * HGD + 2 * (tid & 63));
#pragma unroll
    for (int j = 0; j < 8; ++j) R.lg[j] = pl[j * (HGD / 2)];
}
__device__ __forceinline__ void load_qv(RawQV& R, const bf16* P0h, const bf16* P2h, int c, int tid, int wid) {
    const unsigned* pq = (const unsigned*)(P0h + (size_t)(c * 64 + 8 * wid) * HGD + 2 * (tid & 63));
#pragma unroll
    for (int j = 0; j < 8; ++j) R.q[j] = pq[j * (HGD / 2)];
    const v4u* pv = (const v4u*)(P2h + (size_t)(c * 64 + 2 * (tid & 31)) * HGD + 8 * (tid >> 5));
    R.v[0] = pv[0]; R.v[1] = pv[HGD / 8];
}
__device__ __forceinline__ void load_og(u32x2v (&og)[4], const bf16* P3h, int c, int tid, int tb, int vb) {
    const int lane = tid & 63, r = lane & 31, h = lane >> 5;
    const u32x2v* po = (const u32x2v*)(P3h + (size_t)(c * 64 + 32 * tb + r) * HGD + 32 * vb + 4 * h);
#pragma unroll
    for (int q = 0; q < 4; ++q) og[q] = po[2 * q];
}
__device__ __forceinline__ void chunk_body(LAS unsigned char* lds, RawL& RL, RawQV& QV, f32x16 (&Sst)[2], const int c, const int tid0, const int wid,
                                           const bf16* P0h, const bf16* P1h, const bf16* P2h, const bf16* P3h, const float* gnh, bf16* Yb) {
    LAS float* TOT = (LAS float*)(lds + TAB); LAS float* DL = TOT + 1024; LAS float* DMT = DL + 128; LAS float* SSQX = DMT + 128;
    const int tb = wid >> 2, vb = wid & 3, kb0 = 2 * (wid >> 2);
    int tid = tid0; asm volatile("" : "+v"(tid));
    if (c >= 0) {
    const int lane = tid & 63, r = lane & 31, h = lane >> 5, kp = lane, k0 = 2 * lane, sw256 = r & 15, sw128 = (r >> 1) & 7;
    u32x2v ogr[4]; load_og(ogr, P3h, c, tid, tb, vb);
    { float r0 = 0.f, r1 = 0.f;
#pragma unroll
      for (int j = 0; j < 8; ++j) { r0 += bflo(RL.lg[j]); r1 += bfhi(RL.lg[j]); }
      *(LAS f32x2v*)(TOT + wid * 128 + k0) = (f32x2v){r0, r1}; }
    HG_BAR();
    { const int sp = tid & 31, vg = tid >> 5, s = 2 * sp;
      const unsigned a4[4] = {QV.v[0].x, QV.v[0].y, QV.v[0].z, QV.v[0].w}, b4[4] = {QV.v[1].x, QV.v[1].y, QV.v[1].z, QV.v[1].w};
#pragma unroll
      for (int e = 0; e < 8; ++e) { const int v = 8 * vg + e;
          const unsigned lo = (e & 1) ? (a4[e >> 1] >> 16) : (a4[e >> 1] & 0xffffu), hi = (e & 1) ? (b4[e >> 1] & 0xffff0000u) : (b4[e >> 1] << 16);
          *(LAS unsigned*)(lds + VTI + v * 128 + ((((s >> 3) ^ ((v >> 1) & 7))) << 4) + (s & 7) * 2) = lo | hi; } }
    { float off0 = 0.f, off1 = 0.f, bm0 = 0.f, bm1 = 0.f, bl0 = 0.f, bl1 = 0.f;
#pragma unroll
      for (int sgi = 0; sgi < 8; ++sgi) { const f32x2v tt = *(const LAS f32x2v*)(TOT + sgi * 128 + k0);
          if (sgi < wid) { off0 += tt[0]; off1 += tt[1]; } if (sgi < 4) { bm0 += tt[0]; bm1 += tt[1]; } bl0 += tt[0]; bl1 += tt[1]; }
      const float em0 = ex2(bm0), em1 = ex2(bm1);
      unsigned ktA[4], ktB[4];
      float pk0 = 0.f, pk1 = 0.f, run0 = off0 - bm0, run1 = off1 - bm1;
#pragma unroll
      for (int j = 0; j < 8; ++j) { const int t = 8 * wid + j, rho = sig(t);
          const float l0 = bflo(RL.lg[j]), l1 = bfhi(RL.lg[j]); run0 += l0; run1 += l1;
          const float d0 = run0, d1 = run1;
          const float E0 = ex2(fminf(d0, 115.f)), E1 = ex2(fminf(d1, 115.f)), I0 = ex2(fminf(-d0, 115.f)), I1 = ex2(fminf(-d1, 115.f));
          const float q0 = bflo(QV.q[j]) * E0, q1 = bfhi(QV.q[j]) * E1, kt0 = (1.0f - ex2(l0)) * I0, kt1 = (1.0f - ex2(l1)) * I1;
          const int co = (k0 & 7) * 2;
          *(LAS unsigned*)(lds + QT + t * 256 + ((((k0 >> 3) ^ (t & 15))) << 4) + co) = pg8::cvt_pk_bf16(q0, q1);
          *(LAS unsigned*)(lds + QB + t * 256 + ((((k0 >> 3) ^ (t & 15))) << 4) + co) = pg8::cvt_pk_bf16(q0 * em0, q1 * em1);
          *(LAS unsigned*)(lds + KT + rho * 256 + ((((k0 >> 3) ^ (rho & 15))) << 4) + co) = pg8::cvt_pk_bf16(kt0, kt1);
          if (j & 1) { ktA[j >> 1] = pg8::cvt_pk_bf16(pk0, kt0); ktB[j >> 1] = pg8::cvt_pk_bf16(pk1, kt1); } else { pk0 = kt0; pk1 = kt1; } }
      *(LAS v4u*)(lds + KTT + k0 * 128 + ((((wid) ^ (kp & 7))) << 4)) = (v4u){ktA[0], ktA[1], ktA[2], ktA[3]};
      *(LAS v4u*)(lds + KTT + (k0 + 1) * 128 + ((((wid) ^ (kp & 7))) << 4)) = (v4u){ktB[0], ktB[1], ktB[2], ktB[3]};
      if (wid == 0) *(LAS f32x2v*)(DL + k0) = (f32x2v){ex2(bl0), ex2(bl1)};
      if (wid == 1) *(LAS f32x2v*)(DMT + k0) = (f32x2v){ex2(bl0 - bm0), ex2(bl1 - bm1)}; }
    if (c + 2 < SEQ / 64) load_lg(RL, P1h, c + 2, tid, wid);
    if (c + 1 < SEQ / 64) load_qv(QV, P0h, P2h, c + 1, tid, wid);
    HG_BAR();
    f32x16 oT;
#pragma unroll
    for (int i = 0; i < 16; ++i) oT[i] = 0.f;
    { bf16x8 qfr[8];
#pragma unroll
      for (int ks = 0; ks < 8; ++ks) qfr[ks] = *(const LAS bf16x8*)(lds + QT + (32 * tb + r) * 256 + ((((2 * ks + h) ^ sw256)) << 4));
#pragma unroll
      for (int sb = 0; sb < 2; ++sb) {
        if (sb <= tb) {
            f32x16 x;
#pragma unroll
            for (int i = 0; i < 16; ++i) x[i] = 0.f;
#pragma unroll
            for (int ks = 0; ks < 8; ++ks) { const bf16x8 a = *(const LAS bf16x8*)(lds + KT + (32 * sb + r) * 256 + ((((2 * ks + h) ^ sw256)) << 4));
                x = __builtin_amdgcn_mfma_f32_32x32x16_bf16(a, qfr[ks], x, 0, 0, 0); }
            if (sb == tb) {
#pragma unroll
                for (int i = 0; i < 16; ++i) { const int sl = (i & 3) + 4 * ((i >> 2) & 1) + 8 * h + 16 * (i >> 3); if (sl > r) x[i] = 0.f; } }
#pragma unroll
            for (int ss = 0; ss < 2; ++ss) { v4u w; w.x = pg8::cvt_pk_bf16(x[8 * ss + 0], x[8 * ss + 1]); w.y = pg8::cvt_pk_bf16(x[8 * ss + 2], x[8 * ss + 3]);
                w.z = pg8::cvt_pk_bf16(x[8 * ss + 4], x[8 * ss + 5]); w.w = pg8::cvt_pk_bf16(x[8 * ss + 6], x[8 * ss + 7]);
                const bf16x8 a = *(const LAS bf16x8*)(lds + VTI + (32 * vb + r) * 128 + ((((4 * sb + 2 * ss + h) ^ sw128)) << 4));
                oT = __builtin_amdgcn_mfma_f32_32x32x16_bf16(a, __builtin_bit_cast(bf16x8, w), oT, 0, 0, 0); }
        }
      } }
#pragma unroll
    for (int ks = 0; ks < 8; ++ks) { const bf16x8 a = *(const LAS bf16x8*)(lds + ST + (32 * vb + r) * 256 + ((((2 * ks + h) ^ sw256)) << 4));
        const bf16x8 qb = *(const LAS bf16x8*)(lds + QB + (32 * tb + r) * 256 + ((((2 * ks + h) ^ sw256)) << 4));
        oT = __builtin_amdgcn_mfma_f32_32x32x16_bf16(a, qb, oT, 0, 0, 0); }
#pragma unroll
    for (int blk = 0; blk < 2; ++blk) { f32x16 U[2];
#pragma unroll
        for (int i = 0; i < 16; ++i) U[blk][i] = 0.f;
#pragma unroll
        for (int st = 0; st < 4; ++st) { const bf16x8 a = *(const LAS bf16x8*)(lds + KTT + (32 * (kb0 + blk) + r) * 128 + ((((2 * st + h) ^ sw128)) << 4));
            const bf16x8 bv = *(const LAS bf16x8*)(lds + VTI + (32 * vb + r) * 128 + ((((2 * st + h) ^ sw128)) << 4));
            U[blk] = __builtin_amdgcn_mfma_f32_32x32x16_bf16(a, bv, U[blk], 0, 0, 0); }
#pragma unroll
        for (int q = 0; q < 4; ++q) { const int kbase = 32 * (kb0 + blk) + 8 * q + 4 * h; const f32x4 dl = *(const LAS f32x4*)(DL + kbase), dm = *(const LAS f32x4*)(DMT + kbase);
#pragma unroll
            for (int e = 0; e < 4; ++e) Sst[blk][4 * q + e] = dl[e] * Sst[blk][4 * q + e] + dm[e] * U[blk][4 * q + e]; }
    }
    { float part = 0.f;
#pragma unroll
      for (int i = 0; i < 16; ++i) part += oT[i] * oT[i];
      part = pg8::xor32_sum(part);
      if (h == 0) SSQX[(32 * tb + r) * 4 + vb] = part; }
    HG_BAR();
    { const f32x4 sx = *(const LAS f32x4*)(SSQX + (32 * tb + r) * 4); const float rs = rsqrtf(((sx[0] + sx[1]) + (sx[2] + sx[3])) * (1.0f / HGD) + EPS);
#pragma unroll
      for (int q = 0; q < 4; ++q) { const f32x4 gn4 = *(const LAS f32x4*)(SSQX + 256 + 32 * vb + 8 * q + 4 * h);
          const float y0 = oT[4 * q + 0] * rs * gn4[0] * bflo(ogr[q].x), y1 = oT[4 * q + 1] * rs * gn4[1] * bfhi(ogr[q].x);
          const float y2 = oT[4 * q + 2] * rs * gn4[2] * bflo(ogr[q].y), y3 = oT[4 * q + 3] * rs * gn4[3] * bfhi(ogr[q].y);
          *(u32x2v*)(Yb + ((size_t)(vb >> 1) * TT + (64 * c + 32 * tb + r)) * 64 + (vb & 1) * 32 + 8 * q + 4 * h) = (u32x2v){pg8::cvt_pk_bf16(y0, y1), pg8::cvt_pk_bf16(y2, y3)}; } }
#pragma unroll
    for (int blk = 0; blk < 2; ++blk)
#pragma unroll
        for (int q = 0; q < 4; ++q) { const int kbase = 32 * (kb0 + blk) + 8 * q + 4 * h;
            *(LAS u32x2v*)(lds + ST + (32 * vb + r) * 256 + ((((kbase >> 3) ^ sw256)) << 4) + (kbase & 7) * 2) =
                (u32x2v){pg8::cvt_pk_bf16(Sst[blk][4 * q + 0], Sst[blk][4 * q + 1]), pg8::cvt_pk_bf16(Sst[blk][4 * q + 2], Sst[blk][4 * q + 3])}; }
    } else {
        load_lg(RL, P1h, c + 2, tid, wid);
        if (c == -1) load_qv(QV, P0h, P2h, 0, tid, wid);
    }
}
__device__ __forceinline__ void scan_phase(LAS unsigned char* lds, const bf16* P0  , const bf16* P1  , const bf16* P2  , const bf16* P3  , const float* gnorm, bf16* Y, int wave_s) {
    const int tid0 = opaque_tid(wave_s), wid = __builtin_amdgcn_readfirstlane(tid0 >> 6);
    const int tb = wid >> 2, vb = wid & 3, G = gridDim.x;
    for (int item = blockIdx.x; item < NBATCH * HGH; item += G) {
        const int b = item >> 3, hh = item & 7;
        const size_t hoff = (size_t)item * SEQ * HGD;
        const bf16* P0h = P0 + hoff; const bf16* P1h = P1 + hoff; const bf16* P2h = P2 + hoff; const bf16* P3h = P3 + hoff;
        bf16* Yb = Y + ((size_t)(2 * hh) * TT + (size_t)b * SEQ) * 64; const float* gnh = gnorm + hh * HGD;
        f32x16 Sst[2];
#pragma unroll
        for (int i = 0; i < 16; ++i) { Sst[0][i] = 0.f; Sst[1][i] = 0.f; }
        HG_WAITBAR();
        RawL LA, LB; RawQV QV;
#pragma unroll
        for (int i = 0; i < 16; ++i) *(LAS unsigned*)(lds + ST + (tid0 * 16 + i) * 4) = 0u;
        if (tid0 < HGD) ((LAS float*)(lds + TAB))[1024 + 128 + 128 + 256 + tid0] = gnh[tid0];
#pragma unroll 1
        for (int c = -2; c < SEQ / 64; c += 2) {
            chunk_body(lds, LA, QV, Sst, c, tid0, wid, P0h, P1h, P2h, P3h, gnh, Yb);
            chunk_body(lds, LB, QV, Sst, c + 1, tid0, wid, P0h, P1h, P2h, P3h, gnh, Yb);
        }
    }
    HG_WAITBAR();
}
}
__device__ __forceinline__ void late_weights(const Params& p, LAS unsigned char* lds, int wave_s) {
    const int G = gridDim.x, nside = G - NBATCH * HGH, my = (int)blockIdx.x - NBATCH * HGH;
    if (nside <= 0 || my < 0) return;
    const int tid = opaque_tid(wave_s), lane = tid & 63, wave = __builtin_amdgcn_readfirstlane(tid >> 6);
    tr_run(p, p.ws, (LAS float*)(lds + RING_OFF + wave * 16384), 1, TR_ITEMS_LATE, my * NWAVES + wave, nside * NWAVES, lane);
}

__device__ __forceinline__ void scan_naive(bf16* P0  , const bf16* P1  , const bf16* P2  , const bf16* P3  , const float* gnorm, unsigned char* lds_generic, int G) {
    float* q_s = (float*)lds_generic;
    float* g_s = q_s + 16 * 128;
    float* v_s = g_s + 16 * 128;
    float* part = v_s + 16 * 128;
    const int tid = threadIdx.x, lane = tid & 63, wave = tid >> 6, vv = tid & 127, kq = tid >> 7;
    for (int item = blockIdx.x; item < NBATCH * HGH; item += G) {
        const int b = item >> 3, h = item & 7;
        const size_t base = (size_t)b * SEQ * DM + h * HGD;
        float S[32];
#pragma unroll
        for (int i = 0; i < 32; ++i) S[i] = 0.f;
        for (int t0 = 0; t0 < SEQ; t0 += 16) {
            __syncthreads();
            { const int r = tid >> 5, c4 = (tid & 31) * 4; const size_t off = base + (size_t)(t0 + r) * DM + c4;
              const uint2 a = *(const uint2*)(P0 + off), l = *(const uint2*)(P1 + off), i2 = *(const uint2*)(P2 + off);
              float* qd = q_s + r * 128 + c4; float* gd = g_s + r * 128 + c4; float* vd = v_s + r * 128 + c4;
              qd[0] = bflo(a.x); qd[1] = bfhi(a.x); qd[2] = bflo(a.y); qd[3] = bfhi(a.y);
              gd[0] = exp2f(bflo(l.x)); gd[1] = exp2f(bfhi(l.x)); gd[2] = exp2f(bflo(l.y)); gd[3] = exp2f(bfhi(l.y));
              vd[0] = bflo(i2.x); vd[1] = bfhi(i2.x); vd[2] = bflo(i2.y); vd[3] = bfhi(i2.y); }
            __syncthreads();
            for (int s = 0; s < 16; ++s) {
                const float vval = v_s[s * 128 + vv]; float acc = 0.f;
#pragma unroll
                for (int i = 0; i < 32; ++i) { const float gk = g_s[s * 128 + kq * 32 + i]; S[i] = gk * S[i] + (1.0f - gk) * vval; acc += q_s[s * 128 + kq * 32 + i] * S[i]; }
                part[(s * 4 + kq) * 128 + vv] = acc;
            }
            __syncthreads();
#pragma unroll
            for (int ss = 0; ss < 2; ++ss) { const int s = wave * 2 + ss; const int t = t0 + s;
                float o0 = 0.f, o1 = 0.f;
#pragma unroll
                for (int k = 0; k < 4; ++k) { o0 += part[(s * 4 + k) * 128 + lane]; o1 += part[(s * 4 + k) * 128 + 64 + lane]; }
                const float ssq = wave_sum(o0 * o0 + o1 * o1); const float rs = rsqrtf(ssq * (1.0f / HGD) + EPS);
                const size_t off = base + (size_t)t * DM;
                const float y0 = o0 * rs * gnorm[h * HGD + lane] * bfu2f(P3[off + lane]), y1 = o1 * rs * gnorm[h * HGD + 64 + lane] * bfu2f(P3[off + 64 + lane]);
                P0[off + lane] = (bf16)f2bf(y0); P0[off + 64 + lane] = (bf16)f2bf(y1); }
        }
    }
}

__device__ __forceinline__ void final_norm(const bf16* XBp, const float* gfin, float* out, int wave_s) {
    const int tid = opaque_tid(wave_s), lane = tid & 63, gw = blockIdx.x * NWAVES + __builtin_amdgcn_readfirstlane(tid >> 6), NGW = gridDim.x * NWAVES;
    constexpr int RB = 4;
    f32x4 g[2][2];
#pragma unroll
    for (int j = 0; j < 2; ++j)
#pragma unroll
        for (int q = 0; q < 2; ++q) g[j][q] = *(const f32x4*)(gfin + 512 * j + 8 * lane + 4 * q);
    for (int m0 = RB * gw; m0 < TT; m0 += RB * NGW) {
        v4u a[RB], b[RB];
#pragma unroll
        for (int i = 0; i < RB; ++i) { const bf16* xr = XBp + ((size_t)(lane >> 3) * TT + m0 + i) * 64 + 8 * (lane & 7);
            a[i] = *(const v4u*)xr; b[i] = *(const v4u*)(xr + (size_t)8 * TT * 64); }
#pragma unroll
        for (int i = 0; i < RB; ++i) {
            float v[16] = {bflo(a[i].x), bfhi(a[i].x), bflo(a[i].y), bfhi(a[i].y), bflo(a[i].z), bfhi(a[i].z), bflo(a[i].w), bfhi(a[i].w),
                           bflo(b[i].x), bfhi(b[i].x), bflo(b[i].y), bfhi(b[i].y), bflo(b[i].z), bfhi(b[i].z), bflo(b[i].w), bfhi(b[i].w)};
            float s = 0.f;
#pragma unroll
            for (int k = 0; k < 16; ++k) s += v[k] * v[k];
            s = wave_sum(s); const float rs = rsqrtf(s * (1.0f / DM) + EPS);
#pragma unroll
            for (int j = 0; j < 2; ++j)
#pragma unroll
                for (int q = 0; q < 2; ++q) { const int col = 512 * j + 8 * lane + 4 * q;
                    f32x4 o; o[0] = v[8 * j + 4 * q + 0] * rs * g[j][q][0]; o[1] = v[8 * j + 4 * q + 1] * rs * g[j][q][1]; o[2] = v[8 * j + 4 * q + 2] * rs * g[j][q][2]; o[3] = v[8 * j + 4 * q + 3] * rs * g[j][q][3];
                    *(f32x4*)(out + (size_t)(m0 + i) * DM + col) = o; }
        }
    }
}

#ifndef MK_DUP_G2
#define MK_DUP_G2 0
#endif
#ifndef MK_DUP_GQ
#define MK_DUP_GQ 0
#endif
#ifndef MK_DUP_SCAN
#define MK_DUP_SCAN 0
#endif
#ifndef MK_DUP_ATTN
#define MK_DUP_ATTN 0
#endif
#ifndef MK_DUP_FFN
#define MK_DUP_FFN 0
#endif
#ifndef MK_DUP_PRO
#define MK_DUP_PRO 0
#endif
#ifndef MK_DUP_CONV
#define MK_DUP_CONV 0
#endif
#ifndef MK_EXTRA_BAR
#define MK_EXTRA_BAR 0
#endif
#ifndef MK_SCAN_MFMA
#define MK_SCAN_MFMA 1
#endif
#ifndef MK_ATTN_MFMA
#define MK_ATTN_MFMA 1
#endif
#ifndef MK_G6_REV
#define MK_G6_REV 0
#endif
#ifndef MK_ALIGN_EPI
#define MK_ALIGN_EPI true
#endif
#ifndef MK_SP2
#define MK_SP2 true
#endif
#ifndef MK_NAIVE_GEMM
#define MK_NAIVE_GEMM 1
#endif
#if MK_NAIVE_GEMM
#define RUN_GEMM(EPI_T, g_, S_, E_) pg8::gemm_phase_naive<EPI_T, pg8::StaticOrder>(g_, S_, E_)
#else
#define RUN_GEMM(EPI_T, g_, S_, E_) pg8::gemm_phase<EPI_T, pg8::StaticOrder, MK_ALIGN_EPI, MK_SP2>(lds + RING_OFF, g_, S_, E_, wave_s)
#endif

__global__ void __launch_bounds__(NWAVES * 64, 2) mk_fwd(Params p) {
    extern __shared__ __attribute__((aligned(16))) unsigned char lds_raw[];
    LAS unsigned char* lds = (LAS unsigned char*)lds_raw;
    volatile LAS unsigned* MISC = (volatile LAS unsigned*)(lds + MISC_OFF);
    const int tid = threadIdx.x;
    const int wave_s = __builtin_amdgcn_readfirstlane(tid >> 6);
    const int G = gridDim.x, bid = blockIdx.x;
    unsigned char* const ws0 = p.ws;
    gu32* ctl = (gu32*)(ws0 + WS_CTL);
    for (int u = tid; u < (LDS_BYTES - LDSCTL_OFF) / 4; u += NWAVES * 64) ((LAS unsigned*)(lds + LDSCTL_OFF))[u] = 0u;
    __syncthreads();
    XcdBarrier bar = xcd_barrier_post((unsigned*)(ctl + CW_BAR), MISC + 8);
#define GRID_BAR() xcd_barrier(bar)
    LAS float* const RST = (LAS float*)(lds + pg8::RS_TABLE_OFF);

#define OPQ_WS() (ws0)

    p0_prologue(p, lds, wave_s);
#if MK_DUP_PRO
    p0_prologue(p, lds, wave_s);
#endif
    GRID_BAR();

#pragma unroll 1
    for (int l = 0; l < 2; ++l) {
        unsigned char* ws = OPQ_WS();
        { pg8::Gemm g{(const pg8::bf16_t*)(ws + WS_MEMB), (const pg8::bf16_t*)(ws + WS_WKV + l * SZ_WKV), TMEM, 1024, 1024}; pg8::StaticOrder S; S.init(TMEM, 1024, G, (bid + G - (128 * l) % G) % G);
          pg8::EpiScale E{(pg8::bf16_t*)(ws + WS_KV + l * SZ_KV), 1024, nullptr, (const float*)(ws + WS_RMEM), 1.0f, RST};
          RUN_GEMM(pg8::EpiScale, g, S, E); }
        { pg8::Gemm g{(const pg8::bf16_t*)(ws + WS_WKV + l * SZ_WKV) + 1024 * 1024, (const pg8::bf16_t*)(ws + WS_MEMB), 1024, TMEM, 1024}; pg8::StaticOrder S; S.init(1024, TMEM, G, (bid + G - (128 * l + 64) % G) % G);
          pg8::EpiColScale E{(pg8::bf16_t*)(ws + WS_KV + l * SZ_KV + OFF_VT), TMEM, (const float*)(ws + WS_RMEM)};
          RUN_GEMM(pg8::EpiColScale, g, S, E); }
    }

#pragma unroll 1
    for (int l = 0; l < 2; ++l) {
        unsigned char* ws = OPQ_WS();
        float* SSQ = (float*)(ws + WS_SSQ);
        pg8::bf16_t* XB = (pg8::bf16_t*)(ws + WS_XB);
        pg8::bf16_t* P0 = (pg8::bf16_t*)(ws + WS_P), *P1 = (pg8::bf16_t*)(ws + WS_P + SZ_P), *P2 = (pg8::bf16_t*)(ws + WS_P + 2 * SZ_P), *P3 = (pg8::bf16_t*)(ws + WS_P + 3 * SZ_P);
        pg8::bf16_t* HB = P0;
        if (l == 0) {
            { pg8::Gemm g{XB, (const pg8::bf16_t*)(ws + WS_WCIN), TT, 3072, 1024, 64, (size_t)TT * 128, 64, (size_t)3072 * 128}; pg8::StaticOrder S; S.init(TT, 3072, G, bid);
              pg8::EpiPair<0> E{P0, 1024, P1, SSQ, RST};
              RUN_GEMM(pg8::EpiPair<0>, g, S, E); }
            GRID_BAR();
            conv_pass(P0, P1, p.in[4], P2, wave_s);
#if MK_DUP_CONV
            conv_pass(P0, P1, p.in[4], P2, wave_s);
#endif
            GRID_BAR();
            { pg8::Gemm g{P2, (const pg8::bf16_t*)(ws + WS_WCOUT), TT, 1024, 1024, 64, (size_t)TT * 128, 64, (size_t)1024 * 128}; pg8::StaticOrder S; S.init(TT, 1024, G, bid);
              pg8::EpiResid E{XB, SSQ, 1.0f};
              RUN_GEMM(pg8::EpiResid, g, S, E);
#if MK_DUP_G2
              RUN_GEMM(pg8::EpiResid, g, S, E);
#endif
            }
            GRID_BAR();
        } else {
            { pg8::Gemm g{XB, (const pg8::bf16_t*)(ws + WS_WHIN), TT, 4096, 1024, 64, (size_t)TT * 128, 64, (size_t)4096 * 128}; pg8::StaticOrder S; S.init(TT, 4096, G, bid);
              pg8::EpiHgrn E{P0, (size_t)TT * DM, SSQ, (const float*)(ws + WS_LB), RST};
              RUN_GEMM(pg8::EpiHgrn, g, S, E); }
            GRID_BAR();
#if MK_SCAN_MFMA
            late_weights(p, lds, wave_s);
            hg::scan_phase(lds, P0, P1, P2, P3, p.in[8], (bf16*)(ws + WS_Y), wave_s);
#if MK_DUP_SCAN
            hg::scan_phase(lds, P0, P1, P2, P3, p.in[8], (bf16*)(ws + WS_Y), wave_s);
#endif
            GRID_BAR();
            { pg8::Gemm g{(const pg8::bf16_t*)(ws + WS_Y), (const pg8::bf16_t*)(ws + WS_WHOUT), TT, 1024, 1024, 64, (size_t)TT * 128, 64, (size_t)1024 * 128};
#else
            scan_naive(P0, P1, P2, P3, p.in[8], lds_raw, G);
            GRID_BAR();
            { pg8::Gemm g{P0, (const pg8::bf16_t*)(ws + WS_WHOUT), TT, 1024, 1024};
#endif
              pg8::StaticOrder S; S.init(TT, 1024, G, bid);
              pg8::EpiResid E{XB, SSQ, 1.0f};
              RUN_GEMM(pg8::EpiResid, g, S, E); }
            GRID_BAR();
        }
        { pg8::Gemm g{XB, (const pg8::bf16_t*)(ws + WS_WQ + l * SZ_WQ), TT, 1024, 1024, 64, (size_t)TT * 128, 64, (size_t)1024 * 128}; pg8::StaticOrder S; S.init(TT, 1024, G, bid);
          pg8::EpiScale E{P0, 1024, SSQ, nullptr, QSCALE, RST};
          RUN_GEMM(pg8::EpiScale, g, S, E);
#if MK_DUP_GQ
          if (l == 0) { RUN_GEMM(pg8::EpiScale, g, S, E); }
#endif
        }
#if MK_ATTN_MFMA
        asm volatile("s_waitcnt vmcnt(0) lgkmcnt(0)" ::: "memory"); __syncthreads();
#else
        GRID_BAR();
#endif
#if MK_ATTN_MFMA
        xat::attn_phase(lds, P0, (const bf16*)(ws + WS_KV + l * SZ_KV), (const bf16*)(ws + WS_KV + l * SZ_KV + OFF_VT), P1, wave_s);
#if MK_DUP_ATTN
        xat::attn_phase(lds, P0, (const bf16*)(ws + WS_KV + l * SZ_KV), (const bf16*)(ws + WS_KV + l * SZ_KV + OFF_VT), P1, wave_s);
#endif
#else
        attn_naive(P0, (const bf16*)(ws + WS_KV + l * SZ_KV), (const bf16*)(ws + WS_KV + l * SZ_KV + OFF_VT), P1, wave_s);
#endif
        GRID_BAR();
        { pg8::Gemm g{P1, (const pg8::bf16_t*)(ws + WS_WO + l * SZ_WO), TT, 1024, 1024, 64, (size_t)TT * 128, 64, (size_t)1024 * 128}; pg8::StaticOrder S; S.init(TT, 1024, G, bid);
          pg8::EpiResid E{XB, SSQ, 1.0f};
          RUN_GEMM(pg8::EpiResid, g, S, E); }
        GRID_BAR();
        { pg8::Gemm g{XB, (const pg8::bf16_t*)(ws + WS_WFIN + l * SZ_WFIN), TT, 2 * DFF, 1024, 64, (size_t)TT * 128, 64, (size_t)(2 * DFF) * 128}; pg8::StaticOrder S; S.init(TT, 2 * DFF, G, bid);
          pg8::EpiPair<1> E{HB, DFF, nullptr, SSQ, RST};
          RUN_GEMM(pg8::EpiPair<1>, g, S, E);
#if MK_DUP_FFN
          if (l == 0) { RUN_GEMM(pg8::EpiPair<1>, g, S, E); }
#endif
        }
        GRID_BAR();
        { pg8::Gemm g{HB, (const pg8::bf16_t*)(ws + WS_WFOUT + l * SZ_WFOUT), TT, 1024, DFF, 64, (size_t)TT * 128, 64, (size_t)1024 * 128};     pg8::StaticOrder S; S.init(TT, 1024, G, bid, MK_G6_REV);
          pg8::EpiResid E{XB, SSQ, 1.0f};
          RUN_GEMM(pg8::EpiResid, g, S, E);
#if MK_DUP_G6
          if (l == 0) { pg8::EpiResid E0{XB, SSQ, 0.0f}; RUN_GEMM(pg8::EpiResid, g, S, E0); }
#endif
        }
        GRID_BAR();
    }
#if MK_EXTRA_BAR
#pragma unroll 1
    for (int eb = 0; eb < MK_EXTRA_BAR; ++eb) GRID_BAR();
#endif
    final_norm((const bf16*)(OPQ_WS() + WS_XB), p.in[18], p.out, wave_s);
}

extern "C" void kernel_launch(void* const* d_in, const int* in_sizes, int n_in, void* d_out, int out_size, void* d_ws, size_t ws_size, hipStream_t stream) {
    static int grid = 0;
    if (grid == 0) {
        if (n_in != 19 || out_size != TT * DM || ws_size < WS_END) { fprintf(stderr, "kernel_launch: unexpected shapes (n_in %d, out %d, ws %zu); nothing launched\n", n_in, out_size, ws_size); grid = -1; return; }
        int dev = 0, cus = 0, per_cu = 0;
        if (hipGetDevice(&dev) != hipSuccess || hipDeviceGetAttribute(&cus, hipDeviceAttributeMultiprocessorCount, dev) != hipSuccess) { fprintf(stderr, "kernel_launch: device query failed\n"); grid = -1; return; }
        if (hipFuncSetAttribute((const void*)mk_fwd, hipFuncAttributeMaxDynamicSharedMemorySize, LDS_BYTES) != hipSuccess) { fprintf(stderr, "kernel_launch: hipFuncSetAttribute failed\n"); grid = -1; return; }
        if (hipOccupancyMaxActiveBlocksPerMultiprocessor(&per_cu, (const void*)mk_fwd, NWAVES * 64, LDS_BYTES) != hipSuccess || per_cu < 1) { fprintf(stderr, "kernel_launch: occupancy query says %d blocks per CU\n", per_cu); per_cu = 1; }
        (void)hipGetLastError();
        grid = cus;
        if ((TT / 256) * (2 * DFF / 256) > pg8::RS_MAX_UNITS * grid) { fprintf(stderr, "kernel_launch: %d CUs: a workgroup would get more than %d units in one GEMM phase (the epilogues' LDS row-scale table holds that many); nothing launched\n", cus, pg8::RS_MAX_UNITS); grid = -1; return; }
    }
    if (grid < 0) return;
    if (hipMemsetAsync((char*)d_ws + WS_CTL, 0, CTL_ZERO_BYTES, stream) != hipSuccess) { fprintf(stderr, "kernel_launch: memset failed\n"); return; }
    Params a{};
    for (int i = 0; i < 19; ++i) a.in[i] = (const float*)d_in[i];
    a.out = (float*)d_out; a.ws = (unsigned char*)d_ws;
    hipLaunchKernelGGL(mk_fwd, dim3(grid), dim3(NWAVES * 64), LDS_BYTES, stream, a);
    const hipError_t le = hipPeekAtLastError();
    if (le != hipSuccess) fprintf(stderr, "kernel_launch: launch failed: %s\n", hipGetErrorName(le));
}
```
